# Optimizing an MI355X kernel written in HIP

```python
import math
import jax
import jax.numpy as jnp
from jax import lax
import numpy as np

D_MODEL = 1024
BATCH = 4
SEQ = 8192
DEPTH = 4

GRID_W = 64
CTX_LEN = 256
HEAD_DIM = 64
A_HEADS = 4
A_KV_HEADS = 2
A_WIDTH = A_HEADS * HEAD_DIM
A_KV_WIDTH = A_KV_HEADS * HEAD_DIM
HY_WIDTH = 256
HY_ORDER = 2
HY_IN = (HY_ORDER + 1) * HY_WIDTH
HY_BANDS = 16
HY_EMB_DIM = 1 + 2 * HY_BANDS
HY_HIDDEN = 64
HY_FILTER_CH = 2 * HY_ORDER * HY_WIDTH
HY_FAST_DECAY = 0.3
HY_SLOW_DECAY = 1.5
HY_TARGET = 1e-2
D_HEADS = 4
D_VALUE_DIM = 2 * HEAD_DIM
D_WIDTH = D_HEADS * D_VALUE_DIM
D_QK_WIDTH = D_HEADS * 2 * HEAD_DIM
MIX_WIDTH = A_WIDTH + HY_WIDTH + D_WIDTH
IN_SPLITS = (A_WIDTH, A_WIDTH + A_KV_WIDTH, A_WIDTH + 2 * A_KV_WIDTH, A_WIDTH + 2 * A_KV_WIDTH + HY_IN, A_WIDTH + 2 * A_KV_WIDTH + HY_IN + D_QK_WIDTH, A_WIDTH + 2 * A_KV_WIDTH + HY_IN + 2 * D_QK_WIDTH)
IN_WIDTH = A_WIDTH + 2 * A_KV_WIDTH + HY_IN + 2 * D_QK_WIDTH + D_WIDTH
D_FF = 2816
ROPE_THETA = 10000.0
Q_BLOCK = 128
EPS = 1e-6

kernel_name = 'hybrid_parallel_heads_flow_block'


def rms_norm(x, g):
    xf = x.astype(jnp.float32)
    y = xf * lax.rsqrt(jnp.mean(xf * xf, axis=-1, keepdims=True) + EPS)
    return (y * g.astype(jnp.float32)).astype(x.dtype)


def modulate(h, shift, scale):
    return h * (1.0 + scale) + shift


def dwconv3(u, w, b):
    up = jnp.pad(u, ((0, 0), (1, 1), (0, 0)))
    return up[:, :-2] * w[0] + up[:, 1:-1] * w[1] + up[:, 2:] * w[2] + b


def axial_rope_tables(rows, cols):
    n_freq = HEAD_DIM // 4
    inv = ROPE_THETA ** (-jnp.arange(n_freq, dtype=jnp.float32) / n_freq)
    ang = jnp.concatenate([rows[:, None] * inv, cols[:, None] * inv], axis=-1)
    return jnp.cos(ang), jnp.sin(ang)


def apply_rope(x, cos, sin):
    t = x.shape[1]
    bshape = (t,) + (1,) * (x.ndim - 3) + (cos.shape[-1],)
    c = cos.reshape(bshape)
    s = sin.reshape(bshape)
    xf = x.astype(jnp.float32)
    x1 = xf[..., 0::2]
    x2 = xf[..., 1::2]
    out = jnp.stack([x1 * c - x2 * s, x1 * s + x2 * c], axis=-1).reshape(x.shape)
    return out.astype(x.dtype)


def sweep_attention(q, k, v):
    b, hk, g, n, d = q.shape
    nb = n // Q_BLOCK
    qb = jnp.moveaxis(q.reshape(b, hk, g, nb, Q_BLOCK, d), 3, 0)
    scale = d ** -0.5

    def one_block(qi):
        s = jnp.einsum('bkgqd,bksd->bkgqs', qi, k, preferred_element_type=jnp.float32) * scale
        p = jax.nn.softmax(s, axis=-1)
        return jnp.einsum('bkgqs,bksd->bkgqd', p.astype(v.dtype), v)

    o = lax.map(one_block, qb)
    return jnp.moveaxis(o, 0, 3).reshape(b, hk, g, n, v.shape[-1])


def gqa_attention(q, k, v):
    b, n, h, d = q.shape
    hk = k.shape[2]
    qg = q.reshape(b, n, hk, h // hk, d).transpose(0, 2, 3, 1, 4)
    o = sweep_attention(qg, k.transpose(0, 2, 1, 3), v.transpose(0, 2, 1, 3))
    return o.transpose(0, 3, 1, 2, 4).reshape(b, n, h * v.shape[-1])


def diff_attention(q, k, v, lam):
    vv = v.transpose(0, 2, 1, 3)

    def component(j):
        qj = q[..., j, :].transpose(0, 2, 1, 3)[:, :, None]
        kj = k[..., j, :].transpose(0, 2, 1, 3)
        return sweep_attention(qj, kj, vv)[:, :, 0]

    o = component(0) - lam.astype(v.dtype) * component(1)
    return o.transpose(0, 2, 1, 3)


def hyena_filters(n, fw1, fb1, fw2, fb2, fw3, fb3, freq):
    pos = jnp.arange(n, dtype=jnp.float32)
    t = (pos / max(n - 1, 1))[:, None]
    w = 2.0 * math.pi * pos[:, None] / n
    bands = jnp.linspace(1e-4, HY_BANDS - 1, HY_BANDS, dtype=jnp.float32)
    z = jnp.concatenate([t, jnp.cos(bands * w), -jnp.sin(bands * w)], axis=-1)
    h = jnp.sin(freq * (z.astype(fw1.dtype) @ fw1 + fb1))
    h = jnp.sin(freq * (h @ fw2 + fb2))
    h = (h @ fw3 + fb3).astype(jnp.float32)
    max_decay = math.log(HY_TARGET) / HY_FAST_DECAY
    min_decay = math.log(HY_TARGET) / HY_SLOW_DECAY
    deltas = jnp.linspace(min_decay, max_decay, HY_WIDTH, dtype=jnp.float32)
    decay = jnp.exp(-t * jnp.abs(deltas))
    h = h.reshape(n, 2, HY_ORDER, HY_WIDTH) * decay[:, None, None, :]
    return h / (jnp.sum(jnp.abs(h), axis=(0, 1), keepdims=True) + EPS)


def long_conv(u, h_fwd, h_bwd, bias):
    n = u.shape[1]
    k = jnp.concatenate([h_fwd, jnp.zeros_like(h_fwd[:1]), h_bwd[:0:-1]], axis=0)
    k_f = jnp.fft.rfft(k, n=2 * n, axis=0)
    u32 = u.astype(jnp.float32)
    y = jnp.fft.irfft(jnp.fft.rfft(u32, n=2 * n, axis=1) * k_f[None], n=2 * n, axis=1)[:, :n]
    return (y + u32 * bias.astype(jnp.float32)).astype(u.dtype)


def hyena(u, conv_w, conv_b, fw1, fb1, fw2, fb2, fw3, fb3, freq, bias):
    n = u.shape[1]
    u = dwconv3(u, conv_w, conv_b)
    v, x1, x2 = jnp.split(u, 3, axis=-1)
    h = hyena_filters(n, fw1, fb1, fw2, fb2, fw3, fb3, freq)
    z = x1 * long_conv(v, h[:, 0, 0], h[:, 1, 0], bias[0])
    return x2 * long_conv(z, h[:, 0, 1], h[:, 1, 1], bias[1])


def merge_groups(ya, yh, yd, g_out, w_out, lam_init):
    b, n = ya.shape[:2]
    ya = rms_norm(ya, g_out[:A_WIDTH])
    yh = rms_norm(yh, g_out[A_WIDTH:A_WIDTH + HY_WIDTH])
    yd = rms_norm(yd, g_out[A_WIDTH + HY_WIDTH:].reshape(D_HEADS, D_VALUE_DIM)) * (1.0 - lam_init)
    return jnp.concatenate([ya, yh, yd.reshape(b, n, D_WIDTH)], axis=-1) @ w_out


def token_mixers(h, hc, cos, sin, lam, lam_init, need_ctx, w_in, qn_a, kn_a, qn_d, kn_d, hy_conv_w, hy_conv_b, hy_fw1, hy_fb1, hy_fw2, hy_fb2, hy_fw3, hy_fb3, hy_freq, hy_bias, g_out, w_out):
    b, n = h.shape[:2]
    m = hc.shape[1]
    qa, ka, va, hy, qd, kd, vd = jnp.split(h @ w_in, IN_SPLITS, axis=-1)
    qa_c, ka_c, va_c, hy_c, qd_c, kd_c, vd_c = jnp.split(hc @ w_in, IN_SPLITS, axis=-1)
    ka = apply_rope(rms_norm(ka.reshape(b, n, A_KV_HEADS, HEAD_DIM), kn_a), cos, sin)
    va = va.reshape(b, n, A_KV_HEADS, HEAD_DIM)
    ka_c = rms_norm(ka_c.reshape(b, m, A_KV_HEADS, HEAD_DIM), kn_a)
    va_c = va_c.reshape(b, m, A_KV_HEADS, HEAD_DIM)
    qa = apply_rope(rms_norm(qa.reshape(b, n, A_HEADS, HEAD_DIM), qn_a), cos, sin)
    ya = gqa_attention(qa, jnp.concatenate([ka_c, ka], axis=1), jnp.concatenate([va_c, va], axis=1))
    kd = apply_rope(rms_norm(kd.reshape(b, n, D_HEADS, 2, HEAD_DIM), kn_d), cos, sin)
    vd = vd.reshape(b, n, D_HEADS, D_VALUE_DIM)
    kd_c = rms_norm(kd_c.reshape(b, m, D_HEADS, 2, HEAD_DIM), kn_d)
    vd_c = vd_c.reshape(b, m, D_HEADS, D_VALUE_DIM)
    qd = apply_rope(rms_norm(qd.reshape(b, n, D_HEADS, 2, HEAD_DIM), qn_d), cos, sin)
    yd = diff_attention(qd, jnp.concatenate([kd_c, kd], axis=1), jnp.concatenate([vd_c, vd], axis=1), lam)
    yh = hyena(hy, hy_conv_w, hy_conv_b, hy_fw1, hy_fb1, hy_fw2, hy_fb2, hy_fw3, hy_fb3, hy_freq, hy_bias)
    y = merge_groups(ya, yh, yd, g_out, w_out, lam_init)
    if not need_ctx:
        return y, None
    qa_c = rms_norm(qa_c.reshape(b, m, A_HEADS, HEAD_DIM), qn_a)
    ya_c = gqa_attention(qa_c, ka_c, va_c)
    qd_c = rms_norm(qd_c.reshape(b, m, D_HEADS, 2, HEAD_DIM), qn_d)
    yd_c = diff_attention(qd_c, kd_c, vd_c, lam)
    yh_c = hyena(hy_c, hy_conv_w, hy_conv_b, hy_fw1, hy_fb1, hy_fw2, hy_fb2, hy_fw3, hy_fb3, hy_freq, hy_bias)
    return y, merge_groups(ya_c, yh_c, yd_c, g_out, w_out, lam_init)


def conv_glu(h, w_up, conv_w, conv_b, w_down):
    a, v = jnp.split(h @ w_up, 2, axis=-1)
    a = dwconv3(a, conv_w, conv_b)
    return (jax.nn.gelu(a, approximate=True) * v) @ w_down


def setup_inputs(seed: int = 0) -> dict:
    key = jax.random.key(seed)
    keys = iter(jax.random.split(key, 40))

    def nrm(shape, scale):
        return jax.random.normal(next(keys), shape, jnp.float32) * scale

    def gain(shape):
        return 1.0 + nrm(shape, 0.02)

    L = DEPTH
    return {
        'x': nrm((BATCH, SEQ, D_MODEL), 1.0),
        'c': nrm((BATCH, D_MODEL), 1.0),
        'ctx': nrm((BATCH, CTX_LEN, D_MODEL), 1.0),
        'c_ctx': nrm((D_MODEL,), 1.0),
        'norm1_g': gain((L, D_MODEL)),
        'norm2_g': gain((L, D_MODEL)),
        'w_mod': nrm((L, D_MODEL, 6 * D_MODEL), 0.5 * D_MODEL ** -0.5),
        'b_mod': nrm((L, 6 * D_MODEL), 0.02),
        'w_in': nrm((L, D_MODEL, IN_WIDTH), D_MODEL ** -0.5),
        'qn_a': gain((L, HEAD_DIM)),
        'kn_a': gain((L, HEAD_DIM)),
        'qn_d': gain((L, HEAD_DIM)),
        'kn_d': gain((L, HEAD_DIM)),
        'lam_q1': nrm((L, HEAD_DIM), 0.1),
        'lam_k1': nrm((L, HEAD_DIM), 0.1),
        'lam_q2': nrm((L, HEAD_DIM), 0.1),
        'lam_k2': nrm((L, HEAD_DIM), 0.1),
        'hy_conv_w': nrm((L, 3, HY_IN), 3 ** -0.5),
        'hy_conv_b': nrm((L, HY_IN), 0.02),
        'hy_fw1': nrm((L, HY_EMB_DIM, HY_HIDDEN), HY_EMB_DIM ** -0.5),
        'hy_fb1': nrm((L, HY_HIDDEN), 0.5),
        'hy_fw2': nrm((L, HY_HIDDEN, HY_HIDDEN), HY_HIDDEN ** -0.5),
        'hy_fb2': nrm((L, HY_HIDDEN), 0.5),
        'hy_fw3': nrm((L, HY_HIDDEN, HY_FILTER_CH), HY_HIDDEN ** -0.5),
        'hy_fb3': nrm((L, HY_FILTER_CH), 0.02),
        'hy_freq': gain((L, HY_HIDDEN)),
        'hy_bias': nrm((L, HY_ORDER, HY_WIDTH), 0.1),
        'g_out': gain((L, MIX_WIDTH)),
        'w_out': nrm((L, MIX_WIDTH, D_MODEL), MIX_WIDTH ** -0.5),
        'w_up': nrm((L, D_MODEL, 2 * D_FF), D_MODEL ** -0.5),
        'ffn_conv_w': nrm((L, 3, D_FF), 3 ** -0.5),
        'ffn_conv_b': nrm((L, D_FF), 0.02),
        'w_down': nrm((L, D_FF, D_MODEL), D_FF ** -0.5),
    }


def reference(x, c, ctx, c_ctx, norm1_g, norm2_g, w_mod, b_mod, w_in, qn_a, kn_a, qn_d, kn_d, lam_q1, lam_k1, lam_q2, lam_k2, hy_conv_w, hy_conv_b, hy_fw1, hy_fb1, hy_fw2, hy_fb2, hy_fw3, hy_fb3, hy_freq, hy_bias, g_out, w_out, w_up, ffn_conv_w, ffn_conv_b, w_down):
    n_tok = x.shape[1]
    n_rows = n_tok // GRID_W
    rows = jnp.repeat(jnp.arange(n_rows, dtype=jnp.float32), GRID_W)
    cols = jnp.tile(jnp.arange(GRID_W, dtype=jnp.float32), n_rows)
    cos, sin = axial_rope_tables(rows, cols)
    s_lat = jax.nn.silu(c)
    s_ctx = jax.nn.silu(c_ctx)
    for i in range(DEPTH):
        need_ctx = i < DEPTH - 1
        lam_init = 0.8 - 0.6 * math.exp(-0.3 * i)
        lam = (jnp.exp(jnp.sum((lam_q1[i] * lam_k1[i]).astype(jnp.float32)))
               - jnp.exp(jnp.sum((lam_q2[i] * lam_k2[i]).astype(jnp.float32))) + lam_init)
        sh1, sc1, g1, sh2, sc2, g2 = jnp.split((s_lat @ w_mod[i] + b_mod[i])[:, None, :], 6, axis=-1)
        csh1, csc1, cg1, csh2, csc2, cg2 = jnp.split(s_ctx @ w_mod[i] + b_mod[i], 6, axis=-1)
        h = modulate(rms_norm(x, norm1_g[i]), sh1, sc1)
        hc = modulate(rms_norm(ctx, norm1_g[i]), csh1, csc1)
        y, yc = token_mixers(h, hc, cos, sin, lam, lam_init, need_ctx, w_in[i], qn_a[i], kn_a[i], qn_d[i], kn_d[i], hy_conv_w[i], hy_conv_b[i], hy_fw1[i], hy_fb1[i], hy_fw2[i], hy_fb2[i], hy_fw3[i], hy_fb3[i], hy_freq[i], hy_bias[i], g_out[i], w_out[i])
        x = x + g1 * y
        h = modulate(rms_norm(x, norm2_g[i]), sh2, sc2)
        x = x + g2 * conv_glu(h, w_up[i], ffn_conv_w[i], ffn_conv_b[i], w_down[i])
        if need_ctx:
            ctx = ctx + cg1 * yc
            hc = modulate(rms_norm(ctx, norm2_g[i]), csh2, csc2)
            ctx = ctx + cg2 * conv_glu(hc, w_up[i], ffn_conv_w[i], ffn_conv_b[i], w_down[i])
    return x
```

```cpp
#include <hip/hip_runtime.h>
#include <cstdio>
#include <cstdint>
__device__ __forceinline__ int lane_id_v() { int l; asm volatile("v_mbcnt_lo_u32_b32 %0, -1, 0\n\tv_mbcnt_hi_u32_b32 %0, -1, %0" : "=v"(l)); return l; }
namespace pg8 {
#define PG8_LAS __attribute__((address_space(3)))
typedef unsigned short bf16_t;
typedef short bf16x8 __attribute__((ext_vector_type(8)));
typedef float f32x4 __attribute__((ext_vector_type(4)));
typedef unsigned u32x4 __attribute__((ext_vector_type(4)));
constexpr int BM = 256, BK = 64, HALF = 128, HTB = HALF * BK * 2  , STAGE_BYTES = 8 * HTB, NXCD = 8, WGM = 8;

__host__ __device__ __forceinline__ int lds_byte(int r, int c) { const int st = (r >> 4) * 2 + (c >> 5), rr = r & 15, cc = c & 31, ob = rr * 64 + cc * 2; return st * 1024 + (ob ^ (((ob >> 9) & 1) << 5)); }
__host__ __device__ __forceinline__ void stage_rc(int b, int& R, int& C) { const int st = b / 1024, sb = b % 1024, swz = sb ^ (((sb >> 9) & 1) << 5); R = (st >> 1) * 16 + swz / 64; C = (st & 1) * 32 + (swz % 64) / 2; }
__host__ __device__ __forceinline__ int perm32(int rho) { const int n = rho >> 4, i = rho & 15; return 8 * (i >> 2) + 4 * n + (i & 3); }

struct Unit { int pm, pn; };
struct Gemm { const bf16_t* A; const bf16_t* Bt; int M, N, K; };

struct StaticOrder {
    int nM, nN, nwg, G, c;
    __host__ __device__ void init(int M, int N, int G_, int c_) { nM = M / BM; nN = N / BM; nwg = nM * nN; G = G_; c = c_; }
    __host__ __device__ bool next(int i, Unit& u) const {
        const long L = (long)i * G + c; if (L >= nwg) return false;
        int wgid = (int)L; { const int q = nwg / NXCD, r = nwg % NXCD, xcd = wgid % NXCD, off = wgid / NXCD; wgid = (xcd < r ? xcd * (q + 1) : r * (q + 1) + (xcd - r) * q) + off; }
        const int nig = WGM * nN, gid = wgid / nig, fm = gid * WGM, gsz = (nM - fm) < WGM ? (nM - fm) : WGM;
        u.pm = fm + ((wgid % nig) % gsz); u.pn = (wgid % nig) / gsz; return true;
    }
    __device__ __forceinline__ void a_ready(const Unit&) const {}
    __device__ __forceinline__ void done(const Unit&) const {}
};

__device__ __forceinline__ unsigned cvt_pk_bf16(float lo, float hi) { unsigned r; asm volatile("v_cvt_pk_bf16_f32 %0, %1, %2" : "=v"(r) : "v"(lo), "v"(hi)); return r; }
typedef float f32x2 __attribute__((ext_vector_type(2)));
__device__ __forceinline__ f32x2 gelu_pk(f32x2 v) {
    const f32x2 av = __builtin_elementwise_abs(v), d = av * 0.2316418882f + 1.0f;
    f32x2 t; t.x = __builtin_amdgcn_rcpf(d.x); t.y = __builtin_amdgcn_rcpf(d.y);
    f32x2 q = t * 0.5307027145f + (-0.7265760135f); q = q * t + 0.7107068705f; q = q * t + (-0.142248368f); q = q * t + 0.127414796f; q = q * t;
    const f32x2 s = (v * v) * (-0.72134752044f);
    f32x2 e; e.x = __builtin_amdgcn_exp2f(s.x); e.y = __builtin_amdgcn_exp2f(s.y);
    const f32x2 m = v * (q * e), r = v - m;
    f32x2 o; o.x = v.x < 0.f ? m.x : r.x; o.y = v.y < 0.f ? m.y : r.y; return o;
}

template <int ACT  > struct EpiBf16 {
    static constexpr bool PERM = true, AFTER_DRAIN = false; static_assert(ACT == 0 || ACT == 1, "EpiBf16: ACT is 0 (none) or 1 (gelu_pk)");
    bf16_t* O; int ldc; const float* bias; int split_cols; size_t split_stride; float scale0;
    __device__ __forceinline__ void operator()(const f32x4 (&acc)[2][2][4][2], const Unit& u, int wr, int wc, int fr, int fq) const {
        const int row0 = u.pm * BM + wr * 64 + fr; int colt = u.pn * BM; bf16_t* base = O;
        float sc = 1.f; if (split_cols) { const int t = colt / split_cols; base += (size_t)t * split_stride; colt -= t * split_cols; if (t == 0) sc = scale0; }
        const int col0 = colt + wc * 32 + 8 * fq, bcol0 = u.pn * BM + wc * 32 + 8 * fq;
        f32x4 bv[2][2];
#pragma unroll
        for (int bj = 0; bj < 2; ++bj)
#pragma unroll
            for (int n = 0; n < 2; ++n) bv[bj][n] = bias ? *(const f32x4*)(bias + bcol0 + bj * HALF + 4 * n) : (f32x4){0.f, 0.f, 0.f, 0.f};
#pragma unroll
        for (int ai = 0; ai < 2; ++ai)
#pragma unroll
            for (int m = 0; m < 4; ++m) { bf16_t* rowp = base + (size_t)(row0 + ai * HALF + m * 16) * ldc + col0;
#pragma unroll
                for (int bj = 0; bj < 2; ++bj) { f32x4 v0 = acc[ai][bj][m][0] + bv[bj][0], v1 = acc[ai][bj][m][1] + bv[bj][1];
                    if (ACT == 1) { f32x2 a = gelu_pk((f32x2){v0[0], v0[1]}), b = gelu_pk((f32x2){v0[2], v0[3]}), c = gelu_pk((f32x2){v1[0], v1[1]}), d = gelu_pk((f32x2){v1[2], v1[3]});
                        v0 = (f32x4){a.x, a.y, b.x, b.y}; v1 = (f32x4){c.x, c.y, d.x, d.y}; }
                    v0 = v0 * sc; v1 = v1 * sc; u32x4 w; w.x = cvt_pk_bf16(v0[0], v0[1]); w.y = cvt_pk_bf16(v0[2], v0[3]); w.z = cvt_pk_bf16(v1[0], v1[1]); w.w = cvt_pk_bf16(v1[2], v1[3]);
                    *(u32x4*)(rowp + bj * HALF) = w; } }
    }
};
template <class Epi, class Sched, bool ALIGN_EPI = false, bool SP2 = false, bool HALO = false>
__device__ __forceinline__ void gemm_phase(PG8_LAS unsigned char* lds, const Gemm g, const Sched& S, const Epi& E, const int wave0) {
    int tid_o = wave0 * 64 + lane_id_v(); asm volatile("" : "+v"(tid_o));
    const int tid = tid_o, wid = __builtin_amdgcn_readfirstlane(tid >> 6), lane = tid & 63, wr = wid >> 2, wc = wid & 3, fr = lane & 15, fq = lane >> 4;
    const int K = g.K, nt = K / BK;
    unsigned voffA[2], voffB[2];
#pragma unroll
    for (int i = 0; i < 2; ++i) { int R, C; stage_rc(tid * 16 + i * 8192, R, C); const int Rb = Epi::PERM ? ((R & ~31) + perm32(R & 31)) : R;
        voffA[i] = HALO ? (unsigned)(((R & 63) + 62 * (R >> 6)) * K + C) * 2u : (unsigned)(R * K + C) * 2u; voffB[i] = (unsigned)(Rb * K + C) * 2u; }
    const size_t kstep = (size_t)(BK * 2);
    const size_t hstep = (size_t)HALF * K * 2;
    const size_t tstep = 2 * hstep;
    const size_t hstepA = HALO ? (size_t)124 * K * 2 : hstep, tstepA = 2 * hstepA;
    const unsigned ldsw = (unsigned)wid * 1024u;
    const int aoff = lds_byte(wr * 64 + fr, fq * 8), boff = lds_byte(wc * 32 + fr, fq * 8);
#define PG8_SA(b, h) (((b) * 2 + (h)) * HTB)
#define PG8_SB(b, h) ((4 + (b) * 2 + (h)) * HTB)
#define PG8_STAGE(bufoff, gbase, voff) do { _Pragma("unroll") for (int _i = 0; _i < 2; ++_i) \
        __builtin_amdgcn_global_load_lds((const unsigned*)((const char*)(gbase) + (voff)[_i]), (PG8_LAS unsigned*)(lds + (bufoff) + ldsw + _i * 8192), 16, 0, 0); } while (0)
#define PG8_LDA(dst, b, h) do { _Pragma("unroll") for (int m = 0; m < 4; ++m) _Pragma("unroll") for (int k = 0; k < 2; ++k) dst[m][k] = *(const PG8_LAS bf16x8*)(lds + PG8_SA(b, h) + aoff + m * 2048 + k * 1024); } while (0)
#define PG8_LDB(dst, b, h) do { _Pragma("unroll") for (int n = 0; n < 2; ++n) _Pragma("unroll") for (int k = 0; k < 2; ++k) dst[n][k] = *(const PG8_LAS bf16x8*)(lds + PG8_SB(b, h) + boff + n * 2048 + k * 1024); } while (0)
#define PG8_MMA(ai, bj, At, Bt) do { __builtin_amdgcn_s_setprio(1); _Pragma("unroll") for (int m = 0; m < 4; ++m) _Pragma("unroll") for (int n = 0; n < 2; ++n) _Pragma("unroll") for (int k = 0; k < 2; ++k) \
        acc[ai][bj][m][n] = __builtin_amdgcn_mfma_f32_16x16x32_bf16(Bt[n][k], At[m][k], acc[ai][bj][m][n], 0, 0, 0); __builtin_amdgcn_s_setprio(0); } while (0)
#define PG8_WAIT_V(n) asm volatile("s_waitcnt vmcnt(" #n ")" ::: "memory")
#define PG8_WAIT_L(n) asm volatile("s_waitcnt lgkmcnt(" #n ")" ::: "memory")
#define PG8_BAR __builtin_amdgcn_s_barrier()
#define PG8_SCHED __builtin_amdgcn_sched_barrier(0)
    Unit cur, nxt; int ui = 0;
    if (!S.next(0, cur)) return;
    f32x4 acc[2][2][4][2];
#pragma unroll
    for (int a = 0; a < 2; ++a)
#pragma unroll
        for (int b = 0; b < 2; ++b)
#pragma unroll
            for (int m = 0; m < 4; ++m)
#pragma unroll
                for (int n = 0; n < 2; ++n) acc[a][b][m][n] = (f32x4){0.f, 0.f, 0.f, 0.f};
    bf16x8 At[4][2], B0[2][2], B1[2][2];
    const char* cA = (const char*)g.A + (size_t)cur.pm * tstepA; const char* cB = (const char*)g.Bt + (size_t)cur.pn * tstep;
    S.a_ready(cur);
    if constexpr (SP2) {
        PG8_STAGE(PG8_SB(0, 0), cB, voffB); PG8_STAGE(PG8_SB(0, 1), cB + hstep, voffB); PG8_STAGE(PG8_SA(0, 0), cA, voffA); PG8_STAGE(PG8_SA(0, 1), cA + hstepA, voffA);
        if (wr == 1) PG8_BAR;
        PG8_WAIT_V(2); PG8_BAR;
        PG8_STAGE(PG8_SB(1, 0), cB + kstep, voffB); PG8_STAGE(PG8_SA(1, 0), cA + kstep, voffA); PG8_STAGE(PG8_SB(1, 1), cB + hstep + kstep, voffB);
        PG8_WAIT_V(6); PG8_BAR;
    } else {
        PG8_STAGE(PG8_SB(0, 0), cB, voffB); PG8_STAGE(PG8_SA(0, 0), cA, voffA); PG8_STAGE(PG8_SB(0, 1), cB + hstep, voffB); PG8_STAGE(PG8_SA(0, 1), cA + hstepA, voffA);
        if (wr == 1) PG8_BAR;
        PG8_WAIT_V(4); PG8_BAR;
        PG8_STAGE(PG8_SB(1, 0), cB + kstep, voffB); PG8_STAGE(PG8_SA(1, 0), cA + kstep, voffA); PG8_STAGE(PG8_SB(1, 1), cB + hstep + kstep, voffB);
        PG8_WAIT_V(6); PG8_BAR;
    }
    for (;;) {
        const bool has_next = S.next(ui + 1, nxt);
        const char* nA = has_next ? (const char*)g.A + (size_t)nxt.pm * tstepA : cA; const char* nB = has_next ? (const char*)g.Bt + (size_t)nxt.pn * tstep : cB;
        for (int t = 0; t < nt; t += 2) {
            const bool last = (t == nt - 2);
            const char* a1 = cA + (size_t)(t + 1) * kstep;
            const char* a2 = last ? nA : cA + (size_t)(t + 2) * kstep; const char* b2 = last ? nB : cB + (size_t)(t + 2) * kstep;
            const char* a3 = a2 + kstep; const char* b3 = b2 + kstep;
            if (last && has_next) S.a_ready(nxt);
            if constexpr (SP2) {
            PG8_LDB(B0, 0, 0); PG8_LDB(B1, 0, 1); PG8_SCHED; PG8_LDA(At, 0, 0); PG8_STAGE(PG8_SA(1, 1), a1 + hstepA, voffA);
            PG8_WAIT_V(8); PG8_WAIT_L(0); PG8_BAR; PG8_MMA(0, 0, At, B0); PG8_MMA(0, 1, At, B1); PG8_BAR; PG8_SCHED;
            PG8_LDA(At, 0, 1); PG8_STAGE(PG8_SB(0, 0), b2, voffB); PG8_STAGE(PG8_SB(0, 1), b2 + hstep, voffB); PG8_STAGE(PG8_SA(0, 0), a2, voffA);
            PG8_WAIT_V(8); PG8_WAIT_L(0); PG8_BAR; PG8_MMA(1, 0, At, B0); PG8_MMA(1, 1, At, B1); PG8_BAR; PG8_SCHED;
            PG8_LDB(B0, 1, 0); PG8_LDB(B1, 1, 1); PG8_SCHED; PG8_LDA(At, 1, 0); PG8_STAGE(PG8_SA(0, 1), a2 + hstepA, voffA);
            PG8_WAIT_V(8); PG8_WAIT_L(0); PG8_BAR; PG8_MMA(0, 0, At, B0); PG8_MMA(0, 1, At, B1); PG8_BAR; PG8_SCHED;
            PG8_LDA(At, 1, 1); PG8_STAGE(PG8_SB(1, 0), b3, voffB); PG8_STAGE(PG8_SB(1, 1), b3 + hstep, voffB); PG8_STAGE(PG8_SA(1, 0), a3, voffA);
            PG8_WAIT_V(8); PG8_WAIT_L(0); PG8_BAR; PG8_MMA(1, 0, At, B0); PG8_MMA(1, 1, At, B1); PG8_BAR; PG8_SCHED;
            } else {
            PG8_LDB(B0, 0, 0); PG8_SCHED; PG8_LDA(At, 0, 0); PG8_STAGE(PG8_SA(1, 1), a1 + hstepA, voffA);
            PG8_WAIT_L(8); PG8_BAR; PG8_WAIT_L(0); PG8_MMA(0, 0, At, B0); PG8_BAR; PG8_SCHED;
            PG8_LDB(B1, 0, 1); PG8_STAGE(PG8_SB(0, 0), b2, voffB);
            PG8_BAR; PG8_WAIT_L(0); PG8_MMA(0, 1, At, B1); PG8_BAR;
            PG8_LDA(At, 0, 1); PG8_STAGE(PG8_SA(0, 0), a2, voffA);
            PG8_BAR; PG8_WAIT_L(0); PG8_MMA(1, 0, At, B0); PG8_BAR; PG8_SCHED;
            PG8_STAGE(PG8_SB(0, 1), b2 + hstep, voffB);
            PG8_WAIT_V(6); PG8_BAR; PG8_MMA(1, 1, At, B1); PG8_BAR;
            PG8_LDB(B0, 1, 0); PG8_SCHED; PG8_LDA(At, 1, 0); PG8_STAGE(PG8_SA(0, 1), a2 + hstepA, voffA);
            PG8_WAIT_L(8); PG8_BAR; PG8_WAIT_L(0); PG8_MMA(0, 0, At, B0); PG8_BAR; PG8_SCHED;
            PG8_LDB(B1, 1, 1); PG8_STAGE(PG8_SB(1, 0), b3, voffB);
            PG8_BAR; PG8_WAIT_L(0); PG8_MMA(0, 1, At, B1); PG8_BAR;
            PG8_LDA(At, 1, 1); PG8_STAGE(PG8_SA(1, 0), a3, voffA);
            PG8_BAR; PG8_WAIT_L(0); PG8_MMA(1, 0, At, B0); PG8_BAR; PG8_SCHED;
            PG8_STAGE(PG8_SB(1, 1), b3 + hstep, voffB);
            PG8_WAIT_V(6); PG8_BAR; PG8_MMA(1, 1, At, B1); PG8_BAR;
            }
        }
        if constexpr (ALIGN_EPI) { if (wr == 0) PG8_BAR; }
        if constexpr (!Epi::AFTER_DRAIN) { E(acc, cur, wr, wc, fr, fq); S.done(cur); }
        if (!has_next) break;
#pragma unroll
        for (int a = 0; a < 2; ++a)
#pragma unroll
            for (int b = 0; b < 2; ++b)
#pragma unroll
                for (int m = 0; m < 4; ++m)
#pragma unroll
                    for (int n = 0; n < 2; ++n) acc[a][b][m][n] = (f32x4){0.f, 0.f, 0.f, 0.f};
        cur = nxt; cA = nA; cB = nB; ++ui;
        if constexpr (ALIGN_EPI) { if (wr == 1) PG8_BAR; }
    }
    PG8_WAIT_V(0);
    if constexpr (!ALIGN_EPI) { if (wr == 0) PG8_BAR; }
    PG8_BAR;
    if constexpr (Epi::AFTER_DRAIN) { E.fused(acc, cur, wr, wc, fr, fq, lds, wid, lane); S.done(cur); }
#undef PG8_SA
#undef PG8_SB
#undef PG8_STAGE
#undef PG8_LDA
#undef PG8_LDB
#undef PG8_MMA
#undef PG8_WAIT_V
#undef PG8_WAIT_L
#undef PG8_BAR
#undef PG8_SCHED
}
}

#ifndef PG8_SP2
#define PG8_SP2 true
#endif
#ifndef PG8_ALIGN
#define PG8_ALIGN true
#endif
#include <hip/hip_bf16.h>
#include <cmath>
namespace attn_body {
using bf16=__hip_bfloat16;
using bf16x8=__attribute__((ext_vector_type(8)))short;
using s16x4=__attribute__((ext_vector_type(4)))short;
using f32x16=__attribute__((ext_vector_type(16)))float;
using u32x4=__attribute__((ext_vector_type(4)))unsigned;
constexpr int D=64;
constexpr int NW=8,QBLK=32,QB=QBLK*NW,KVBLK=64;
constexpr int ATTN_UNIT_ROWS=QB;
__device__ __forceinline__ int crow(int r,int hi){return (r&3)+8*(r>>2)+4*hi;}
#define SBAR() __builtin_amdgcn_sched_barrier(0)
__device__ __forceinline__ void cmask(f32x16&p0,f32x16&p1,int jb,int qrel,int hi){
  const float NEG=-INFINITY; int kb=64*jb+4*hi;
  #pragma unroll
  for(int r=0;r<16;++r){int kv=kb+(r&3)+8*(r>>2); if(kv>qrel)p0[r]=NEG; if(kv+32>qrel)p1[r]=NEG;}
}

constexpr int NSLOT=3, SLOTB=8192;
constexpr int LDS_K=0, LDS_V=NSLOT*SLOTB, LDS_WS=2*NSLOT*SLOTB, LDS_OST=LDS_WS+NW*64*4, LDS_BYTES=LDS_OST+NW*4096;
constexpr float C2=0.125f*1.4426950408889634f;
__device__ __forceinline__ void glds16(const void*gsrc,unsigned lds_dst){unsigned keep;
  asm volatile("s_mov_b32 %0, m0\n\ts_mov_b32 m0, %2\n\ts_nop 0\n\tglobal_load_lds_dwordx4 %1, off\n\ts_mov_b32 m0, %0":"=&s"(keep):"v"(gsrc),"s"(lds_dst):"memory");}
__device__ __forceinline__ float max3f(float a,float b,float c){float r;asm("v_max3_f32 %0, %1, %2, %3":"=v"(r):"v"(a),"v"(b),"v"(c));return r;}
__device__ __forceinline__ float max2f(float a,float b){float r;asm("v_max_f32_e32 %0, %1, %2":"=v"(r):"v"(a),"v"(b));return r;}
__device__ __forceinline__ float fadd_s(float a,float b){float r;asm("v_add_f32_e32 %0, %1, %2":"=v"(r):"v"(a),"v"(b));return r;}
__device__ __forceinline__ float fsub_s(float a,float b){float r;asm("v_sub_f32_e32 %0, %1, %2":"=v"(r):"v"(a),"v"(b));return r;}
typedef float f32x2_t __attribute__((ext_vector_type(2))); typedef __bf16 bf16x2_t __attribute__((ext_vector_type(2)));
__device__ __forceinline__ unsigned cvtpk_s(float lo,float hi){f32x2_t v={lo,hi};bf16x2_t b=__builtin_convertvector(v,bf16x2_t);return __builtin_bit_cast(unsigned,b);}
#define WAIT_BAR(N) asm volatile("s_waitcnt vmcnt(" #N ") lgkmcnt(0)\n\ts_barrier":::"memory")

__device__ __forceinline__ void qkt(f32x16&p0,f32x16&p1,const char*Kslot,const bf16x8*qr,const f32x16&negm,int r32,int hi){
  const char*kb=Kslot+hi*1024+r32*16;
  #pragma unroll
  for(int d0=0;d0<4;++d0){
    const bf16x8 b0=*reinterpret_cast<const bf16x8*>(kb+d0*2048);
    const bf16x8 b1=*reinterpret_cast<const bf16x8*>(kb+d0*2048+512);
    if(d0==0){p0=__builtin_amdgcn_mfma_f32_32x32x16_bf16(b0,qr[0],negm,0,0,0);p1=__builtin_amdgcn_mfma_f32_32x32x16_bf16(b1,qr[0],negm,0,0,0);}
    else{p0=__builtin_amdgcn_mfma_f32_32x32x16_bf16(b0,qr[d0],p0,0,0,0);p1=__builtin_amdgcn_mfma_f32_32x32x16_bf16(b1,qr[d0],p1,0,0,0);}}
}
typedef __attribute__((address_space(3))) const char* lds_cptr;
typedef short v4i16_t __attribute__((ext_vector_type(4)));
__device__ __forceinline__ void kload8(bf16x8*kf,lds_cptr kp){
  kf[0]=*(const __attribute__((address_space(3))) bf16x8*)(kp);      kf[1]=*(const __attribute__((address_space(3))) bf16x8*)(kp+512);
  kf[2]=*(const __attribute__((address_space(3))) bf16x8*)(kp+2048); kf[3]=*(const __attribute__((address_space(3))) bf16x8*)(kp+2560);
  kf[4]=*(const __attribute__((address_space(3))) bf16x8*)(kp+4096); kf[5]=*(const __attribute__((address_space(3))) bf16x8*)(kp+4608);
  kf[6]=*(const __attribute__((address_space(3))) bf16x8*)(kp+6144); kf[7]=*(const __attribute__((address_space(3))) bf16x8*)(kp+6656);
}
__device__ __forceinline__ void kload2(bf16x8*kf,lds_cptr kp,int j){ kf[2*j]=*(const __attribute__((address_space(3))) bf16x8*)(kp+j*2048); kf[2*j+1]=*(const __attribute__((address_space(3))) bf16x8*)(kp+j*2048+512); }
__device__ __forceinline__ s16x4 vtr(lds_cptr p){ return __builtin_bit_cast(s16x4,__builtin_amdgcn_ds_read_tr16_b64_v4i16((__attribute__((address_space(3))) v4i16_t*)p)); }
__device__ __forceinline__ float rowmax(const f32x16&p0,const f32x16&p1){
  float a=max3f(p0[0],p0[1],p1[0]),b=max3f(p0[2],p0[3],p1[1]);a=max3f(a,p1[2],p1[3]);
  #pragma unroll
  for(int r=4;r<16;r+=4){a=max3f(a,p0[r],p0[r+1]);b=max3f(b,p0[r+2],p0[r+3]);a=max3f(a,p1[r],p1[r+1]);b=max3f(b,p1[r+2],p1[r+3]);}
  const float m=max2f(a,b);
  auto rr=__builtin_amdgcn_permlane32_swap(__float_as_uint(m),__float_as_uint(m),false,false);
  return max2f(__uint_as_float(rr[0]),__uint_as_float(rr[1]));
}
__device__ __forceinline__ void pv(f32x16*o,int vb,bf16x8 pa0,bf16x8 pa1,bf16x8 pa2,bf16x8 pa3){
  #pragma unroll
  for(int d0=0;d0<2;++d0){s16x4 lo[4],hi[4];
    #pragma unroll
    for(int ks=0;ks<4;++ks){
      asm volatile("ds_read_b64_tr_b16 %0,%1 offset:%c2":"=&v"(lo[ks]):"v"(vb),"i"(d0*4096+ks*1024):"memory");
      asm volatile("ds_read_b64_tr_b16 %0,%1 offset:%c2":"=&v"(hi[ks]):"v"(vb),"i"(d0*4096+ks*1024+512):"memory");}
    asm volatile("s_waitcnt lgkmcnt(0)":::"memory");SBAR();
    #define PK(k) (bf16x8){lo[k][0],lo[k][1],lo[k][2],lo[k][3],hi[k][0],hi[k][1],hi[k][2],hi[k][3]}
    o[d0]=__builtin_amdgcn_mfma_f32_32x32x16_bf16(pa0,PK(0),o[d0],0,0,0);
    o[d0]=__builtin_amdgcn_mfma_f32_32x32x16_bf16(pa1,PK(1),o[d0],0,0,0);
    o[d0]=__builtin_amdgcn_mfma_f32_32x32x16_bf16(pa2,PK(2),o[d0],0,0,0);
    o[d0]=__builtin_amdgcn_mfma_f32_32x32x16_bf16(pa3,PK(3),o[d0],0,0,0);
    #undef PK
  }
}

#ifndef ATTN_STORE16
#define ATTN_STORE16(p,v) (*(u32x4*)(p)=(v))
#endif
template<int THRL,bool DV128,int PQ,int PK,int PV,int PO> __device__ __forceinline__ void attn_unit(const bf16*Qb,const bf16*__restrict__ Kb,const bf16*__restrict__ Vb,bf16*Ob,const int NT,char*shm,const int wave0){
  int tid_o=wave0*64+lane_id_v(); asm volatile("":"+v"(tid_o)); const int tid=tid_o,lane=tid&63,r32=lane&31,hi=lane>>5; const int wid=__builtin_amdgcn_readfirstlane(tid>>6);
  const bf16*Qw=Qb+(long)(wid*QBLK)*PQ;
  const bf16*Kh=Kb,*Vh=Vb;
  const unsigned lds0=(unsigned)(uintptr_t)shm;
  constexpr int VS=DV128?2:1, L_WS=LDS_V+NSLOT*SLOTB*VS, L_OST=L_WS+NW*64*4;
  float*wsf=(float*)(shm+L_WS)+wid*64;
  const bf16*ksrc=Kh+(long)lane*PK+wid*8;
  const bf16*vsrc=Vh+(long)(16*(wid&3)+(lane>>2))*PV+(wid>>2)*32+(lane&3)*8;
  const unsigned kdst=lds0+LDS_K+wid*1024, vdst=lds0+LDS_V+wid*1024;
  #define DMA_K(t,slot) glds16(ksrc+(long)(t)*KVBLK*PK,(unsigned)__builtin_amdgcn_readfirstlane(kdst+(slot)))
  #define DMA_V(t,slot) do{ glds16(vsrc+(long)(t)*KVBLK*PV,(unsigned)__builtin_amdgcn_readfirstlane(vdst+VS*(slot))); if constexpr(DV128){ glds16(vsrc+64+(long)(t)*KVBLK*PV,(unsigned)__builtin_amdgcn_readfirstlane(vdst+VS*(slot)+8192)); } }while(0)
  const char*Kbase=shm+LDS_K; bf16x8 kf[8];
  const lds_cptr shm3=(lds_cptr)shm; const lds_cptr kp0=shm3+LDS_K+hi*1024+r32*16; const lds_cptr vp0=shm3+LDS_V+((lane>>4)&1)*32+(lane&3)*8+(4*hi+((lane&15)>>2))*64;
  DMA_K(0,0);DMA_V(0,0);DMA_K(1,SLOTB);
  bf16x8 qr[4];
  #pragma unroll
  for(int d0=0;d0<4;++d0)qr[d0]=*reinterpret_cast<const bf16x8*>(&Qw[(long)r32*PQ+d0*16+hi*8]);
  float mhat=0.f,l_reg=0.f;f32x16 o[4];o[0]=f32x16{};o[1]=f32x16{};o[2]=f32x16{};o[3]=f32x16{};f32x16 negm=f32x16{};asm volatile("":"+v"(negm));
  #define CMASK(P0,P1,t) do{}while(0)
  bool resc=false;
  #define START(P0,P1) do{ const float rm=rowmax(P0,P1); resc=false; \
    { const float dl=rm; mhat=fadd_s(mhat,dl); \
      _Pragma("unroll") for(int r=0;r<16;++r){P0[r]=fsub_s(P0[r],dl);P1[r]=fsub_s(P1[r],dl);} \
      _Pragma("unroll") for(int r=0;r<16;++r)negm[r]=-mhat; asm volatile("":"+v"(negm)); } \
    _Pragma("unroll") for(int r=0;r<16;++r)P0[r]=__builtin_amdgcn_exp2f(P0[r]); }while(0)
  #define RESC() do{ if(resc){ asm volatile("s_waitcnt lgkmcnt(0)":::"memory"); \
      _Pragma("unroll") for(int d_=0;d_<2*VS;++d_) _Pragma("unroll") for(int r=0;r<16;++r)o[d_][r]*=wsf[crow(r,hi)]; } }while(0)
  f32x16 pA0,pA1,pB0,pB1;
  int sl_prev=0,sl_cur=0,sl_next=SLOTB;
  #define ROT() do{sl_prev=sl_cur;sl_cur=sl_next;sl_next=(sl_next==(NSLOT-1)*SLOTB)?0:sl_next+SLOTB;}while(0)
  DMA_K(2,2*SLOTB);
  WAIT_BAR(3);
  qkt(pA0,pA1,Kbase,qr,negm,r32,hi);asm volatile("s_nop 15\n\ts_nop 7":"+v"(pA0),"+v"(pA1));CMASK(pA0,pA1,0);
  START(pA0,pA1);
  _Pragma("unroll") for(int r=0;r<16;++r)pA1[r]=__builtin_amdgcn_exp2f(pA1[r]);
  WAIT_BAR(0);
  DMA_K(3,0);DMA_V(1,SLOTB);
  ROT();
  kload8(kf,kp0+sl_cur);
  #define WB2() do{ if constexpr(DV128){WAIT_BAR(3);}else{WAIT_BAR(2);} }while(0)
  #define WB1() do{ if constexpr(DV128){WAIT_BAR(2);}else{WAIT_BAR(1);} }while(0)
  WB2();
  s16x4 vlo[8],vhi[8]; u32x4 pw0,pw1,pw2,pw3;
  #define PKW(P,B) cvtpk_s(P[B],P[B+1])
  #define PAF(k) __builtin_bit_cast(bf16x8,pw##k)
  #define VFR(i) (bf16x8){vlo[i][0],vlo[i][1],vlo[i][2],vlo[i][3],vhi[i][0],vhi[i][1],vhi[i][2],vhi[i][3]}
  #define PIN(x) asm volatile("":"+v"(x))
  #define MX3(a,b,c) __builtin_fmaxf(__builtin_fmaxf((a),(b)),(c))
  #define GAPA(MF,A0,A1,A2,A3,W0,W1,PW) do{ MF; sacc+=A0; sacc+=A1; sacc+=A2; sacc+=A3; PIN(sacc); W0; W1; PIN(PW); SBAR(); }while(0)
  #define EX(v) __builtin_amdgcn_exp2f(v)
  #define GAPC(MF,X,B) do{ MF; X[B]=EX(X[B]); X[B+1]=EX(X[B+1]); PIN(X); SBAR(); }while(0)
  #define GAPB(MF,X,B) do{ MF; X[B]=EX(X[B]); X[B+1]=EX(X[B+1]); X[B+2]=EX(X[B+2]); X[B+3]=EX(X[B+3]); PIN(X); SBAR(); }while(0)
  #define VRD(i) do{ vlo[i]=vtr(vp_+(((i)>>2)*4096+((i)&3)*1024)); vhi[i]=vtr(vp_+(((i)>>2)*4096+((i)&3)*1024+512)); }while(0)
  #define KRD(G,j) do{ if(G){ kload2(kf,kp0+sl_next,j); SBAR(); } }while(0)
  #define STEP(C0,C1,P0,P1,t,GK,GV,GL) do{ SBAR(); \
    const lds_cptr vp_=vp0+VS*sl_prev; \
    VRD(0); SBAR(); float sacc=(P0[0]+P0[1]); \
    GAPA(C0=__builtin_amdgcn_mfma_f32_32x32x16_bf16(kf[0],qr[0],negm,0,0,0), P0[2],P0[3],P0[4],P0[5],     pw0[0]=PKW(P0,0), pw0[1]=PKW(P0,2), pw0); \
    VRD(4); SBAR(); GAPA(C1=__builtin_amdgcn_mfma_f32_32x32x16_bf16(kf[1],qr[0],negm,0,0,0), P0[6],P0[7],P0[8],P0[9],     pw0[2]=PKW(P0,4), pw0[3]=PKW(P0,6), pw0); \
    VRD(1); SBAR(); GAPA(C0=__builtin_amdgcn_mfma_f32_32x32x16_bf16(kf[2],qr[1],C0,0,0,0),   P0[10],P0[11],P0[12],P0[13], pw1[0]=PKW(P0,8), pw1[1]=PKW(P0,10), pw1); \
    VRD(5); SBAR(); GAPA(C1=__builtin_amdgcn_mfma_f32_32x32x16_bf16(kf[3],qr[1],C1,0,0,0),   P0[14],P0[15],P1[0],P1[1],   pw1[2]=PKW(P0,12),pw1[3]=PKW(P0,14), pw1); \
    VRD(2); SBAR(); GAPA(C0=__builtin_amdgcn_mfma_f32_32x32x16_bf16(kf[4],qr[2],C0,0,0,0),   P1[2],P1[3],P1[4],P1[5],     pw2[0]=PKW(P1,0), pw2[1]=PKW(P1,2), pw2); \
    VRD(6); SBAR(); GAPA(C1=__builtin_amdgcn_mfma_f32_32x32x16_bf16(kf[5],qr[2],C1,0,0,0),   P1[6],P1[7],P1[8],P1[9],     pw2[2]=PKW(P1,4), pw2[3]=PKW(P1,6), pw2); \
    VRD(3); SBAR(); GAPA(C0=__builtin_amdgcn_mfma_f32_32x32x16_bf16(kf[6],qr[3],C0,0,0,0),   P1[10],P1[11],P1[12],P1[13], pw3[0]=PKW(P1,8), pw3[1]=PKW(P1,10), pw3); \
    VRD(7); SBAR(); GAPA(C1=__builtin_amdgcn_mfma_f32_32x32x16_bf16(kf[7],qr[3],C1,0,0,0),   P1[14],P1[15],0.f,0.f,       pw3[2]=PKW(P1,12),pw3[3]=PKW(P1,14), pw3); \
    l_reg+=sacc; \
    if(GK){DMA_K((t)+3,sl_cur);} if(GV){DMA_V((t)+1,sl_next);} \
    CMASK(C0,C1,t); \
    { float a=MX3(C0[0],C0[1],C1[0]),b=MX3(C0[2],C0[3],C1[1]); a=MX3(a,C1[2],C1[3]); \
      _Pragma("unroll") for(int r=4;r<16;r+=4){a=MX3(a,C0[r],C0[r+1]);b=MX3(b,C0[r+2],C0[r+3]);a=MX3(a,C1[r],C1[r+1]);b=MX3(b,C1[r+2],C1[r+3]);} \
      float rm=__builtin_fmaxf(a,b); { auto rr=__builtin_amdgcn_permlane32_swap(__float_as_uint(rm),__float_as_uint(rm),false,false); rm=__builtin_fmaxf(__uint_as_float(rr[0]),__uint_as_float(rr[1])); } \
      resc=false; \
      if(__builtin_expect(__any(rm>(float)THRL),0)){ const float dl=__builtin_fmaxf(rm,0.f); mhat+=dl; \
        _Pragma("unroll") for(int r=0;r<16;++r){C0[r]-=dl;C1[r]-=dl;} \
        _Pragma("unroll") for(int r=0;r<16;++r)negm[r]=-mhat; asm volatile("":"+v"(negm)); \
        const float f=__builtin_amdgcn_exp2f(-dl); l_reg*=f; if(hi==0)wsf[r32]=f; resc=true; } } \
    SBAR(); \
    GAPB(o[0]=__builtin_amdgcn_mfma_f32_32x32x16_bf16(PAF(0),VFR(0),o[0],0,0,0), C0,0); \
    GAPB(o[1]=__builtin_amdgcn_mfma_f32_32x32x16_bf16(PAF(0),VFR(4),o[1],0,0,0), C0,4); \
    KRD(GL,0); GAPB(o[0]=__builtin_amdgcn_mfma_f32_32x32x16_bf16(PAF(1),VFR(1),o[0],0,0,0), C0,8); \
    KRD(GL,1); GAPB(o[1]=__builtin_amdgcn_mfma_f32_32x32x16_bf16(PAF(1),VFR(5),o[1],0,0,0), C0,12); \
    KRD(GL,2); GAPB(o[0]=__builtin_amdgcn_mfma_f32_32x32x16_bf16(PAF(2),VFR(2),o[0],0,0,0), C1,0); \
    KRD(GL,3); GAPB(o[1]=__builtin_amdgcn_mfma_f32_32x32x16_bf16(PAF(2),VFR(6),o[1],0,0,0), C1,4); \
    GAPB(o[0]=__builtin_amdgcn_mfma_f32_32x32x16_bf16(PAF(3),VFR(3),o[0],0,0,0), C1,8); \
    GAPB(o[1]=__builtin_amdgcn_mfma_f32_32x32x16_bf16(PAF(3),VFR(7),o[1],0,0,0), C1,12); \
    }while(0)
  #define VRD2(i) do{ vlo[i]=vtr(vp_+(8192+((i)>>2)*4096+((i)&3)*1024)); vhi[i]=vtr(vp_+(8192+((i)>>2)*4096+((i)&3)*1024+512)); }while(0)
  #define STEP128(C0,C1,P0,P1,t,GK,GV,GL) do{ SBAR(); \
    const lds_cptr vp_=vp0+VS*sl_prev; \
    float sacc=(P0[0]+P0[1]); \
    GAPA(C0=__builtin_amdgcn_mfma_f32_32x32x16_bf16(kf[0],qr[0],negm,0,0,0), P0[2],P0[3],P0[4],P0[5],     pw0[0]=PKW(P0,0), pw0[1]=PKW(P0,2), pw0); \
    GAPA(C1=__builtin_amdgcn_mfma_f32_32x32x16_bf16(kf[1],qr[0],negm,0,0,0), P0[6],P0[7],P0[8],P0[9],     pw0[2]=PKW(P0,4), pw0[3]=PKW(P0,6), pw0); \
    GAPA(C0=__builtin_amdgcn_mfma_f32_32x32x16_bf16(kf[2],qr[1],C0,0,0,0),   P0[10],P0[11],P0[12],P0[13], pw1[0]=PKW(P0,8), pw1[1]=PKW(P0,10), pw1); \
    GAPA(C1=__builtin_amdgcn_mfma_f32_32x32x16_bf16(kf[3],qr[1],C1,0,0,0),   P0[14],P0[15],P1[0],P1[1],   pw1[2]=PKW(P0,12),pw1[3]=PKW(P0,14), pw1); \
    GAPA(C0=__builtin_amdgcn_mfma_f32_32x32x16_bf16(kf[4],qr[2],C0,0,0,0),   P1[2],P1[3],P1[4],P1[5],     pw2[0]=PKW(P1,0), pw2[1]=PKW(P1,2), pw2); \
    GAPA(C1=__builtin_amdgcn_mfma_f32_32x32x16_bf16(kf[5],qr[2],C1,0,0,0),   P1[6],P1[7],P1[8],P1[9],     pw2[2]=PKW(P1,4), pw2[3]=PKW(P1,6), pw2); \
    GAPA(C0=__builtin_amdgcn_mfma_f32_32x32x16_bf16(kf[6],qr[3],C0,0,0,0),   P1[10],P1[11],P1[12],P1[13], pw3[0]=PKW(P1,8), pw3[1]=PKW(P1,10), pw3); \
    GAPA(C1=__builtin_amdgcn_mfma_f32_32x32x16_bf16(kf[7],qr[3],C1,0,0,0),   P1[14],P1[15],0.f,0.f,       pw3[2]=PKW(P1,12),pw3[3]=PKW(P1,14), pw3); \
    l_reg+=sacc; \
    if(GK){DMA_K((t)+3,sl_cur);} if(GV){DMA_V((t)+1,sl_next);} \
    CMASK(C0,C1,t); \
    { float a=MX3(C0[0],C0[1],C1[0]),b=MX3(C0[2],C0[3],C1[1]); a=MX3(a,C1[2],C1[3]); \
      _Pragma("unroll") for(int r=4;r<16;r+=4){a=MX3(a,C0[r],C0[r+1]);b=MX3(b,C0[r+2],C0[r+3]);a=MX3(a,C1[r],C1[r+1]);b=MX3(b,C1[r+2],C1[r+3]);} \
      float rm=__builtin_fmaxf(a,b); { auto rr=__builtin_amdgcn_permlane32_swap(__float_as_uint(rm),__float_as_uint(rm),false,false); rm=__builtin_fmaxf(__uint_as_float(rr[0]),__uint_as_float(rr[1])); } \
      resc=false; \
      if(__builtin_expect(__any(rm>(float)THRL),0)){ const float dl=__builtin_fmaxf(rm,0.f); mhat+=dl; \
        _Pragma("unroll") for(int r=0;r<16;++r){C0[r]-=dl;C1[r]-=dl;} \
        _Pragma("unroll") for(int r=0;r<16;++r)negm[r]=-mhat; asm volatile("":"+v"(negm)); \
        const float f=__builtin_amdgcn_exp2f(-dl); l_reg*=f; if(hi==0)wsf[r32]=f; resc=true; } } \
    SBAR(); \
    VRD(0); VRD(4); VRD(1); VRD(5); SBAR(); \
    GAPC(o[0]=__builtin_amdgcn_mfma_f32_32x32x16_bf16(PAF(0),VFR(0),o[0],0,0,0), C0,0); VRD(2); SBAR(); \
    GAPC(o[1]=__builtin_amdgcn_mfma_f32_32x32x16_bf16(PAF(0),VFR(4),o[1],0,0,0), C0,2); VRD(6); SBAR(); \
    KRD(GL,0); GAPC(o[0]=__builtin_amdgcn_mfma_f32_32x32x16_bf16(PAF(1),VFR(1),o[0],0,0,0), C0,4); VRD(3); SBAR(); \
    KRD(GL,1); GAPC(o[1]=__builtin_amdgcn_mfma_f32_32x32x16_bf16(PAF(1),VFR(5),o[1],0,0,0), C0,6); VRD(7); SBAR(); \
    KRD(GL,2); GAPC(o[0]=__builtin_amdgcn_mfma_f32_32x32x16_bf16(PAF(2),VFR(2),o[0],0,0,0), C0,8); VRD2(0); SBAR(); \
    KRD(GL,3); GAPC(o[1]=__builtin_amdgcn_mfma_f32_32x32x16_bf16(PAF(2),VFR(6),o[1],0,0,0), C0,10); VRD2(4); SBAR(); \
    GAPC(o[0]=__builtin_amdgcn_mfma_f32_32x32x16_bf16(PAF(3),VFR(3),o[0],0,0,0), C0,12); VRD2(1); SBAR(); \
    GAPC(o[1]=__builtin_amdgcn_mfma_f32_32x32x16_bf16(PAF(3),VFR(7),o[1],0,0,0), C0,14); VRD2(5); SBAR(); \
    GAPC(o[2]=__builtin_amdgcn_mfma_f32_32x32x16_bf16(PAF(0),VFR(0),o[2],0,0,0), C1,0); VRD2(2); SBAR(); \
    GAPC(o[3]=__builtin_amdgcn_mfma_f32_32x32x16_bf16(PAF(0),VFR(4),o[3],0,0,0), C1,2); VRD2(6); SBAR(); \
    GAPC(o[2]=__builtin_amdgcn_mfma_f32_32x32x16_bf16(PAF(1),VFR(1),o[2],0,0,0), C1,4); VRD2(3); SBAR(); \
    GAPC(o[3]=__builtin_amdgcn_mfma_f32_32x32x16_bf16(PAF(1),VFR(5),o[3],0,0,0), C1,6); VRD2(7); SBAR(); \
    GAPC(o[2]=__builtin_amdgcn_mfma_f32_32x32x16_bf16(PAF(2),VFR(2),o[2],0,0,0), C1,8); \
    GAPC(o[3]=__builtin_amdgcn_mfma_f32_32x32x16_bf16(PAF(2),VFR(6),o[3],0,0,0), C1,10); \
    GAPC(o[2]=__builtin_amdgcn_mfma_f32_32x32x16_bf16(PAF(3),VFR(3),o[2],0,0,0), C1,12); \
    GAPC(o[3]=__builtin_amdgcn_mfma_f32_32x32x16_bf16(PAF(3),VFR(7),o[3],0,0,0), C1,14); \
    }while(0)
  #define STEPX(...) do{ if constexpr(DV128){ STEP128(__VA_ARGS__); } else { STEP(__VA_ARGS__); } }while(0)
  int t=1;
  #undef CMASK
  #define CMASK(P0,P1,t) do{}while(0)
  for(;t+5<NT;t+=2){
    STEPX(pB0,pB1,pA0,pA1,t,true,true,true);     WB2(); RESC(); ROT();
    STEPX(pA0,pA1,pB0,pB1,t+1,true,true,true);   WB2(); RESC(); ROT();
  }
  #undef CMASK
  #define CMASK(P0,P1,t) do{}while(0)
  #define ENDW(tt) do{ if((tt)+3<NT){WB2();} else if((tt)+2<NT){WB1();} else {WAIT_BAR(0);} }while(0)
  for(;t+1<NT;t+=2){
    STEPX(pB0,pB1,pA0,pA1,t,(t+3<NT),(t+1<NT),(t+1<NT));       ENDW(t);   RESC(); ROT();
    STEPX(pA0,pA1,pB0,pB1,t+1,(t+4<NT),(t+2<NT),(t+2<NT));     ENDW(t+1); RESC(); ROT();
  }
  STEPX(pB0,pB1,pA0,pA1,NT-1,false,false,false); RESC();
  { float sacc=pB0[0]+pB0[1]; _Pragma("unroll") for(int r=2;r<16;++r)sacc+=pB0[r]; _Pragma("unroll") for(int r=0;r<16;++r)sacc+=pB1[r]; l_reg+=sacc;
    pw0=(u32x4){PKW(pB0,0),PKW(pB0,2),PKW(pB0,4),PKW(pB0,6)};pw1=(u32x4){PKW(pB0,8),PKW(pB0,10),PKW(pB0,12),PKW(pB0,14)};pw2=(u32x4){PKW(pB1,0),PKW(pB1,2),PKW(pB1,4),PKW(pB1,6)};pw3=(u32x4){PKW(pB1,8),PKW(pB1,10),PKW(pB1,12),PKW(pB1,14)};
    int lane_d=lane; asm volatile("":"+v"(lane_d)); const int vb0=(int)(lds0+LDS_V)+((lane_d>>4)&1)*32+(lane_d&3)*8+(4*(lane_d>>5)+((lane_d&15)>>2))*64;
    SBAR(); pv(o,vb0+VS*sl_cur,PAF(0),PAF(1),PAF(2),PAF(3)); if constexpr(DV128){ pv(o+2,vb0+VS*sl_cur+8192,PAF(0),PAF(1),PAF(2),PAF(3)); } }
  #undef PKW
  #undef PAF
  #undef VFR
  #undef PIN
  #undef MX3
  #undef GAPA
  #undef GAPB
  #undef GAPC
  #undef EX
  #undef VRD
  #undef KRD
  #undef STEP
  #undef STEP128
  #undef STEPX
  #undef VRD2
  #undef WB2
  #undef WB1
  #undef ENDW
  {auto rr=__builtin_amdgcn_permlane32_swap(__float_as_uint(l_reg),__float_as_uint(l_reg),false,false);l_reg=__uint_as_float(rr[0])+__uint_as_float(rr[1]);}
  if(hi==0)wsf[32+r32]=l_reg;asm volatile("s_waitcnt lgkmcnt(0)":::"memory");
  float rli[16];
  #pragma unroll
  for(int r=0;r<16;++r)rli[r]=__builtin_amdgcn_rcpf(wsf[32+crow(r,hi)]);
  bf16*Ow=Ob+(long)(wid*QBLK)*PO;
  { bf16*stg=(bf16*)(shm+L_OST)+wid*2048;
    #pragma unroll
    for(int hf=0;hf<VS;++hf){
      #pragma unroll
      for(int r=0;r<16;++r){const int orow=crow(r,hi);
        #pragma unroll
        for(int d0=0;d0<2;++d0)stg[orow*64+d0*32+r32]=__float2bfloat16(o[2*hf+d0][r]*rli[r]);}
      asm volatile("s_waitcnt lgkmcnt(0)":::"memory");
      #pragma unroll
      for(int i=0;i<4;++i){const int row=i*8+(lane>>3),ch=lane&7; const u32x4 v=*(const u32x4*)(stg+row*64+ch*8); ATTN_STORE16(Ow+(long)row*PO+hf*64+ch*8,v);}
      asm volatile("s_waitcnt lgkmcnt(0)":::"memory"); } }
  asm volatile("s_waitcnt lgkmcnt(0)\n\ts_barrier":::"memory");
  #undef DMA_K
  #undef DMA_V
  #undef CMASK
  #undef START
  #undef RESC
  #undef ROT
}
constexpr int ATTN_LDS_BYTES=LDS_BYTES;
#undef SBAR
#undef WAIT_BAR
}
#include <hip/hip_cooperative_groups.h>
namespace cg = cooperative_groups;
#define LAS __attribute__((address_space(3)))
typedef unsigned short bf16_t;
typedef unsigned v4u __attribute__((ext_vector_type(4)));
typedef unsigned v2u __attribute__((ext_vector_type(2)));
typedef float f32x4 __attribute__((ext_vector_type(4)));
typedef float cf __attribute__((ext_vector_type(2)));

constexpr int NTHR = 512;
constexpr int DMOD = 1024, NBATCH = 4, SEQ = 8192, CTXL = 256, DEPTH = 4;
constexpr int ML = NBATCH * SEQ, MC = NBATCH * CTXL, MT = ML + MC;
constexpr int INW = 2816, DFF = 2816, NKEY = SEQ + CTXL;
constexpr float EPSF = 1e-6f;
constexpr int FFTN = 16384;

constexpr size_t MiB = 1u << 20;
constexpr size_t WS_MOD = 1 * MiB;
constexpr size_t WS_LAM = 1 * MiB + 512 * 1024;
constexpr size_t WS_ROPE = WS_LAM + 256;
constexpr size_t WS_TW = 1 * MiB + 768 * 1024;
constexpr size_t WS_WIN = 2 * MiB, WS_WOUT = WS_WIN + (size_t)INW * 1024 * 2, WS_WUP = WS_WOUT + 2 * MiB, WS_WDN = WS_WUP + (size_t)2 * DFF * 1024 * 2;
constexpr size_t WS_CTXX = 26 * MiB;
constexpr size_t WS_FILT = 30 * MiB, WS_FILTC = 62 * MiB;
constexpr size_t WS_H = 64 * MiB;
constexpr size_t WS_KF = 64 * MiB;
constexpr size_t WS_RAW = 130 * MiB;
constexpr size_t WS_YRAW = 130 * MiB;
constexpr size_t WS_YH = 213 * MiB, WS_YHC = 245 * MiB;
constexpr size_t WS_QA = 312 * MiB, WS_KA = 329 * MiB, WS_VA = 338 * MiB, WS_QD = 347 * MiB, WS_KD = 380 * MiB, WS_VD = 413 * MiB;
constexpr size_t WS_HYR = 446 * MiB, WS_HYRC = 494 * MiB;
constexpr size_t WS_G = 130 * MiB;
constexpr size_t WS_END = 496 * MiB;
static_assert(WS_WDN + (size_t)DFF * 1024 * 2 <= WS_CTXX, "weights");
static_assert(WS_H + (size_t)MT * 1024 * 2 <= WS_RAW && WS_RAW + (size_t)MT * INW * 2 <= WS_QA, "map1");
static_assert(WS_YRAW + (size_t)MT * 1280 * 2 <= WS_YH && WS_G + (size_t)MT * DFF * 2 <= WS_QA, "map2");
constexpr int LDS_BYTES = 147456;
#ifndef PHM
#define PHM 0xffff
#endif
#define PH(b) ((PHM >> (b)) & 1)
#ifndef REP_ATT
#define REP_ATT 1
#endif
#ifndef REP_HY
#define REP_HY 1
#endif
#ifndef REP_GEMM
#define REP_GEMM 1
#endif
#ifndef REP_PREP
#define REP_PREP 1
#endif
#ifndef REP_PP
#define REP_PP 1
#endif
#ifndef REP_MERGE
#define REP_MERGE 1
#endif
#ifndef REP_N2
#define REP_N2 1
#endif
#ifndef REP_GLU
#define REP_GLU 1
#endif
#ifndef REP_GEMM2
#define REP_GEMM2 1
#endif
#ifndef REP_PRO
#define REP_PRO 1
#endif
#ifndef PROBE_PLAIN_LAUNCH
#define PROBE_PLAIN_LAUNCH 0
#endif
#ifndef EXTRA_SYNC
#define EXTRA_SYNC 0
#endif

__device__ __forceinline__ unsigned f2bf(float f) { unsigned u = __builtin_bit_cast(unsigned, f); return (u + 0x7fffu + ((u >> 16) & 1u)) >> 16; }
__device__ __forceinline__ unsigned pk2(float lo, float hi) { return f2bf(lo) | (f2bf(hi) << 16); }
__device__ __forceinline__ float bf2f(bf16_t u) { return __uint_as_float((unsigned)u << 16); }
__device__ __forceinline__ float bflo(unsigned w) { return __uint_as_float(w << 16); }
__device__ __forceinline__ float bfhi(unsigned w) { return __uint_as_float(w & 0xffff0000u); }
__device__ __forceinline__ float shx(float v, int m, int lane) { return __builtin_bit_cast(float, __builtin_amdgcn_ds_bpermute((lane ^ m) << 2, __builtin_bit_cast(int, v))); }
__device__ __forceinline__ float wave_sum(float v) {
    const int lane = lane_id_v();
#pragma unroll
    for (int o = 1; o < 64; o <<= 1) v += shx(v, o, lane);
    return v;
}
__device__ __forceinline__ float block_sum(float v, LAS float* RED, int tid) {
    v = wave_sum(v); __syncthreads(); if ((tid & 63) == 0) RED[tid >> 6] = v; __syncthreads();
    float s = 0.f;
#pragma unroll
    for (int w = 0; w < 8; ++w) s += RED[w];
    return s;
}

struct EpiGateRes {
    static constexpr bool PERM = false, AFTER_DRAIN = false;
    const float* base_lat; float* out_lat; const float* base_ctx; float* out_ctx; const float* gate; int row_off;
    __device__ __forceinline__ void operator()(const pg8::f32x4 (&acc)[2][2][4][2], const pg8::Unit& u, int wr, int wc, int fr, int fq) const {
        const int col0 = u.pn * 256 + wc * 32 + 4 * fq;
#pragma unroll
        for (int ai = 0; ai < 2; ++ai)
#pragma unroll
            for (int m = 0; m < 4; ++m) {
                const int r = row_off + u.pm * 256 + ai * 128 + wr * 64 + m * 16 + fr;
                const bool lat = r < ML; const int bi = lat ? (r >> 13) : 4;
                const size_t off = lat ? (size_t)r * 1024 : (size_t)(r - ML) * 1024;
                const float* bp = (lat ? base_lat : base_ctx) + off + col0; float* op = (lat ? out_lat : out_ctx) + off + col0;
                const float* gp = gate + bi * 6144 + col0;
#pragma unroll
                for (int bj = 0; bj < 2; ++bj)
#pragma unroll
                    for (int n = 0; n < 2; ++n) {
                        const pg8::f32x4 g4 = *(const pg8::f32x4*)(gp + bj * 128 + n * 16), b4 = *(const pg8::f32x4*)(bp + bj * 128 + n * 16);
                        *(pg8::f32x4*)(op + bj * 128 + n * 16) = b4 + g4 * acc[ai][bj][m][n];
                    }
            }
    }
};

__device__ __forceinline__ float dpp_ror1(float v) { return __builtin_bit_cast(float, __builtin_amdgcn_update_dpp(0, __builtin_bit_cast(int, v), 0x121, 0xF, 0xF, false)); }
__device__ __forceinline__ float dpp_rol1(float v) { return __builtin_bit_cast(float, __builtin_amdgcn_update_dpp(0, __builtin_bit_cast(int, v), 0x12F, 0xF, 0xF, false)); }
struct EpiGlu {
    static constexpr bool PERM = true, AFTER_DRAIN = false;
    bf16_t* G; const float* cw; const float* cb; int nrows;
    __device__ __forceinline__ void operator()(const pg8::f32x4 (&acc)[2][2][4][2], const pg8::Unit& u, int wr, int wc, int fr, int fq) const {
        const int ch0 = u.pn * 128 + wc * 32 + 8 * fq;
        float w0[8], w1[8], w2[8], bb[8];
#pragma unroll
        for (int hq = 0; hq < 2; ++hq) { const pg8::f32x4 q0 = *(const pg8::f32x4*)(cw + ch0 + 4 * hq), q1 = *(const pg8::f32x4*)(cw + DFF + ch0 + 4 * hq), q2 = *(const pg8::f32x4*)(cw + 2 * DFF + ch0 + 4 * hq), q3 = *(const pg8::f32x4*)(cb + ch0 + 4 * hq);
#pragma unroll
            for (int e = 0; e < 4; ++e) { w0[4 * hq + e] = q0[e]; w1[4 * hq + e] = q1[e]; w2[4 * hq + e] = q2[e]; bb[4 * hq + e] = q3[e]; } }
#pragma unroll
        for (int ai = 0; ai < 2; ++ai) {
            const int kb = u.pm * 4 + ai * 2 + wr;
#pragma unroll
            for (int m = 0; m < 4; ++m) {
                const int rl = 16 * m + fr, gr = 62 * kb - 1 + rl;
                bool first, last; if (gr < ML) { const int t = gr & 8191; first = t == 0; last = t == 8191; } else { const int t = (gr - ML) & 255; first = t == 0; last = t == 255; }
                float res[8];
#pragma unroll
                for (int n = 0; n < 2; ++n)
#pragma unroll
                    for (int e = 0; e < 4; ++e) {
                        const float x0 = acc[ai][0][m][n][e];
                        const float ru = dpp_ror1(x0), rd = dpp_rol1(x0);
                        const float rum = dpp_ror1(acc[ai][0][m > 0 ? m - 1 : 0][n][e]), rdp = dpp_rol1(acc[ai][0][m < 3 ? m + 1 : 3][n][e]);
                        float xu = fr == 0 ? rum : ru, xd = fr == 15 ? rdp : rd;
                        xu = first ? 0.f : xu; xd = last ? 0.f : xd;
                        const int c = 4 * n + e;
                        const float x = w0[c] * xu + w1[c] * x0 + w2[c] * xd + bb[c];
                        const float uu = 0.7978845608028654f * (x + 0.044715f * x * x * x);
                        const float th = 1.0f - 2.0f / (1.0f + __expf(2.0f * uu));
                        res[c] = 0.5f * x * (1.0f + th) * acc[ai][1][m][n][e];
                    }
                if (rl >= 1 && rl <= 62 && gr < nrows) { v4u o; o.x = pk2(res[0], res[1]); o.y = pk2(res[2], res[3]); o.z = pk2(res[4], res[5]); o.w = pk2(res[6], res[7]);
                    *(v4u*)(G + (size_t)gr * DFF + ch0) = o; }
            }
        }
    }
};

struct EpiInProj {
    static constexpr bool PERM = true, AFTER_DRAIN = false;
    bf16_t *qa, *ka, *va, *qd, *kd, *vd, *hyr, *hyrc; const float *qn_a, *kn_a, *qn_d, *kn_d; const cf* rope;
    __device__ __forceinline__ void operator()(const pg8::f32x4 (&acc)[2][2][4][2], const pg8::Unit& u, int wr, int wc, int fr, int fq) const {
        const int pn = u.pn, lane = fr + 16 * fq;
        bool normed, keyrow; const float* gain = qn_a; float scale = 1.f; bf16_t* dbase; int dpitch, dcol, nh = 1, hidx = 0;
        if (pn == 0) { normed = true; gain = qn_a; scale = attn_body::C2; dbase = qa; dpitch = 256; keyrow = false; dcol = wc * 64; }
        else if (pn == 1) { keyrow = true; dpitch = 64; nh = 2; dcol = 0; if (wc < 2) { normed = true; gain = kn_a; dbase = ka; hidx = wc; } else { normed = false; dbase = va; hidx = wc - 2; } }
        else if (pn < 5) { normed = false; dbase = hyr; dpitch = 0; keyrow = false; dcol = (pn - 2) * 256 + wc * 64; }
        else if (pn < 7) { normed = true; gain = qn_d; scale = attn_body::C2; dbase = qd; dpitch = 512; keyrow = false; dcol = ((pn - 5) * 4 + wc) * 64; }
        else if (pn < 9) { normed = true; gain = kn_d; dbase = kd; dpitch = 64; keyrow = true; nh = 8; hidx = (pn - 7) * 4 + wc; dcol = 0; }
        else { normed = false; dbase = vd; dpitch = 128; keyrow = true; nh = 4; hidx = (pn - 9) * 2 + (wc >> 1); dcol = (wc & 1) * 64; }
        pg8::f32x4 gg[2][2];
#pragma unroll
        for (int bj = 0; bj < 2; ++bj)
#pragma unroll
            for (int n = 0; n < 2; ++n) gg[bj][n] = *(const pg8::f32x4*)(gain + 32 * bj + 8 * fq + 4 * n);
#pragma unroll
        for (int ai = 0; ai < 2; ++ai)
#pragma unroll
            for (int m = 0; m < 4; ++m) {
                const int r = u.pm * 256 + ai * 128 + wr * 64 + m * 16 + fr;
                const bool lat = r < ML; int b, t; if (lat) { b = r >> 13; t = r & 8191; } else { b = (r - ML) >> 8; t = (r - ML) & 255; }
                const size_t drow = keyrow ? (size_t)(b * nh + hidx) * NKEY + (lat ? 256 + t : t) : (size_t)r;
                if (pn >= 2 && pn < 5) {
                    bf16_t* cbp = lat ? hyr + (size_t)b * 768 * 8192 + t : hyrc + (size_t)b * 768 * 256 + t; const size_t cst = lat ? 8192 : 256;
#pragma unroll
                    for (int bj = 0; bj < 2; ++bj)
#pragma unroll
                        for (int n = 0; n < 2; ++n)
#pragma unroll
                            for (int e = 0; e < 4; ++e) cbp[(size_t)(dcol + 32 * bj + 8 * fq + 4 * n + e) * cst] = (bf16_t)f2bf(acc[ai][bj][m][n][e]);
                    continue;
                }
                bf16_t* dp = dbase + drow * dpitch + dcol + 8 * fq;
                float rinv = 1.f;
                if (normed) { float ss = 0.f;
#pragma unroll
                    for (int bj = 0; bj < 2; ++bj)
#pragma unroll
                        for (int n = 0; n < 2; ++n) { const pg8::f32x4 x = acc[ai][bj][m][n]; ss += (x[0] * x[0] + x[1] * x[1]) + (x[2] * x[2] + x[3] * x[3]); }
                    ss += shx(ss, 16, lane); ss += shx(ss, 32, lane);
                    rinv = scale / sqrtf(ss * (1.0f / 64.0f) + EPSF); }
#pragma unroll
                for (int bj = 0; bj < 2; ++bj) {
                    pg8::f32x4 y0 = acc[ai][bj][m][0], y1 = acc[ai][bj][m][1];
                    if (normed) {
                        y0 = y0 * rinv * gg[bj][0]; y1 = y1 * rinv * gg[bj][1];
                        if (lat) { const int p = bj == 0 ? (t >> 6) : (t & 63); const pg8::f32x4* rp = (const pg8::f32x4*)(rope + p * 16 + 4 * fq); const pg8::f32x4 c01 = rp[0], c23 = rp[1];
                            const pg8::f32x4 z0 = {y0[0] * c01[0] - y0[1] * c01[1], y0[0] * c01[1] + y0[1] * c01[0], y0[2] * c01[2] - y0[3] * c01[3], y0[2] * c01[3] + y0[3] * c01[2]};
                            const pg8::f32x4 z1 = {y1[0] * c23[0] - y1[1] * c23[1], y1[0] * c23[1] + y1[1] * c23[0], y1[2] * c23[2] - y1[3] * c23[3], y1[2] * c23[3] + y1[3] * c23[2]};
                            y0 = z0; y1 = z1; }
                    }
                    v4u o; o.x = pk2(y0[0], y0[1]); o.y = pk2(y0[2], y0[3]); o.z = pk2(y1[0], y1[1]); o.w = pk2(y1[2], y1[3]);
                    *(v4u*)(dp + 32 * bj) = o;
                }
            }
    }
};

template <int PERM_UP = 0> __device__ __forceinline__ void transpose_item(const float* W, int K, int N, bf16_t* WT, LAS float* scr, int item, int lane) {
    const int nblk = N / 32, kb = item / nblk, nb = item % nblk, k0 = 64 * kb, n0 = 32 * nb;
#pragma unroll 8
    for (int i = 0; i < 32; ++i) { const int kk = 2 * i + (lane >> 5); scr[kk * 33 + (lane & 31)] = W[(size_t)(k0 + kk) * N + n0 + (lane & 31)]; }
    asm volatile("s_waitcnt lgkmcnt(0)" ::: "memory");
    const int c = lane & 7;
#pragma unroll
    for (int j = 0; j < 4; ++j) { const int n = (lane >> 3) + 8 * j; const LAS float* s = scr + (8 * c) * 33 + n;
        v4u o; o.x = pk2(s[0 * 33], s[1 * 33]); o.y = pk2(s[2 * 33], s[3 * 33]); o.z = pk2(s[4 * 33], s[5 * 33]); o.w = pk2(s[6 * 33], s[7 * 33]);
        int row = n0 + n; if (PERM_UP == 2) { const int nl = row & 255; row = (row & ~255) + 128 * ((nl >> 5) & 1) + 32 * (nl >> 6) + (nl & 31); }
        if (PERM_UP == 1) { const bool isv = row >= DFF; const int ch = isv ? row - DFF : row; row = (ch >> 7) * 256 + (isv ? 128 : 0) + (ch & 127); }
        *(v4u*)(WT + (size_t)row * K + k0 + 8 * c) = o; }
    asm volatile("s_waitcnt lgkmcnt(0)" ::: "memory");
}

__device__ __forceinline__ void norm_mod(const float* xl, const float* xc, const float* g, const float* mod, int shoff, int scoff, bf16_t* H, int nrows, int gw, int NGW, int lane, int rbeg = 0) {
    for (int r = rbeg + gw; r < nrows; r += 4 * NGW) {
        int rr[4]; const float* xp[4]; const float* mp[4];
#pragma unroll
        for (int k = 0; k < 4; ++k) { const int rk = r + k * NGW; rr[k] = rk < nrows ? rk : r; xp[k] = rr[k] < ML ? xl + (size_t)rr[k] * 1024 : xc + (size_t)(rr[k] - ML) * 1024; mp[k] = mod + (rr[k] < ML ? (rr[k] >> 13) : 4) * 6144; }
        f32x4 v[4][4]; float ss[4];
#pragma unroll
        for (int k = 0; k < 4; ++k)
#pragma unroll
            for (int j = 0; j < 4; ++j) v[k][j] = ((const f32x4*)xp[k])[lane + 64 * j];
#pragma unroll
        for (int k = 0; k < 4; ++k) { ss[k] = 0.f;
#pragma unroll
            for (int j = 0; j < 4; ++j) ss[k] += (v[k][j].x * v[k][j].x + v[k][j].y * v[k][j].y) + (v[k][j].z * v[k][j].z + v[k][j].w * v[k][j].w); }
#pragma unroll
        for (int o = 1; o < 64; o <<= 1) {
#pragma unroll
            for (int k = 0; k < 4; ++k) ss[k] += shx(ss[k], o, lane); }
#pragma unroll
        for (int j = 0; j < 4; ++j) { const int col = 4 * lane + 256 * j;
            const f32x4 g4 = *(const f32x4*)(g + col);
#pragma unroll
            for (int k = 0; k < 4; ++k) { if (k == 0 || r + k * NGW < nrows) {
                const float rinv = 1.0f / sqrtf(ss[k] * (1.0f / 1024.0f) + EPSF);
                const f32x4 sc4 = *(const f32x4*)(mp[k] + scoff + col), sh4 = *(const f32x4*)(mp[k] + shoff + col); const f32x4 o = (v[k][j] * rinv * g4) * (sc4 + 1.0f) + sh4;
                v2u w; w.x = pk2(o.x, o.y); w.y = pk2(o.z, o.w); *(v2u*)(H + (size_t)rr[k] * 1024 + col) = w; } }
        }
    }
}

struct DualOrder {
    pg8::StaticOrder base; int mode, c, pm0, nN, nextra;
    __device__ __forceinline__ bool next(int i, pg8::Unit& u) const {
        if (mode == 0) return base.next(i, u);
        if (i > 0 || c >= nextra) return false;
        u.pm = pm0 + c / nN; u.pn = c % nN; return true; }
    __device__ __forceinline__ void a_ready(const pg8::Unit&) const {}
    __device__ __forceinline__ void done(const pg8::Unit&) const {}
};

__device__ __forceinline__ cf mk2(float x, float y) { cf r; r.x = x; r.y = y; return r; }
__device__ __forceinline__ cf cmul(cf a, cf b) { return mk2(a.x * b.x - a.y * b.y, a.x * b.y + a.y * b.x); }
__device__ __forceinline__ cf cmulc(cf a, cf b) { return mk2(a.x * b.x + a.y * b.y, a.y * b.x - a.x * b.y); }
__device__ __forceinline__ cf ld_f2_l2(const cf* p) {
    const unsigned long long w = __hip_atomic_load((const unsigned long long*)p, __ATOMIC_RELAXED, __HIP_MEMORY_SCOPE_AGENT);
    return mk2(__uint_as_float((unsigned)w), __uint_as_float((unsigned)(w >> 32)));
}
__device__ __forceinline__ int PX(int i) { return i + (i >> 6); }
__device__ __forceinline__ cf twid(float frac) { return mk2(__builtin_amdgcn_cosf(frac), -__builtin_amdgcn_sinf(frac)); }
__device__ __forceinline__ void bfly4_fwd(cf& a0, cf& a1, cf& a2, cf& a3) {
    const cf s02 = a0 + a2, d02 = a0 - a2, s13 = a1 + a3, d13 = a1 - a3;
    a0 = s02 + s13; a2 = s02 - s13; a1 = mk2(d02.x + d13.y, d02.y - d13.x); a3 = mk2(d02.x - d13.y, d02.y + d13.x);
}
__device__ __forceinline__ void bfly4_inv(cf& a0, cf& a1, cf& a2, cf& a3) {
    const cf s02 = a0 + a2, d02 = a0 - a2, s13 = a1 + a3, d13 = a1 - a3;
    a0 = s02 + s13; a2 = s02 - s13; a1 = mk2(d02.x - d13.y, d02.y + d13.x); a3 = mk2(d02.x + d13.y, d02.y - d13.x);
}
template <int LG, bool INV> __device__ __forceinline__ void fft_pass2(LAS cf* X, int tid) {
    constexpr int L = 1 << LG, L16 = L >> 4, L4 = L >> 2; constexpr float fL = 1.0f / (float)L;
#pragma unroll 1
    for (int i = 0; i < 2; ++i) {
        const int it = tid + 512 * i; int g, j;
        if (LG == 14) { g = 0; j = it; } else if (LG == 10) { j = it & 63; g = it >> 6; } else { g = it & 255; j = it >> 8; }
        const int base = g * L + j;
        cf e[4][4];
#pragma unroll
        for (int r = 0; r < 4; ++r)
#pragma unroll
            for (int m = 0; m < 4; ++m) e[r][m] = X[PX(base + r * L16 + m * L4)];
        const cf v1 = twid((float)(4 * j) * fL), v2 = cmul(v1, v1), v3 = cmul(v2, v1);
        if (!INV) {
#pragma unroll
            for (int r = 0; r < 4; ++r) { bfly4_fwd(e[r][0], e[r][1], e[r][2], e[r][3]);
                const cf w1 = twid((float)(j + r * L16) * fL), w2 = cmul(w1, w1), w3 = cmul(w2, w1);
                e[r][1] = cmul(e[r][1], w1); e[r][2] = cmul(e[r][2], w2); e[r][3] = cmul(e[r][3], w3); }
#pragma unroll
            for (int p = 0; p < 4; ++p) { bfly4_fwd(e[0][p], e[1][p], e[2][p], e[3][p]); e[1][p] = cmul(e[1][p], v1); e[2][p] = cmul(e[2][p], v2); e[3][p] = cmul(e[3][p], v3); }
        } else {
#pragma unroll
            for (int p = 0; p < 4; ++p) { e[1][p] = cmulc(e[1][p], v1); e[2][p] = cmulc(e[2][p], v2); e[3][p] = cmulc(e[3][p], v3); bfly4_inv(e[0][p], e[1][p], e[2][p], e[3][p]); }
#pragma unroll
            for (int r = 0; r < 4; ++r) { const cf w1 = twid((float)(j + r * L16) * fL), w2 = cmul(w1, w1), w3 = cmul(w2, w1);
                e[r][1] = cmulc(e[r][1], w1); e[r][2] = cmulc(e[r][2], w2); e[r][3] = cmulc(e[r][3], w3); bfly4_inv(e[r][0], e[r][1], e[r][2], e[r][3]); }
        }
#pragma unroll
        for (int r = 0; r < 4; ++r)
#pragma unroll
            for (int m = 0; m < 4; ++m) X[PX(base + r * L16 + m * L4)] = e[r][m];
    }
    __syncthreads();
}
__device__ __forceinline__ void fft_last_fwd(LAS cf* X, int tid, cf* KFW, float bias, float scale) {
#pragma unroll 2
    for (int i = 0; i < 8; ++i) { const int it = tid + 512 * i, g = it & 255, k = it >> 8, base = g * 64 + 4 * k;
        cf e0 = X[PX(base)], e1 = X[PX(base + 1)], e2 = X[PX(base + 2)], e3 = X[PX(base + 3)];
        bfly4_fwd(e0, e1, e2, e3);
        if (KFW) { cf* o = KFW + (4 * k) * 256 + g; o[0] = mk2((e0.x + bias) * scale, e0.y * scale); o[256] = mk2((e1.x + bias) * scale, e1.y * scale); o[512] = mk2((e2.x + bias) * scale, e2.y * scale); o[768] = mk2((e3.x + bias) * scale, e3.y * scale); }
        else { X[PX(base)] = e0; X[PX(base + 1)] = e1; X[PX(base + 2)] = e2; X[PX(base + 3)] = e3; } }
    __syncthreads();
}
__device__ __forceinline__ void fft_first_inv_mul(LAS cf* X, int tid, const cf* KFR) {
#pragma unroll 2
    for (int i = 0; i < 8; ++i) { const int it = tid + 512 * i, g = it & 255, k = it >> 8, base = g * 64 + 4 * k; const cf* q = KFR + (4 * k) * 256 + g;
        cf e0 = cmul(X[PX(base)], ld_f2_l2(q)), e1 = cmul(X[PX(base + 1)], ld_f2_l2(q + 256)), e2 = cmul(X[PX(base + 2)], ld_f2_l2(q + 512)), e3 = cmul(X[PX(base + 3)], ld_f2_l2(q + 768));
        bfly4_inv(e0, e1, e2, e3);
        X[PX(base)] = e0; X[PX(base + 1)] = e1; X[PX(base + 2)] = e2; X[PX(base + 3)] = e3; }
    __syncthreads();
}
__device__ __forceinline__ void fft_mid_mul(LAS cf* X, int tid, const cf* KFR) {
#pragma unroll 2
    for (int i = 0; i < 8; ++i) { const int it = tid + 512 * i, g = it & 255, k = it >> 8, base = g * 64 + 4 * k; const cf* q = KFR + (4 * k) * 256 + g;
        cf e0 = X[PX(base)], e1 = X[PX(base + 1)], e2 = X[PX(base + 2)], e3 = X[PX(base + 3)];
        const cf k0 = ld_f2_l2(q), k1 = ld_f2_l2(q + 256), k2 = ld_f2_l2(q + 512), k3 = ld_f2_l2(q + 768);
        bfly4_fwd(e0, e1, e2, e3);
        e0 = cmul(e0, k0); e1 = cmul(e1, k1); e2 = cmul(e2, k2); e3 = cmul(e3, k3);
        bfly4_inv(e0, e1, e2, e3);
        X[PX(base)] = e0; X[PX(base + 1)] = e1; X[PX(base + 2)] = e2; X[PX(base + 3)] = e3; }
    __syncthreads();
}
__device__ __forceinline__ void fft_fwd_lds(LAS cf* X, int tid) { fft_pass2<14, false>(X, tid); fft_pass2<10, false>(X, tid); fft_pass2<6, false>(X, tid); }
__device__ __forceinline__ void fft_inv_lds(LAS cf* X, int tid) { fft_pass2<6, true>(X, tid); fft_pass2<10, true>(X, tid); fft_pass2<14, true>(X, tid); }
__device__ __forceinline__ void conv8(const bf16_t* p, int c, int n, float w0, float w1, float w2, float b, float (&o)[8]) {
    const v4u v = *(const v4u*)(p + 8 * c);
    const float um = c > 0 ? bf2f(p[8 * c - 1]) : 0.f, up = 8 * c + 8 < n ? bf2f(p[8 * c + 8]) : 0.f;
    const float u0 = bflo(v.x), u1 = bfhi(v.x), u2 = bflo(v.y), u3 = bfhi(v.y), u4 = bflo(v.z), u5 = bfhi(v.z), u6 = bflo(v.w), u7 = bfhi(v.w);
    o[0] = w0 * um + w1 * u0 + w2 * u1 + b; o[1] = w0 * u0 + w1 * u1 + w2 * u2 + b; o[2] = w0 * u1 + w1 * u2 + w2 * u3 + b; o[3] = w0 * u2 + w1 * u3 + w2 * u4 + b;
    o[4] = w0 * u3 + w1 * u4 + w2 * u5 + b; o[5] = w0 * u4 + w1 * u5 + w2 * u6 + b; o[6] = w0 * u5 + w1 * u6 + w2 * u7 + b; o[7] = w0 * u6 + w1 * u7 + w2 * up + b;
}
__device__ __forceinline__ float hy_in(const bf16_t* p, int t, int n, float w0, float w1, float w2, float b) {
    const float um = t > 0 ? bf2f(p[t - 1]) : 0.f, u0 = bf2f(p[t]), up = t < n - 1 ? bf2f(p[t + 1]) : 0.f;
    return w0 * um + w1 * u0 + w2 * up + b;
}

#define XB_TMO      128
#define XB_XCNT(j)  (256  + 64 * (j))
#define XB_XSUB(j)  (1280 + 64 * (j))
#define XB_XGEN(j)  (2304 + 64 * (j))
#define XB_TOP      3328
#define XB_TOPGEN   3392
#define XCD_BAR_WORDS 3456
#define XB_SPIN_CAP (1u << 18)

__device__ __forceinline__ unsigned xb_ld(unsigned* p)              { return __hip_atomic_load(p, __ATOMIC_RELAXED, __HIP_MEMORY_SCOPE_AGENT); }
__device__ __forceinline__ unsigned xb_add(unsigned* p, unsigned v) { return __hip_atomic_fetch_add(p, v, __ATOMIC_RELAXED, __HIP_MEMORY_SCOPE_AGENT); }
__device__ __forceinline__ unsigned xb_xcc_id() { return (unsigned)__builtin_amdgcn_s_getreg((3 << 11) | 20) & 0xFu; }
#define XB_SPIN(cond, bar) do { unsigned _sp = 0; while (cond) { __builtin_amdgcn_s_sleep(1); \
    if ((++_sp & 255u) == 0u) { if (xb_ld(&(bar)[XB_TMO])) break; if (_sp > XB_SPIN_CAP) { atomicAdd(&(bar)[XB_TMO], 1u); break; } } } } while (0)

struct XcdBarrier {
    unsigned* bar; unsigned x;
    volatile LAS unsigned* st;
};

__device__ __forceinline__ XcdBarrier xcd_barrier_post(unsigned* bar, volatile LAS unsigned* st) {
    XcdBarrier b; b.bar = bar; b.x = xb_xcc_id(); b.st = st;
    if (threadIdx.x == 0) (void)xb_add(&bar[XB_XCNT(b.x)], 1u);
    return b;
}
__device__ __forceinline__ void xcd_barrier_complete(unsigned* bar, unsigned x, unsigned& nloc, unsigned& nx) {
    const unsigned G = gridDim.x * gridDim.y * gridDim.z;
    unsigned sum, cnt, mine, sp = 0u;
    for (;;) {
        sum = 0u; cnt = 0u; mine = 0u;
#pragma unroll
        for (unsigned j = 0; j < 16; ++j) { const unsigned c = xb_ld(&bar[XB_XCNT(j)]); sum += c; cnt += (c > 0u) ? 1u : 0u; mine = (j == x) ? c : mine; }
        if (sum == G) break;
        __builtin_amdgcn_s_sleep(1);
        if ((++sp & 255u) == 0u) { if (xb_ld(&bar[XB_TMO])) break; if (sp > XB_SPIN_CAP) { atomicAdd(&bar[XB_TMO], 1u); break; } }
    }
    nloc = mine > 0u ? mine : 1u; nx = cnt > 0u ? cnt : 1u;
}

__device__ __forceinline__ void xcd_barrier(const XcdBarrier& b, const int wave0) {
    asm volatile("s_waitcnt vmcnt(0)" ::: "memory");
    __syncthreads();
    if (wave0 == 0 && lane_id_v() == 0) {
        unsigned* bar = b.bar;
        __builtin_amdgcn_s_waitcnt(0);
        unsigned nloc = b.st[0], nx = b.st[1];
        if (nloc == 0u) { xcd_barrier_complete(bar, b.x, nloc, nx); b.st[0] = nloc; b.st[1] = nx; }
        const unsigned old = xb_add(&bar[XB_XSUB(b.x)], 1u);
        const unsigned gen = old / nloc;
        if (old + 1u == (gen + 1u) * nloc) {
            __builtin_amdgcn_fence(__ATOMIC_RELEASE, "agent");
            asm volatile("s_waitcnt vmcnt(0)" ::: "memory");
            const unsigned og = xb_add(&bar[XB_TOP], 1u);
            const unsigned tg = og / nx;
            if (og + 1u == (tg + 1u) * nx) xb_add(&bar[XB_TOPGEN], 1u);
            else XB_SPIN(xb_ld(&bar[XB_TOPGEN]) == tg, bar);
            __builtin_amdgcn_fence(__ATOMIC_ACQUIRE, "agent");
            xb_add(&bar[XB_XGEN(b.x)], 1u);
            asm volatile("s_waitcnt vmcnt(0)" ::: "memory");
        } else {
            XB_SPIN(xb_ld(&bar[XB_XGEN(b.x)]) == gen, bar);
            __builtin_amdgcn_fence(__ATOMIC_ACQUIRE, "agent");
            asm volatile("s_waitcnt vmcnt(0)" ::: "memory");
        }
    }
    __syncthreads();
}


struct Args { const float* in[33]; float* out; unsigned char* ws; };
__device__ __forceinline__ unsigned char* wsb(unsigned char* p) { asm volatile("" : "+s"(p)); return p; }
__device__ __forceinline__ int opq(int i) { asm volatile("" : "+s"(i)); return i; }

#define MOD ((float*)(wsb(a.ws) + WS_MOD))
#define LAM ((float*)(wsb(a.ws) + WS_LAM))
#define ROPE ((cf*)(wsb(a.ws) + WS_ROPE))
#define TW ((cf*)(wsb(a.ws) + WS_TW))
#define WIN ((bf16_t*)(wsb(a.ws) + WS_WIN))
#define WOUT ((bf16_t*)(wsb(a.ws) + WS_WOUT))
#define WUP ((bf16_t*)(wsb(a.ws) + WS_WUP))
#define WDN ((bf16_t*)(wsb(a.ws) + WS_WDN))
#define CTXX ((float*)(wsb(a.ws) + WS_CTXX))
#define FILT ((float*)(wsb(a.ws) + WS_FILT))
#define FILTC ((float*)(wsb(a.ws) + WS_FILTC))
#define H ((bf16_t*)(wsb(a.ws) + WS_H))
#define KFB ((cf*)(wsb(a.ws) + WS_KF))
#define RAW ((bf16_t*)(wsb(a.ws) + WS_RAW))
#define YRAW ((bf16_t*)(wsb(a.ws) + WS_YRAW))
#define YH ((float*)(wsb(a.ws) + WS_YH))
#define YHC ((float*)(wsb(a.ws) + WS_YHC))
#define QA ((bf16_t*)(wsb(a.ws) + WS_QA))
#define KA ((bf16_t*)(wsb(a.ws) + WS_KA))
#define VA ((bf16_t*)(wsb(a.ws) + WS_VA))
#define QD ((bf16_t*)(wsb(a.ws) + WS_QD))
#define KD ((bf16_t*)(wsb(a.ws) + WS_KD))
#define VD ((bf16_t*)(wsb(a.ws) + WS_VD))
#define HYR ((bf16_t*)(wsb(a.ws) + WS_HYR))
#define HYRC ((bf16_t*)(wsb(a.ws) + WS_HYRC))
#define GB ((bf16_t*)(wsb(a.ws) + WS_G))
#define OUT (a.out)
__device__ __forceinline__ void prep_work(const Args& a, LAS unsigned char* lds, const int lp, const bool needc, const int widx, const int nwg, const bool do_main, const bool do_dn, const int tid, const int lane, const int wave) {
    LAS float* scr = (LAS float*)(lds + wave * 16384);
    constexpr int I_IN = 16 * 88, I_OUT = 16 * 32, I_UP = 16 * 176, I_DN = 44 * 32;
    for (int it = (do_main ? 0 : I_IN + I_OUT + I_UP) + widx * 8 + wave; it < (do_dn ? I_IN + I_OUT + I_UP + I_DN : I_IN + I_OUT + I_UP); it += nwg * 8) {
        int r = it;
        if (r < I_IN) { transpose_item<2>(a.in[opq(8)] + (size_t)lp * 1024 * INW, 1024, INW, WIN, scr, r, lane); continue; } r -= I_IN;
        if (r < I_OUT) { transpose_item(a.in[opq(28)] + (size_t)lp * 1024 * 1024, 1024, 1024, WOUT, scr, r, lane); continue; } r -= I_OUT;
        if (r < I_UP) { transpose_item<1>(a.in[opq(29)] + (size_t)lp * 1024 * 2 * DFF, 1024, 2 * DFF, WUP, scr, r, lane); continue; } r -= I_UP;
        transpose_item(a.in[opq(32)] + (size_t)lp * DFF * 1024, DFF, 1024, WDN, scr, r, lane);
    }
    __syncthreads();
    if (do_main) {
    const float* fw1 = a.in[opq(19)] + lp * 33 * 64; const float* fb1 = a.in[opq(20)] + lp * 64; const float* fw2 = a.in[opq(21)] + lp * 64 * 64; const float* fb2 = a.in[opq(22)] + lp * 64;
    const float* fw3 = a.in[opq(23)] + (size_t)lp * 64 * 1024; const float* fb3 = a.in[opq(24)] + lp * 1024; const float* freq = a.in[opq(25)] + lp * 64;
    LAS float* Z = (LAS float*)lds; LAS float* H1 = Z + 33 * 33; LAS float* H2 = H1 + 33 * 64; LAS float* W1 = H2 + 33 * 64; LAS float* W2 = W1 + 33 * 64; LAS float* FB = W2 + 64 * 64;
    for (int i = tid; i < 33 * 64; i += NTHR) W1[i] = fw1[i];
    for (int i = tid; i < 64 * 64; i += NTHR) W2[i] = fw2[i];
    if (tid < 64) { FB[tid] = fb1[tid]; FB[64 + tid] = fb2[tid]; FB[128 + tid] = freq[tid]; }
    const int npos = needc ? 33 : 32;
    for (int item = widx; item < 256; item += nwg) {
        __syncthreads();
        for (int i = tid; i < npos * 33; i += NTHR) { const int p = i / 33, e = i - p * 33; const bool isc = p == 32; const int n = isc ? item : item * 32 + p; const float NP = isc ? 256.0f : 8192.0f; float val;
            if (e == 0) val = (float)n / (NP - 1.0f);
            else { const int k = (e - 1) & 15; const float band = 1e-4f + (float)k * ((15.0f - 1e-4f) / 15.0f); const float w = 6.283185307179586f * (float)n / NP; const float arg = band * w;
                val = (e <= 16) ? cosf(arg) : -sinf(arg); }
            Z[i] = val; }
        __syncthreads();
        for (int i = tid; i < npos * 64; i += NTHR) { const int p = i >> 6, j = i & 63; float s = FB[j];
#pragma unroll
            for (int e = 0; e < 33; ++e) s += Z[p * 33 + e] * W1[e * 64 + j];
            H1[i] = sinf(FB[128 + j] * s); }
        __syncthreads();
        for (int i = tid; i < npos * 64; i += NTHR) { const int p = i >> 6, j = i & 63; float s = FB[64 + j];
#pragma unroll 16
            for (int e = 0; e < 64; ++e) s += H1[p * 64 + e] * W2[e * 64 + j];
            H2[i] = sinf(FB[128 + j] * s); }
        __syncthreads();
#pragma unroll 1
        for (int half = 0; half < 2; ++half) { const int q = tid + 512 * half, c = q & 255;
            float w[64];
#pragma unroll
            for (int e = 0; e < 64; ++e) w[e] = fw3[(size_t)e * 1024 + q];
            const float b3 = fb3[q], adelta = 3.0701134573253945f + (float)c * ((15.350567286626973f - 3.0701134573253945f) / 255.0f);
#pragma unroll 1
            for (int p = 0; p < npos; ++p) { float s = b3;
#pragma unroll
                for (int e = 0; e < 64; ++e) s += H2[p * 64 + e] * w[e];
                const bool isc = p == 32; const int n = isc ? item : item * 32 + p; const float t = (float)n / (isc ? 255.0f : 8191.0f);
                float* dst = isc ? FILTC + (size_t)q * 256 : FILT + (size_t)q * 8192;
                dst[n] = s * expf(-t * adelta); }
        }
    }
    __syncthreads();
    }
}

__global__ void __launch_bounds__(NTHR, 2) fwd_mega(Args a) {
    extern __shared__ __attribute__((aligned(16))) unsigned char lds_raw[];
    cg::grid_group grid = cg::this_grid();
    LAS unsigned char* lds = (LAS unsigned char*)lds_raw;
    const int G = gridDim.x, bx = blockIdx.x;
    const int NGW = G * 8;
const int wave0 = __builtin_amdgcn_readfirstlane(threadIdx.x >> 6);
#define PHASE_IDS int tid = wave0 * 64 + lane_id_v(); asm volatile("" : "+v"(tid)); const int lane = tid & 63, wave = __builtin_amdgcn_readfirstlane(tid >> 6); const int gw = bx * 8 + wave; (void)lane; (void)gw;

    volatile LAS unsigned* MISC = (volatile LAS unsigned*)(lds + 147392);
    if (threadIdx.x < 16) MISC[threadIdx.x] = 0u;
    __syncthreads();
    const XcdBarrier xbar = xcd_barrier_post((unsigned*)a.ws, MISC + 8);
    if (threadIdx.x == 0) MISC[2] = xb_add((unsigned*)a.ws + 4096 + 64 * xbar.x, 1u);
    {
        PHASE_IDS
        LAS float* S = (LAS float*)lds; LAS float* RED = S + 5 * 1024;
        const float* c = a.in[opq(1)]; const float* cctx = a.in[opq(3)];
        for (int i = tid; i < 5 * 1024; i += NTHR) { const float v = i < 4096 ? c[i] : cctx[i - 4096]; S[i] = v / (1.f + expf(-v)); }
        __syncthreads();
        const float* wmod = a.in[opq(6)]; const float* bmod = a.in[opq(7)];
        for (int item = bx; item < 384; item += G) {
            const int l = item / 96, cgi = item % 96, ks = tid >> 6, jl = tid & 63, col = cgi * 64 + jl;
            const float* w = wmod + ((size_t)l * 1024 + ks * 128) * 6144 + col;
            float a0 = 0.f, a1 = 0.f, a2 = 0.f, a3 = 0.f, a4 = 0.f;
#pragma unroll 8
            for (int k = 0; k < 128; ++k) { const float wv = w[(size_t)k * 6144]; const int kk = ks * 128 + k;
                a0 += S[kk] * wv; a1 += S[1024 + kk] * wv; a2 += S[2048 + kk] * wv; a3 += S[3072 + kk] * wv; a4 += S[4096 + kk] * wv; }
            RED[(ks * 5 + 0) * 64 + jl] = a0; RED[(ks * 5 + 1) * 64 + jl] = a1; RED[(ks * 5 + 2) * 64 + jl] = a2; RED[(ks * 5 + 3) * 64 + jl] = a3; RED[(ks * 5 + 4) * 64 + jl] = a4;
            __syncthreads();
            if (tid < 320) { const int bi = tid >> 6, j = tid & 63; float s = bmod[l * 6144 + cgi * 64 + j];
#pragma unroll
                for (int k2 = 0; k2 < 8; ++k2) s += RED[(k2 * 5 + bi) * 64 + j];
                MOD[((size_t)l * 5 + bi) * 6144 + cgi * 64 + j] = s; }
            __syncthreads();
        }
        if (bx == 0 && wave < 4) { const int l = wave;
            const float s1 = wave_sum(a.in[opq(13)][l * 64 + lane] * a.in[opq(14)][l * 64 + lane]), s2 = wave_sum(a.in[opq(15)][l * 64 + lane] * a.in[opq(16)][l * 64 + lane]);
            if (lane == 0) LAM[l] = expf(s1) - expf(s2) + (0.8f - 0.6f * expf(-0.3f * (float)l)); }
        const int gt = bx * NTHR + tid;
        if (gt < 2048) { const int p = gt >> 4, f = gt & 15; const float inv = powf(10000.0f, -(float)f / 16.0f); float sn, cs; sincosf((float)p * inv, &sn, &cs); ROPE[gt] = mk2(cs, sn); }
        for (int m = gt; m < FFTN; m += G * NTHR) { float sn, cs; sincospif((float)m / 8192.0f, &sn, &cs); TW[m] = mk2(cs, -sn); }
    }
    if (PROBE_PLAIN_LAUNCH) xcd_barrier(xbar, wave0); else grid.sync();
    if (threadIdx.x == 0) {
        bool ok = (G % 8 == 0) && xbar.x < 8u;
        for (int j = 0; j < 8; ++j) ok = ok && (xb_ld((unsigned*)a.ws + 4096 + 64 * j) == (unsigned)(G / 8));
        const unsigned rk = MISC[2];
        MISC[0] = ok ? rk * 8u + xbar.x : (unsigned)bx;
        MISC[1] = ok ? xbar.x * (unsigned)(G / 8) + rk : (unsigned)((G % 8 == 0) ? (bx % 8) * (G / 8) + bx / 8 : bx);
    }
    __syncthreads();
    const int cbx = __builtin_amdgcn_readfirstlane((int)MISC[0]), vcu = __builtin_amdgcn_readfirstlane((int)MISC[1]);

    for (int l = 0; l < DEPTH; ++l) {
        const bool need_ctx = l < DEPTH - 1;
        const float* xl = l == 0 ? a.in[opq(0)] : OUT; const float* xc = l == 0 ? a.in[opq(2)] : CTXX;
        const float* modl = MOD + (size_t)l * 5 * 6144;
        for (int rep_ = 0; rep_ < REP_PREP; ++rep_) {
            PHASE_IDS
            __syncthreads();
            prep_work(a, lds, l, need_ctx, bx, G, l == 0, true, tid, lane, wave);
            norm_mod(xl, xc, a.in[opq(4)] + l * 1024, modl, 0, 1024, H, MT, gw, NGW, lane, l == 0 ? 0 : ML);
        }
        xcd_barrier(xbar, wave0);
        {
            pg8::Gemm g{H, WIN, MT, INW, 1024}; pg8::StaticOrder S; S.init(MT, INW, G, cbx);
            EpiInProj E{QA, KA, VA, QD, KD, VD, HYR, HYRC, a.in[opq(9)] + l * 64, a.in[opq(10)] + l * 64, a.in[opq(11)] + l * 64, a.in[opq(12)] + l * 64, ROPE};
            pg8::gemm_phase<EpiInProj, pg8::StaticOrder, PG8_ALIGN, PG8_SP2>(lds, g, S, E, wave0);
        }
        xcd_barrier(xbar, wave0);
        {
            PHASE_IDS
            LAS cf* X = (LAS cf*)lds; LAS float* RED = (LAS float*)(lds + 135168);
            const float* cw = a.in[opq(17)] + l * 3 * 768; const float* cb = a.in[opq(18)] + l * 768; const float* hb_ = a.in[opq(26)] + l * 512;
            for (int rep_ = 0; rep_ < REP_HY; ++rep_) for (int c = vcu; c < 256; c += G) {
                const float wv0 = cw[c], wv1 = cw[768 + c], wv2 = cw[1536 + c], bv = cb[c];
                const float wa0 = cw[256 + c], wa1 = cw[768 + 256 + c], wa2 = cw[1536 + 256 + c], ba = cb[256 + c];
                const float wb0 = cw[512 + c], wb1 = cw[768 + 512 + c], wb2 = cw[1536 + 512 + c], bb = cb[512 + c];
                const float bias1 = hb_[c], bias2 = hb_[256 + c];
                cf* KF = KFB + (size_t)c * 2 * FFTN;
                const int cw = 8 * (lane & 7) + (lane >> 3);
                for (int o = 0; o < 2; ++o) {
                    const float* hf = FILT + ((size_t)(0 * 2 + o) * 256 + c) * 8192; const float* hb = FILT + ((size_t)(1 * 2 + o) * 256 + c) * 8192;
                    float s = 0.f; for (int i = tid; i < 8192; i += NTHR) s += fabsf(hf[i]) + fabsf(hb[i]);
                    s = block_sum(s, RED, tid); const float inv = 1.0f / (s + EPSF);
                    for (int i = tid; i < 8192; i += NTHR) { X[PX(i)] = mk2(hf[i] * inv, 0.f); X[PX(8192 + i)] = (i == 0) ? mk2(0.f, 0.f) : mk2(hb[8192 - i] * inv, 0.f); }
                    __syncthreads();
                    fft_fwd_lds(X, tid);
                    fft_last_fwd(X, tid, KF + o * FFTN, o == 0 ? bias1 : bias2, 1.0f / FFTN);
                }
                __threadfence(); __syncthreads();
                for (int bp = 0; bp < 2; ++bp) {
                    const int b0 = 2 * bp, b1 = b0 + 1;
                    const bf16_t* pv0 = HYR + ((size_t)b0 * 768 + c) * 8192; const bf16_t* pv1 = HYR + ((size_t)b1 * 768 + c) * 8192;
#pragma unroll 1
                    for (int k = 0; k < 2; ++k) { const int ch = 64 * (wave + 8 * k) + cw; float u0[8], u1[8];
                        conv8(pv0, ch, 8192, wv0, wv1, wv2, bv, u0); conv8(pv1, ch, 8192, wv0, wv1, wv2, bv, u1);
#pragma unroll
                        for (int e = 0; e < 8; ++e) { X[PX(8 * ch + e)] = mk2(u0[e], u1[e]); X[PX(8192 + 8 * ch + e)] = mk2(0.f, 0.f); } }
                    __syncthreads();
                    fft_fwd_lds(X, tid); fft_mid_mul(X, tid, KF); fft_inv_lds(X, tid);
#pragma unroll 1
                    for (int k = 0; k < 2; ++k) { const int ch = 64 * (wave + 8 * k) + cw; float a0_[8], a1_[8];
                        conv8(pv0 + 256 * 8192, ch, 8192, wa0, wa1, wa2, ba, a0_); conv8(pv1 + 256 * 8192, ch, 8192, wa0, wa1, wa2, ba, a1_);
#pragma unroll
                        for (int e = 0; e < 8; ++e) { const cf cv = X[PX(8 * ch + e)]; X[PX(8 * ch + e)] = mk2(a0_[e] * cv.x, a1_[e] * cv.y); X[PX(8192 + 8 * ch + e)] = mk2(0.f, 0.f); } }
                    __syncthreads();
                    fft_fwd_lds(X, tid); fft_mid_mul(X, tid, KF + FFTN); fft_inv_lds(X, tid);
#pragma unroll 1
                    for (int k = 0; k < 2; ++k) { const int ch = 64 * (wave + 8 * k) + cw; float x0_[8], x1_[8];
                        conv8(pv0 + 512 * 8192, ch, 8192, wb0, wb1, wb2, bb, x0_); conv8(pv1 + 512 * 8192, ch, 8192, wb0, wb1, wb2, bb, x1_);
                        f32x4 o0a, o0b, o1a, o1b;
#pragma unroll
                        for (int e = 0; e < 4; ++e) { const cf ca = X[PX(8 * ch + e)], cb2 = X[PX(8 * ch + 4 + e)]; o0a[e] = x0_[e] * ca.x; o1a[e] = x1_[e] * ca.y; o0b[e] = x0_[4 + e] * cb2.x; o1b[e] = x1_[4 + e] * cb2.y; }
                        float* y0p = YH + ((size_t)b0 * 256 + c) * 8192 + 8 * ch; float* y1p = YH + ((size_t)b1 * 256 + c) * 8192 + 8 * ch;
                        *(f32x4*)y0p = o0a; *(f32x4*)(y0p + 4) = o0b; *(f32x4*)y1p = o1a; *(f32x4*)(y1p + 4) = o1b; }
                    __syncthreads();
                }
                if (need_ctx) {
                    int tidc = tid; asm volatile("" : "+v"(tidc));
                    LAS float* KC = (LAS float*)lds; LAS float* U = KC + 1024; LAS float* XA = U + 1024; LAS float* XB = XA + 1024; LAS float* Z1 = XB + 1024;
                    for (int o = 0; o < 2; ++o) {
                        const float* hf = FILTC + ((size_t)(0 * 2 + o) * 256 + c) * 256; const float* hb = FILTC + ((size_t)(1 * 2 + o) * 256 + c) * 256;
                        const float f_ = tid < 256 ? hf[tid] : 0.f, b_ = tid < 256 ? hb[tid] : 0.f;
                        float s = fabsf(f_) + fabsf(b_);
                        s = block_sum(s, RED, tid); const float inv = 1.0f / (s + EPSF);
                        if (tid < 256) { KC[o * 512 + 255 + tid] = f_ * inv; if (tid > 0) KC[o * 512 + 255 - tid] = b_ * inv; }
                    }
#pragma unroll 1
                    for (int k = 0; k < 2; ++k) { const int i = tidc + 512 * k, b = i >> 8, t = i & 255; const bf16_t* p = HYRC + ((size_t)b * 768 + c) * 256;
                        U[i] = hy_in(p, t, 256, wv0, wv1, wv2, bv); XA[i] = hy_in(p + 256 * 256, t, 256, wa0, wa1, wa2, ba); XB[i] = hy_in(p + 512 * 256, t, 256, wb0, wb1, wb2, bb); }
                    __syncthreads();
#pragma unroll 1
                    for (int k = 0; k < 2; ++k) { const int i = tidc + 512 * k, b = i >> 8, t = i & 255; float acc = 0.f; const LAS float* kp = KC + 255 + t; const LAS float* up = U + b * 256;
#pragma unroll 8
                        for (int s = 0; s < 256; ++s) acc += kp[-s] * up[s];
                        Z1[i] = XA[i] * (acc + bias1 * U[i]); }
                    __syncthreads();
#pragma unroll 1
                    for (int k = 0; k < 2; ++k) { const int i = tidc + 512 * k, b = i >> 8, t = i & 255; float acc = 0.f; const LAS float* kp = KC + 512 + 255 + t; const LAS float* up = Z1 + b * 256;
#pragma unroll 8
                        for (int s = 0; s < 256; ++s) acc += kp[-s] * up[s];
                        YHC[((size_t)b * 256 + c) * 256 + t] = XB[i] * (acc + bias2 * Z1[i]); }
                    __syncthreads();
                }
            }
            for (int rep_ = 0; rep_ < REP_ATT; ++rep_) {
                const int nA = 16 * 32 + (need_ctx ? 16 : 0), nC = 32 * 32 + (need_ctx ? 32 : 0);
                for (int u = vcu; u < nA; u += G) {
                    const bool isc = u >= 16 * 32; const int hu = isc ? u - 16 * 32 : (u >> 5), qb = u & 31, b = hu >> 2, k = hu & 3, row0 = isc ? ML + b * 256 : b * 8192 + qb * 256;
                    attn_body::attn_unit<8, false, 256, 64, 64, 1280>((const attn_body::bf16*)(QA + k * 64 + (size_t)row0 * 256), (const attn_body::bf16*)(KA + (size_t)(b * 2 + (k >> 1)) * NKEY * 64), (const attn_body::bf16*)(VA + (size_t)(b * 2 + (k >> 1)) * NKEY * 64),
                        (attn_body::bf16*)(YRAW + k * 64 + (size_t)row0 * 1280), isc ? 4 : 132, (char*)lds_raw, wave0);
                }
                for (int u = vcu; u < nC; u += G) {
                    const bool isc = u >= 32 * 32; const int hu = isc ? u - 32 * 32 : (u >> 5), qb = u & 31, b = hu >> 3, h = (hu & 7) >> 1, j = hu & 1, row0 = isc ? ML + b * 256 : b * 8192 + qb * 256;
                    attn_body::attn_unit<8, true, 512, 64, 128, 1280>((const attn_body::bf16*)(QD + (h * 2 + j) * 64 + (size_t)row0 * 512), (const attn_body::bf16*)(KD + (size_t)(b * 8 + h * 2 + j) * NKEY * 64), (const attn_body::bf16*)(VD + (size_t)(b * 4 + h) * NKEY * 128),
                        (attn_body::bf16*)(YRAW + 256 + j * 512 + h * 128 + (size_t)row0 * 1280), isc ? 4 : 132, (char*)lds_raw, wave0);
                }
            }
        }
        xcd_barrier(xbar, wave0);
        for (int rep_ = 0; rep_ < REP_MERGE; ++rep_) {
            PHASE_IDS
            LAS float* S = (LAS float*)lds;
            const float* go = a.in[opq(27)] + l * 1024;
            const float lam = LAM[l], lam_init = 0.8f - 0.6f * expf(-0.3f * (float)l);
            const int ntile = need_ctx ? 528 : 512;
            for (int tl = bx; tl < ntile; tl += G) {
                const int r0 = tl * 64; const float* yb; int cstride;
                if (r0 < ML) { yb = YH + (size_t)(r0 >> 13) * 256 * 8192 + (r0 & 8191); cstride = 8192; } else { const int rr = r0 - ML; yb = YHC + (size_t)(rr >> 8) * 256 * 256 + (rr & 255); cstride = 256; }
                for (int i = 0; i < 32; ++i) { const int c = i * 8 + wave; S[lane * 257 + c] = yb[(size_t)c * cstride + lane]; }
                __syncthreads();
                for (int k = 0; k < 8; ++k) {
                    const int row = wave * 8 + k, r = r0 + row; const bf16_t* yr = YRAW + (size_t)r * 1280; bf16_t* hr = H + (size_t)r * 1024;
                    { const v2u w = *(const v2u*)(yr + 4 * lane); const float y0 = bflo(w.x), y1 = bfhi(w.x), y2 = bflo(w.y), y3 = bfhi(w.y);
                      const float ss = wave_sum(y0 * y0 + y1 * y1 + y2 * y2 + y3 * y3); const float rinv = 1.0f / sqrtf(ss * (1.0f / 256.0f) + EPSF);
                      const f32x4 g4 = *(const f32x4*)(go + 4 * lane); v2u o; o.x = pk2(y0 * rinv * g4.x, y1 * rinv * g4.y); o.y = pk2(y2 * rinv * g4.z, y3 * rinv * g4.w); *(v2u*)(hr + 4 * lane) = o; }
                    { const float y0 = S[row * 257 + 4 * lane], y1 = S[row * 257 + 4 * lane + 1], y2 = S[row * 257 + 4 * lane + 2], y3 = S[row * 257 + 4 * lane + 3];
                      const float ss = wave_sum(y0 * y0 + y1 * y1 + y2 * y2 + y3 * y3); const float rinv = 1.0f / sqrtf(ss * (1.0f / 256.0f) + EPSF);
                      const f32x4 g4 = *(const f32x4*)(go + 256 + 4 * lane); v2u o; o.x = pk2(y0 * rinv * g4.x, y1 * rinv * g4.y); o.y = pk2(y2 * rinv * g4.z, y3 * rinv * g4.w); *(v2u*)(hr + 256 + 4 * lane) = o; }
                    { const v4u w0 = *(const v4u*)(yr + 256 + 8 * lane), w1 = *(const v4u*)(yr + 768 + 8 * lane);
                      float d[8];
                      d[0] = bflo(w0.x) - lam * bflo(w1.x); d[1] = bfhi(w0.x) - lam * bfhi(w1.x); d[2] = bflo(w0.y) - lam * bflo(w1.y); d[3] = bfhi(w0.y) - lam * bfhi(w1.y);
                      d[4] = bflo(w0.z) - lam * bflo(w1.z); d[5] = bfhi(w0.z) - lam * bfhi(w1.z); d[6] = bflo(w0.w) - lam * bflo(w1.w); d[7] = bfhi(w0.w) - lam * bfhi(w1.w);
                      float ss = 0.f;
#pragma unroll
                      for (int q = 0; q < 8; ++q) ss += d[q] * d[q];
                      ss += shx(ss, 1, lane); ss += shx(ss, 2, lane); ss += shx(ss, 4, lane); ss += shx(ss, 8, lane);
                      const float rinv = (1.0f - lam_init) / sqrtf(ss * (1.0f / 128.0f) + EPSF);
                      const f32x4 ga = *(const f32x4*)(go + 512 + 8 * lane), gb = *(const f32x4*)(go + 512 + 8 * lane + 4);
                      v4u o; o.x = pk2(d[0] * rinv * ga.x, d[1] * rinv * ga.y); o.y = pk2(d[2] * rinv * ga.z, d[3] * rinv * ga.w); o.z = pk2(d[4] * rinv * gb.x, d[5] * rinv * gb.y); o.w = pk2(d[6] * rinv * gb.z, d[7] * rinv * gb.w);
                      *(v4u*)(hr + 512 + 8 * lane) = o; }
                }
                __syncthreads();
            }
        }
        xcd_barrier(xbar, wave0);
        for (int es_ = 0; es_ < EXTRA_SYNC; ++es_) xcd_barrier(xbar, wave0);
        const int M5 = need_ctx ? MT : ML;
        {
            pg8::Gemm g{H, WOUT, M5, 1024, 1024}; pg8::StaticOrder S; S.init(M5, 1024, G, cbx);
            EpiGateRes E{xl, OUT, xc, CTXX, modl + 2048, 0};
            pg8::gemm_phase<EpiGateRes, pg8::StaticOrder, PG8_ALIGN, PG8_SP2>(lds, g, S, E, wave0);
            for (int rep_ = 1; rep_ < REP_GEMM2; ++rep_) { EpiGateRes E2{OUT, OUT, CTXX, CTXX, (const float*)(wsb(a.ws) + 65536), 0}; pg8::gemm_phase<EpiGateRes, pg8::StaticOrder, PG8_ALIGN, PG8_SP2>(lds, g, S, E2, wave0); }
        }
        xcd_barrier(xbar, wave0);
        for (int rep_ = 0; rep_ < REP_N2; ++rep_) { PHASE_IDS norm_mod(OUT, CTXX, a.in[opq(5)] + l * 1024, modl, 3072, 4096, H, M5, gw, NGW, lane); }
        xcd_barrier(xbar, wave0);
        {
            const int ntm = (M5 + 247) / 248;
            pg8::Gemm g{H - 1024, WUP, ntm * 256, 2 * DFF, 1024}; pg8::StaticOrder S; S.init(ntm * 256, 2 * DFF, G, cbx);
            EpiGlu E{GB, a.in[opq(30)] + (size_t)l * 3 * DFF, a.in[opq(31)] + l * DFF, M5};
            pg8::gemm_phase<EpiGlu, pg8::StaticOrder, PG8_ALIGN, PG8_SP2, true>(lds, g, S, E, wave0);
        }
        xcd_barrier(xbar, wave0);
        for (int part = 0; part < (need_ctx ? 2 : 1); ++part) {
            pg8::Gemm g{GB, WDN, M5, 1024, DFF}; DualOrder S; S.base.init(ML, 1024, G, cbx); S.mode = part; S.c = cbx; S.pm0 = ML / 256; S.nN = 4; S.nextra = 16;
            EpiGateRes E{OUT, OUT, CTXX, CTXX, modl + 5120, 0};
            pg8::gemm_phase<EpiGateRes, DualOrder, PG8_ALIGN, PG8_SP2>(lds, g, S, E, wave0);
            if (part == 0 && need_ctx) xcd_barrier(xbar, wave0);
            if (part == 1 && cbx >= 16) { PHASE_IDS __syncthreads();
                prep_work(a, lds, l + 1, l + 1 < DEPTH - 1, cbx - 16, G - 16, true, false, tid, lane, wave);
                norm_mod(OUT, CTXX, a.in[opq(4)] + (l + 1) * 1024, MOD + (size_t)(l + 1) * 5 * 6144, 0, 1024, H, ML, (cbx - 16) * 8 + wave, (G - 16) * 8, lane); }
        }
        xcd_barrier(xbar, wave0);
    }
}

extern "C" void kernel_launch(void* const* d_in, const int* in_sizes, int n_in, void* d_out, int out_size, void* d_ws, size_t ws_size, hipStream_t stream) {
    static int grid = 0;
    if (grid == 0) {
        if (n_in != 33 || out_size != ML * DMOD || ws_size < WS_END) { fprintf(stderr, "kernel_launch: unexpected shapes: n_in %d out %d ws %zu (need %zu)\n", n_in, out_size, ws_size, (size_t)WS_END); grid = -1; return; }
        int dev = 0, cus = 0, per_cu = 0;
        if (hipGetDevice(&dev) != hipSuccess || hipDeviceGetAttribute(&cus, hipDeviceAttributeMultiprocessorCount, dev) != hipSuccess) { grid = -1; return; }
        if (hipFuncSetAttribute((const void*)fwd_mega, hipFuncAttributeMaxDynamicSharedMemorySize, LDS_BYTES) != hipSuccess) { fprintf(stderr, "kernel_launch: hipFuncSetAttribute failed\n"); grid = -1; return; }
        if (hipOccupancyMaxActiveBlocksPerMultiprocessor(&per_cu, (const void*)fwd_mega, NTHR, LDS_BYTES) != hipSuccess || per_cu < 1) { fprintf(stderr, "kernel_launch: occupancy query says %d\n", per_cu); }
        (void)hipGetLastError();
        grid = cus;
    }
    if (grid < 0) return;
    Args a{};
    for (int i = 0; i < 33; ++i) a.in[i] = (const float*)d_in[i];
    a.out = (float*)d_out; a.ws = (unsigned char*)d_ws;
    if (hipMemsetAsync(d_ws, 0, 32768, stream) != hipSuccess) { fprintf(stderr, "kernel_launch: memset failed\n"); return; }
    void* args[] = {&a};
#if PROBE_PLAIN_LAUNCH
    hipLaunchKernelGGL(fwd_mega, dim3(grid), dim3(NTHR), LDS_BYTES, stream, a); const hipError_t e = hipPeekAtLastError(); (void)args;
#else
    const hipError_t e = hipLaunchCooperativeKernel((const void*)fwd_mega, dim3(grid), dim3(NTHR), args, LDS_BYTES, stream);
#endif
    if (e != hipSuccess) fprintf(stderr, "kernel_launch: cooperative launch failed: %s (grid %d)\n", hipGetErrorString(e), grid);
}
```

```cpp
#include <hip/hip_runtime.h>
#include <cstdio>
#include <cstdint>
__device__ __forceinline__ int lane_id_v() { int l; asm volatile("v_mbcnt_lo_u32_b32 %0, -1, 0\n\tv_mbcnt_hi_u32_b32 %0, -1, %0" : "=v"(l)); return l; }
namespace pg8 {
#define PG8_LAS __attribute__((address_space(3)))
typedef unsigned short bf16_t;
typedef short bf16x8 __attribute__((ext_vector_type(8)));
typedef float f32x4 __attribute__((ext_vector_type(4)));
typedef unsigned u32x4 __attribute__((ext_vector_type(4)));
constexpr int BM = 256, BK = 64, HALF = 128, HTB = HALF * BK * 2  , STAGE_BYTES = 8 * HTB, NXCD = 8, WGM = 8;

__host__ __device__ __forceinline__ int lds_byte(int r, int c) { const int st = (r >> 4) * 2 + (c >> 5), rr = r & 15, cc = c & 31, ob = rr * 64 + cc * 2; return st * 1024 + (ob ^ (((ob >> 9) & 1) << 5)); }
__host__ __device__ __forceinline__ void stage_rc(int b, int& R, int& C) { const int st = b / 1024, sb = b % 1024, swz = sb ^ (((sb >> 9) & 1) << 5); R = (st >> 1) * 16 + swz / 64; C = (st & 1) * 32 + (swz % 64) / 2; }
__host__ __device__ __forceinline__ int perm32(int rho) { const int n = rho >> 4, i = rho & 15; return 8 * (i >> 2) + 4 * n + (i & 3); }

struct Unit { int pm, pn; };
struct Gemm { const bf16_t* A; const bf16_t* Bt; int M, N, K; };

struct StaticOrder {
    int nM, nN, nwg, G, c;
    __host__ __device__ void init(int M, int N, int G_, int c_) { nM = M / BM; nN = N / BM; nwg = nM * nN; G = G_; c = c_; }
    __host__ __device__ bool next(int i, Unit& u) const {
        const long L = (long)i * G + c; if (L >= nwg) return false;
        int wgid = (int)L; { const int q = nwg / NXCD, r = nwg % NXCD, xcd = wgid % NXCD, off = wgid / NXCD; wgid = (xcd < r ? xcd * (q + 1) : r * (q + 1) + (xcd - r) * q) + off; }
        const int nig = WGM * nN, gid = wgid / nig, fm = gid * WGM, gsz = (nM - fm) < WGM ? (nM - fm) : WGM;
        u.pm = fm + ((wgid % nig) % gsz); u.pn = (wgid % nig) / gsz; return true;
    }
    __device__ __forceinline__ void a_ready(const Unit&) const {}
    __device__ __forceinline__ void done(const Unit&) const {}
};

__device__ __forceinline__ unsigned cvt_pk_bf16(float lo, float hi) { unsigned r; asm volatile("v_cvt_pk_bf16_f32 %0, %1, %2" : "=v"(r) : "v"(lo), "v"(hi)); return r; }
typedef float f32x2 __attribute__((ext_vector_type(2)));
__device__ __forceinline__ f32x2 gelu_pk(f32x2 v) {
    const f32x2 av = __builtin_elementwise_abs(v), d = av * 0.2316418882f + 1.0f;
    f32x2 t; t.x = __builtin_amdgcn_rcpf(d.x); t.y = __builtin_amdgcn_rcpf(d.y);
    f32x2 q = t * 0.5307027145f + (-0.7265760135f); q = q * t + 0.7107068705f; q = q * t + (-0.142248368f); q = q * t + 0.127414796f; q = q * t;
    const f32x2 s = (v * v) * (-0.72134752044f);
    f32x2 e; e.x = __builtin_amdgcn_exp2f(s.x); e.y = __builtin_amdgcn_exp2f(s.y);
    const f32x2 m = v * (q * e), r = v - m;
    f32x2 o; o.x = v.x < 0.f ? m.x : r.x; o.y = v.y < 0.f ? m.y : r.y; return o;
}

template <int ACT  > struct EpiBf16 {
    static constexpr bool PERM = true, AFTER_DRAIN = false; static_assert(ACT == 0 || ACT == 1, "EpiBf16: ACT is 0 (none) or 1 (gelu_pk)");
    bf16_t* O; int ldc; const float* bias; int split_cols; size_t split_stride; float scale0;
    __device__ __forceinline__ void operator()(const f32x4 (&acc)[2][2][4][2], const Unit& u, int wr, int wc, int fr, int fq) const {
        const int row0 = u.pm * BM + wr * 64 + fr; int colt = u.pn * BM; bf16_t* base = O;
        float sc = 1.f; if (split_cols) { const int t = colt / split_cols; base += (size_t)t * split_stride; colt -= t * split_cols; if (t == 0) sc = scale0; }
        const int col0 = colt + wc * 32 + 8 * fq, bcol0 = u.pn * BM + wc * 32 + 8 * fq;
        f32x4 bv[2][2];
#pragma unroll
        for (int bj = 0; bj < 2; ++bj)
#pragma unroll
            for (int n = 0; n < 2; ++n) bv[bj][n] = bias ? *(const f32x4*)(bias + bcol0 + bj * HALF + 4 * n) : (f32x4){0.f, 0.f, 0.f, 0.f};
#pragma unroll
        for (int ai = 0; ai < 2; ++ai)
#pragma unroll
            for (int m = 0; m < 4; ++m) { bf16_t* rowp = base + (size_t)(row0 + ai * HALF + m * 16) * ldc + col0;
#pragma unroll
                for (int bj = 0; bj < 2; ++bj) { f32x4 v0 = acc[ai][bj][m][0] + bv[bj][0], v1 = acc[ai][bj][m][1] + bv[bj][1];
                    if (ACT == 1) { f32x2 a = gelu_pk((f32x2){v0[0], v0[1]}), b = gelu_pk((f32x2){v0[2], v0[3]}), c = gelu_pk((f32x2){v1[0], v1[1]}), d = gelu_pk((f32x2){v1[2], v1[3]});
                        v0 = (f32x4){a.x, a.y, b.x, b.y}; v1 = (f32x4){c.x, c.y, d.x, d.y}; }
                    v0 = v0 * sc; v1 = v1 * sc; u32x4 w; w.x = cvt_pk_bf16(v0[0], v0[1]); w.y = cvt_pk_bf16(v0[2], v0[3]); w.z = cvt_pk_bf16(v1[0], v1[1]); w.w = cvt_pk_bf16(v1[2], v1[3]);
                    *(u32x4*)(rowp + bj * HALF) = w; } }
    }
};
template <class Epi, class Sched, bool ALIGN_EPI = false, bool SP2 = false, bool HALO = false>
__device__ __forceinline__ void gemm_phase(PG8_LAS unsigned char* lds, const Gemm g, const Sched& S, const Epi& E, const int wave0) {
    int tid_o = wave0 * 64 + lane_id_v(); asm volatile("" : "+v"(tid_o));
    const int tid = tid_o, wid = __builtin_amdgcn_readfirstlane(tid >> 6), lane = tid & 63, wr = wid >> 2, wc = wid & 3, fr = lane & 15, fq = lane >> 4;
    const int K = g.K, nt = K / BK;
    unsigned voffA[2], voffB[2];
#pragma unroll
    for (int i = 0; i < 2; ++i) { int R, C; stage_rc(tid * 16 + i * 8192, R, C); const int Rb = Epi::PERM ? ((R & ~31) + perm32(R & 31)) : R;
        voffA[i] = HALO ? (unsigned)(((R & 63) + 62 * (R >> 6)) * K + C) * 2u : (unsigned)(R * K + C) * 2u; voffB[i] = (unsigned)(Rb * K + C) * 2u; }
    const size_t kstep = (size_t)(BK * 2);
    const size_t hstep = (size_t)HALF * K * 2;
    const size_t tstep = 2 * hstep;
    const size_t hstepA = HALO ? (size_t)124 * K * 2 : hstep, tstepA = 2 * hstepA;
    const unsigned ldsw = (unsigned)wid * 1024u;
    const int aoff = lds_byte(wr * 64 + fr, fq * 8), boff = lds_byte(wc * 32 + fr, fq * 8);
#define PG8_SA(b, h) (((b) * 2 + (h)) * HTB)
#define PG8_SB(b, h) ((4 + (b) * 2 + (h)) * HTB)
#define PG8_STAGE(bufoff, gbase, voff) do { _Pragma("unroll") for (int _i = 0; _i < 2; ++_i) \
        __builtin_amdgcn_global_load_lds((const unsigned*)((const char*)(gbase) + (voff)[_i]), (PG8_LAS unsigned*)(lds + (bufoff) + ldsw + _i * 8192), 16, 0, 0); } while (0)
#define PG8_LDA(dst, b, h) do { _Pragma("unroll") for (int m = 0; m < 4; ++m) _Pragma("unroll") for (int k = 0; k < 2; ++k) dst[m][k] = *(const PG8_LAS bf16x8*)(lds + PG8_SA(b, h) + aoff + m * 2048 + k * 1024); } while (0)
#define PG8_LDB(dst, b, h) do { _Pragma("unroll") for (int n = 0; n < 2; ++n) _Pragma("unroll") for (int k = 0; k < 2; ++k) dst[n][k] = *(const PG8_LAS bf16x8*)(lds + PG8_SB(b, h) + boff + n * 2048 + k * 1024); } while (0)
#define PG8_MMA(ai, bj, At, Bt) do { __builtin_amdgcn_s_setprio(1); _Pragma("unroll") for (int m = 0; m < 4; ++m) _Pragma("unroll") for (int n = 0; n < 2; ++n) _Pragma("unroll") for (int k = 0; k < 2; ++k) \
        acc[ai][bj][m][n] = __builtin_amdgcn_mfma_f32_16x16x32_bf16(Bt[n][k], At[m][k], acc[ai][bj][m][n], 0, 0, 0); __builtin_amdgcn_s_setprio(0); } while (0)
#define PG8_WAIT_V(n) asm volatile("s_waitcnt vmcnt(" #n ")" ::: "memory")
#define PG8_WAIT_L(n) asm volatile("s_waitcnt lgkmcnt(" #n ")" ::: "memory")
#define PG8_BAR __builtin_amdgcn_s_barrier()
#define PG8_SCHED __builtin_amdgcn_sched_barrier(0)
    Unit cur, nxt; int ui = 0;
    if (!S.next(0, cur)) return;
    f32x4 acc[2][2][4][2];
#pragma unroll
    for (int a = 0; a < 2; ++a)
#pragma unroll
        for (int b = 0; b < 2; ++b)
#pragma unroll
            for (int m = 0; m < 4; ++m)
#pragma unroll
                for (int n = 0; n < 2; ++n) acc[a][b][m][n] = (f32x4){0.f, 0.f, 0.f, 0.f};
    bf16x8 At[4][2], B0[2][2], B1[2][2];
    const char* cA = (const char*)g.A + (size_t)cur.pm * tstepA; const char* cB = (const char*)g.Bt + (size_t)cur.pn * tstep;
    S.a_ready(cur);
    if constexpr (SP2) {
        PG8_STAGE(PG8_SB(0, 0), cB, voffB); PG8_STAGE(PG8_SB(0, 1), cB + hstep, voffB); PG8_STAGE(PG8_SA(0, 0), cA, voffA); PG8_STAGE(PG8_SA(0, 1), cA + hstepA, voffA);
        if (wr == 1) PG8_BAR;
        PG8_WAIT_V(2); PG8_BAR;
        PG8_STAGE(PG8_SB(1, 0), cB + kstep, voffB); PG8_STAGE(PG8_SA(1, 0), cA + kstep, voffA); PG8_STAGE(PG8_SB(1, 1), cB + hstep + kstep, voffB);
        PG8_WAIT_V(6); PG8_BAR;
    } else {
        PG8_STAGE(PG8_SB(0, 0), cB, voffB); PG8_STAGE(PG8_SA(0, 0), cA, voffA); PG8_STAGE(PG8_SB(0, 1), cB + hstep, voffB); PG8_STAGE(PG8_SA(0, 1), cA + hstepA, voffA);
        if (wr == 1) PG8_BAR;
        PG8_WAIT_V(4); PG8_BAR;
        PG8_STAGE(PG8_SB(1, 0), cB + kstep, voffB); PG8_STAGE(PG8_SA(1, 0), cA + kstep, voffA); PG8_STAGE(PG8_SB(1, 1), cB + hstep + kstep, voffB);
        PG8_WAIT_V(6); PG8_BAR;
    }
    for (;;) {
        const bool has_next = S.next(ui + 1, nxt);
        const char* nA = has_next ? (const char*)g.A + (size_t)nxt.pm * tstepA : cA; const char* nB = has_next ? (const char*)g.Bt + (size_t)nxt.pn * tstep : cB;
        for (int t = 0; t < nt; t += 2) {
            const bool last = (t == nt - 2);
            const char* a1 = cA + (size_t)(t + 1) * kstep;
            const char* a2 = last ? nA : cA + (size_t)(t + 2) * kstep; const char* b2 = last ? nB : cB + (size_t)(t + 2) * kstep;
            const char* a3 = a2 + kstep; const char* b3 = b2 + kstep;
            if (last && has_next) S.a_ready(nxt);
            if constexpr (SP2) {
            PG8_LDB(B0, 0, 0); PG8_LDB(B1, 0, 1); PG8_SCHED; PG8_LDA(At, 0, 0); PG8_STAGE(PG8_SA(1, 1), a1 + hstepA, voffA);
            PG8_WAIT_V(8); PG8_WAIT_L(0); PG8_BAR; PG8_MMA(0, 0, At, B0); PG8_MMA(0, 1, At, B1); PG8_BAR; PG8_SCHED;
            PG8_LDA(At, 0, 1); PG8_STAGE(PG8_SB(0, 0), b2, voffB); PG8_STAGE(PG8_SB(0, 1), b2 + hstep, voffB); PG8_STAGE(PG8_SA(0, 0), a2, voffA);
            PG8_WAIT_V(8); PG8_WAIT_L(0); PG8_BAR; PG8_MMA(1, 0, At, B0); PG8_MMA(1, 1, At, B1); PG8_BAR; PG8_SCHED;
            PG8_LDB(B0, 1, 0); PG8_LDB(B1, 1, 1); PG8_SCHED; PG8_LDA(At, 1, 0); PG8_STAGE(PG8_SA(0, 1), a2 + hstepA, voffA);
            PG8_WAIT_V(8); PG8_WAIT_L(0); PG8_BAR; PG8_MMA(0, 0, At, B0); PG8_MMA(0, 1, At, B1); PG8_BAR; PG8_SCHED;
            PG8_LDA(At, 1, 1); PG8_STAGE(PG8_SB(1, 0), b3, voffB); PG8_STAGE(PG8_SB(1, 1), b3 + hstep, voffB); PG8_STAGE(PG8_SA(1, 0), a3, voffA);
            PG8_WAIT_V(8); PG8_WAIT_L(0); PG8_BAR; PG8_MMA(1, 0, At, B0); PG8_MMA(1, 1, At, B1); PG8_BAR; PG8_SCHED;
            } else {
            PG8_LDB(B0, 0, 0); PG8_SCHED; PG8_LDA(At, 0, 0); PG8_STAGE(PG8_SA(1, 1), a1 + hstepA, voffA);
            PG8_WAIT_L(8); PG8_BAR; PG8_WAIT_L(0); PG8_MMA(0, 0, At, B0); PG8_BAR; PG8_SCHED;
            PG8_LDB(B1, 0, 1); PG8_STAGE(PG8_SB(0, 0), b2, voffB);
            PG8_BAR; PG8_WAIT_L(0); PG8_MMA(0, 1, At, B1); PG8_BAR;
            PG8_LDA(At, 0, 1); PG8_STAGE(PG8_SA(0, 0), a2, voffA);
            PG8_BAR; PG8_WAIT_L(0); PG8_MMA(1, 0, At, B0); PG8_BAR; PG8_SCHED;
            PG8_STAGE(PG8_SB(0, 1), b2 + hstep, voffB);
            PG8_WAIT_V(6); PG8_BAR; PG8_MMA(1, 1, At, B1); PG8_BAR;
            PG8_LDB(B0, 1, 0); PG8_SCHED; PG8_LDA(At, 1, 0); PG8_STAGE(PG8_SA(0, 1), a2 + hstepA, voffA);
            PG8_WAIT_L(8); PG8_BAR; PG8_WAIT_L(0); PG8_MMA(0, 0, At, B0); PG8_BAR; PG8_SCHED;
            PG8_LDB(B1, 1, 1); PG8_STAGE(PG8_SB(1, 0), b3, voffB);
            PG8_BAR; PG8_WAIT_L(0); PG8_MMA(0, 1, At, B1); PG8_BAR;
            PG8_LDA(At, 1, 1); PG8_STAGE(PG8_SA(1, 0), a3, voffA);
            PG8_BAR; PG8_WAIT_L(0); PG8_MMA(1, 0, At, B0); PG8_BAR; PG8_SCHED;
            PG8_STAGE(PG8_SB(1, 1), b3 + hstep, voffB);
            PG8_WAIT_V(6); PG8_BAR; PG8_MMA(1, 1, At, B1); PG8_BAR;
            }
        }
        if constexpr (ALIGN_EPI) { if (wr == 0) PG8_BAR; }
        if constexpr (!Epi::AFTER_DRAIN) { E(acc, cur, wr, wc, fr, fq); S.done(cur); }
        if (!has_next) break;
#pragma unroll
        for (int a = 0; a < 2; ++a)
#pragma unroll
            for (int b = 0; b < 2; ++b)
#pragma unroll
                for (int m = 0; m < 4; ++m)
#pragma unroll
                    for (int n = 0; n < 2; ++n) acc[a][b][m][n] = (f32x4){0.f, 0.f, 0.f, 0.f};
        cur = nxt; cA = nA; cB = nB; ++ui;
        if constexpr (ALIGN_EPI) { if (wr == 1) PG8_BAR; }
    }
    PG8_WAIT_V(0);
    if constexpr (!ALIGN_EPI) { if (wr == 0) PG8_BAR; }
    PG8_BAR;
    if constexpr (Epi::AFTER_DRAIN) { E.fused(acc, cur, wr, wc, fr, fq, lds, wid, lane); S.done(cur); }
#undef PG8_SA
#undef PG8_SB
#undef PG8_STAGE
#undef PG8_LDA
#undef PG8_LDB
#undef PG8_MMA
#undef PG8_WAIT_V
#undef PG8_WAIT_L
#undef PG8_BAR
#undef PG8_SCHED
}
}

#ifndef PG8_SP2
#define PG8_SP2 true
#endif
#ifndef PG8_ALIGN
#define PG8_ALIGN true
#endif
#include <hip/hip_bf16.h>
#include <cmath>
namespace attn_body {
using bf16=__hip_bfloat16;
using bf16x8=__attribute__((ext_vector_type(8)))short;
using s16x4=__attribute__((ext_vector_type(4)))short;
using f32x16=__attribute__((ext_vector_type(16)))float;
using u32x4=__attribute__((ext_vector_type(4)))unsigned;
constexpr int D=64;
constexpr int NW=8,QBLK=32,QB=QBLK*NW,KVBLK=64;
constexpr int ATTN_UNIT_ROWS=QB;
__device__ __forceinline__ int crow(int r,int hi){return (r&3)+8*(r>>2)+4*hi;}
#define SBAR() __builtin_amdgcn_sched_barrier(0)
__device__ __forceinline__ void cmask(f32x16&p0,f32x16&p1,int jb,int qrel,int hi){
  const float NEG=-INFINITY; int kb=64*jb+4*hi;
  #pragma unroll
  for(int r=0;r<16;++r){int kv=kb+(r&3)+8*(r>>2); if(kv>qrel)p0[r]=NEG; if(kv+32>qrel)p1[r]=NEG;}
}

constexpr int NSLOT=3, SLOTB=8192;
constexpr int LDS_K=0, LDS_V=NSLOT*SLOTB, LDS_WS=2*NSLOT*SLOTB, LDS_OST=LDS_WS+NW*64*4, LDS_BYTES=LDS_OST+NW*4096;
constexpr float C2=0.125f*1.4426950408889634f;
__device__ __forceinline__ void glds16(const void*gsrc,unsigned lds_dst){unsigned keep;
  asm volatile("s_mov_b32 %0, m0\n\ts_mov_b32 m0, %2\n\ts_nop 0\n\tglobal_load_lds_dwordx4 %1, off\n\ts_mov_b32 m0, %0":"=&s"(keep):"v"(gsrc),"s"(lds_dst):"memory");}
__device__ __forceinline__ float max3f(float a,float b,float c){float r;asm("v_max3_f32 %0, %1, %2, %3":"=v"(r):"v"(a),"v"(b),"v"(c));return r;}
__device__ __forceinline__ float max2f(float a,float b){float r;asm("v_max_f32_e32 %0, %1, %2":"=v"(r):"v"(a),"v"(b));return r;}
__device__ __forceinline__ float fadd_s(float a,float b){float r;asm("v_add_f32_e32 %0, %1, %2":"=v"(r):"v"(a),"v"(b));return r;}
__device__ __forceinline__ float fsub_s(float a,float b){float r;asm("v_sub_f32_e32 %0, %1, %2":"=v"(r):"v"(a),"v"(b));return r;}
typedef float f32x2_t __attribute__((ext_vector_type(2))); typedef __bf16 bf16x2_t __attribute__((ext_vector_type(2)));
__device__ __forceinline__ unsigned cvtpk_s(float lo,float hi){f32x2_t v={lo,hi};bf16x2_t b=__builtin_convertvector(v,bf16x2_t);return __builtin_bit_cast(unsigned,b);}
#define WAIT_BAR(N) asm volatile("s_waitcnt vmcnt(" #N ") lgkmcnt(0)\n\ts_barrier":::"memory")

__device__ __forceinline__ void qkt(f32x16&p0,f32x16&p1,const char*Kslot,const bf16x8*qr,const f32x16&negm,int r32,int hi){
  const char*kb=Kslot+hi*1024+r32*16;
  #pragma unroll
  for(int d0=0;d0<4;++d0){
    const bf16x8 b0=*reinterpret_cast<const bf16x8*>(kb+d0*2048);
    const bf16x8 b1=*reinterpret_cast<const bf16x8*>(kb+d0*2048+512);
    if(d0==0){p0=__builtin_amdgcn_mfma_f32_32x32x16_bf16(b0,qr[0],negm,0,0,0);p1=__builtin_amdgcn_mfma_f32_32x32x16_bf16(b1,qr[0],negm,0,0,0);}
    else{p0=__builtin_amdgcn_mfma_f32_32x32x16_bf16(b0,qr[d0],p0,0,0,0);p1=__builtin_amdgcn_mfma_f32_32x32x16_bf16(b1,qr[d0],p1,0,0,0);}}
}
typedef __attribute__((address_space(3))) const char* lds_cptr;
typedef short v4i16_t __attribute__((ext_vector_type(4)));
__device__ __forceinline__ void kload8(bf16x8*kf,lds_cptr kp){
  kf[0]=*(const __attribute__((address_space(3))) bf16x8*)(kp);      kf[1]=*(const __attribute__((address_space(3))) bf16x8*)(kp+512);
  kf[2]=*(const __attribute__((address_space(3))) bf16x8*)(kp+2048); kf[3]=*(const __attribute__((address_space(3))) bf16x8*)(kp+2560);
  kf[4]=*(const __attribute__((address_space(3))) bf16x8*)(kp+4096); kf[5]=*(const __attribute__((address_space(3))) bf16x8*)(kp+4608);
  kf[6]=*(const __attribute__((address_space(3))) bf16x8*)(kp+6144); kf[7]=*(const __attribute__((address_space(3))) bf16x8*)(kp+6656);
}
__device__ __forceinline__ void kload2(bf16x8*kf,lds_cptr kp,int j){ kf[2*j]=*(const __attribute__((address_space(3))) bf16x8*)(kp+j*2048); kf[2*j+1]=*(const __attribute__((address_space(3))) bf16x8*)(kp+j*2048+512); }
__device__ __forceinline__ s16x4 vtr(lds_cptr p){ return __builtin_bit_cast(s16x4,__builtin_amdgcn_ds_read_tr16_b64_v4i16((__attribute__((address_space(3))) v4i16_t*)p)); }
__device__ __forceinline__ float rowmax(const f32x16&p0,const f32x16&p1){
  float a=max3f(p0[0],p0[1],p1[0]),b=max3f(p0[2],p0[3],p1[1]);a=max3f(a,p1[2],p1[3]);
  #pragma unroll
  for(int r=4;r<16;r+=4){a=max3f(a,p0[r],p0[r+1]);b=max3f(b,p0[r+2],p0[r+3]);a=max3f(a,p1[r],p1[r+1]);b=max3f(b,p1[r+2],p1[r+3]);}
  const float m=max2f(a,b);
  auto rr=__builtin_amdgcn_permlane32_swap(__float_as_uint(m),__float_as_uint(m),false,false);
  return max2f(__uint_as_float(rr[0]),__uint_as_float(rr[1]));
}
__device__ __forceinline__ void pv(f32x16*o,int vb,bf16x8 pa0,bf16x8 pa1,bf16x8 pa2,bf16x8 pa3){
  #pragma unroll
  for(int d0=0;d0<2;++d0){s16x4 lo[4],hi[4];
    #pragma unroll
    for(int ks=0;ks<4;++ks){
      asm volatile("ds_read_b64_tr_b16 %0,%1 offset:%c2":"=&v"(lo[ks]):"v"(vb),"i"(d0*4096+ks*1024):"memory");
      asm volatile("ds_read_b64_tr_b16 %0,%1 offset:%c2":"=&v"(hi[ks]):"v"(vb),"i"(d0*4096+ks*1024+512):"memory");}
    asm volatile("s_waitcnt lgkmcnt(0)":::"memory");SBAR();
    #define PK(k) (bf16x8){lo[k][0],lo[k][1],lo[k][2],lo[k][3],hi[k][0],hi[k][1],hi[k][2],hi[k][3]}
    o[d0]=__builtin_amdgcn_mfma_f32_32x32x16_bf16(pa0,PK(0),o[d0],0,0,0);
    o[d0]=__builtin_amdgcn_mfma_f32_32x32x16_bf16(pa1,PK(1),o[d0],0,0,0);
    o[d0]=__builtin_amdgcn_mfma_f32_32x32x16_bf16(pa2,PK(2),o[d0],0,0,0);
    o[d0]=__builtin_amdgcn_mfma_f32_32x32x16_bf16(pa3,PK(3),o[d0],0,0,0);
    #undef PK
  }
}

#ifndef ATTN_STORE16
#define ATTN_STORE16(p,v) (*(u32x4*)(p)=(v))
#endif
template<int THRL,bool DV128,int PQ,int PK,int PV,int PO> __device__ __forceinline__ void attn_unit(const bf16*Qb,const bf16*__restrict__ Kb,const bf16*__restrict__ Vb,bf16*Ob,const int NT,char*shm,const int wave0){
  int tid_o=wave0*64+lane_id_v(); asm volatile("":"+v"(tid_o)); const int tid=tid_o,lane=tid&63,r32=lane&31,hi=lane>>5; const int wid=__builtin_amdgcn_readfirstlane(tid>>6);
  const bf16*Qw=Qb+(long)(wid*QBLK)*PQ;
  const bf16*Kh=Kb,*Vh=Vb;
  const unsigned lds0=(unsigned)(uintptr_t)shm;
  constexpr int VS=DV128?2:1, L_WS=LDS_V+NSLOT*SLOTB*VS, L_OST=L_WS+NW*64*4;
  float*wsf=(float*)(shm+L_WS)+wid*64;
  const bf16*ksrc=Kh+(long)lane*PK+wid*8;
  const bf16*vsrc=Vh+(long)(16*(wid&3)+(lane>>2))*PV+(wid>>2)*32+(lane&3)*8;
  const unsigned kdst=lds0+LDS_K+wid*1024, vdst=lds0+LDS_V+wid*1024;
  #define DMA_K(t,slot) glds16(ksrc+(long)(t)*KVBLK*PK,(unsigned)__builtin_amdgcn_readfirstlane(kdst+(slot)))
  #define DMA_V(t,slot) do{ glds16(vsrc+(long)(t)*KVBLK*PV,(unsigned)__builtin_amdgcn_readfirstlane(vdst+VS*(slot))); if constexpr(DV128){ glds16(vsrc+64+(long)(t)*KVBLK*PV,(unsigned)__builtin_amdgcn_readfirstlane(vdst+VS*(slot)+8192)); } }while(0)
  const char*Kbase=shm+LDS_K; bf16x8 kf[8];
  const lds_cptr shm3=(lds_cptr)shm; const lds_cptr kp0=shm3+LDS_K+hi*1024+r32*16; const lds_cptr vp0=shm3+LDS_V+((lane>>4)&1)*32+(lane&3)*8+(4*hi+((lane&15)>>2))*64;
  DMA_K(0,0);DMA_V(0,0);DMA_K(1,SLOTB);
  bf16x8 qr[4];
  #pragma unroll
  for(int d0=0;d0<4;++d0)qr[d0]=*reinterpret_cast<const bf16x8*>(&Qw[(long)r32*PQ+d0*16+hi*8]);
  float mhat=0.f,l_reg=0.f;f32x16 o[4];o[0]=f32x16{};o[1]=f32x16{};o[2]=f32x16{};o[3]=f32x16{};f32x16 negm=f32x16{};asm volatile("":"+v"(negm));
  #define CMASK(P0,P1,t) do{}while(0)
  bool resc=false;
  #define START(P0,P1) do{ const float rm=rowmax(P0,P1); resc=false; \
    { const float dl=rm; mhat=fadd_s(mhat,dl); \
      _Pragma("unroll") for(int r=0;r<16;++r){P0[r]=fsub_s(P0[r],dl);P1[r]=fsub_s(P1[r],dl);} \
      _Pragma("unroll") for(int r=0;r<16;++r)negm[r]=-mhat; asm volatile("":"+v"(negm)); } \
    _Pragma("unroll") for(int r=0;r<16;++r)P0[r]=__builtin_amdgcn_exp2f(P0[r]); }while(0)
  #define RESC() do{ if(resc){ asm volatile("s_waitcnt lgkmcnt(0)":::"memory"); \
      _Pragma("unroll") for(int d_=0;d_<2*VS;++d_) _Pragma("unroll") for(int r=0;r<16;++r)o[d_][r]*=wsf[crow(r,hi)]; } }while(0)
  f32x16 pA0,pA1,pB0,pB1;
  int sl_prev=0,sl_cur=0,sl_next=SLOTB;
  #define ROT() do{sl_prev=sl_cur;sl_cur=sl_next;sl_next=(sl_next==(NSLOT-1)*SLOTB)?0:sl_next+SLOTB;}while(0)
  DMA_K(2,2*SLOTB);
  WAIT_BAR(3);
  qkt(pA0,pA1,Kbase,qr,negm,r32,hi);asm volatile("s_nop 15\n\ts_nop 7":"+v"(pA0),"+v"(pA1));CMASK(pA0,pA1,0);
  START(pA0,pA1);
  _Pragma("unroll") for(int r=0;r<16;++r)pA1[r]=__builtin_amdgcn_exp2f(pA1[r]);
  WAIT_BAR(0);
  DMA_K(3,0);DMA_V(1,SLOTB);
  ROT();
  kload8(kf,kp0+sl_cur);
  #define WB2() do{ if constexpr(DV128){WAIT_BAR(3);}else{WAIT_BAR(2);} }while(0)
  #define WB1() do{ if constexpr(DV128){WAIT_BAR(2);}else{WAIT_BAR(1);} }while(0)
  WB2();
  s16x4 vlo[8],vhi[8]; u32x4 pw0,pw1,pw2,pw3;
  #define PKW(P,B) cvtpk_s(P[B],P[B+1])
  #define PAF(k) __builtin_bit_cast(bf16x8,pw##k)
  #define VFR(i) (bf16x8){vlo[i][0],vlo[i][1],vlo[i][2],vlo[i][3],vhi[i][0],vhi[i][1],vhi[i][2],vhi[i][3]}
  #define PIN(x) asm volatile("":"+v"(x))
  #define MX3(a,b,c) __builtin_fmaxf(__builtin_fmaxf((a),(b)),(c))
  #define GAPA(MF,A0,A1,A2,A3,W0,W1,PW) do{ MF; sacc+=A0; sacc+=A1; sacc+=A2; sacc+=A3; PIN(sacc); W0; W1; PIN(PW); SBAR(); }while(0)
  #define EX(v) __builtin_amdgcn_exp2f(v)
  #define GAPC(MF,X,B) do{ MF; X[B]=EX(X[B]); X[B+1]=EX(X[B+1]); PIN(X); SBAR(); }while(0)
  #define GAPB(MF,X,B) do{ MF; X[B]=EX(X[B]); X[B+1]=EX(X[B+1]); X[B+2]=EX(X[B+2]); X[B+3]=EX(X[B+3]); PIN(X); SBAR(); }while(0)
  #define VRD(i) do{ vlo[i]=vtr(vp_+(((i)>>2)*4096+((i)&3)*1024)); vhi[i]=vtr(vp_+(((i)>>2)*4096+((i)&3)*1024+512)); }while(0)
  #define KRD(G,j) do{ if(G){ kload2(kf,kp0+sl_next,j); SBAR(); } }while(0)
  #define STEP(C0,C1,P0,P1,t,GK,GV,GL) do{ SBAR(); \
    const lds_cptr vp_=vp0+VS*sl_prev; \
    VRD(0); SBAR(); float sacc=(P0[0]+P0[1]); \
    GAPA(C0=__builtin_amdgcn_mfma_f32_32x32x16_bf16(kf[0],qr[0],negm,0,0,0), P0[2],P0[3],P0[4],P0[5],     pw0[0]=PKW(P0,0), pw0[1]=PKW(P0,2), pw0); \
    VRD(4); SBAR(); GAPA(C1=__builtin_amdgcn_mfma_f32_32x32x16_bf16(kf[1],qr[0],negm,0,0,0), P0[6],P0[7],P0[8],P0[9],     pw0[2]=PKW(P0,4), pw0[3]=PKW(P0,6), pw0); \
    VRD(1); SBAR(); GAPA(C0=__builtin_amdgcn_mfma_f32_32x32x16_bf16(kf[2],qr[1],C0,0,0,0),   P0[10],P0[11],P0[12],P0[13], pw1[0]=PKW(P0,8), pw1[1]=PKW(P0,10), pw1); \
    VRD(5); SBAR(); GAPA(C1=__builtin_amdgcn_mfma_f32_32x32x16_bf16(kf[3],qr[1],C1,0,0,0),   P0[14],P0[15],P1[0],P1[1],   pw1[2]=PKW(P0,12),pw1[3]=PKW(P0,14), pw1); \
    VRD(2); SBAR(); GAPA(C0=__builtin_amdgcn_mfma_f32_32x32x16_bf16(kf[4],qr[2],C0,0,0,0),   P1[2],P1[3],P1[4],P1[5],     pw2[0]=PKW(P1,0), pw2[1]=PKW(P1,2), pw2); \
    VRD(6); SBAR(); GAPA(C1=__builtin_amdgcn_mfma_f32_32x32x16_bf16(kf[5],qr[2],C1,0,0,0),   P1[6],P1[7],P1[8],P1[9],     pw2[2]=PKW(P1,4), pw2[3]=PKW(P1,6), pw2); \
    VRD(3); SBAR(); GAPA(C0=__builtin_amdgcn_mfma_f32_32x32x16_bf16(kf[6],qr[3],C0,0,0,0),   P1[10],P1[11],P1[12],P1[13], pw3[0]=PKW(P1,8), pw3[1]=PKW(P1,10), pw3); \
    VRD(7); SBAR(); GAPA(C1=__builtin_amdgcn_mfma_f32_32x32x16_bf16(kf[7],qr[3],C1,0,0,0),   P1[14],P1[15],0.f,0.f,       pw3[2]=PKW(P1,12),pw3[3]=PKW(P1,14), pw3); \
    l_reg+=sacc; \
    if(GK){DMA_K((t)+3,sl_cur);} if(GV){DMA_V((t)+1,sl_next);} \
    CMASK(C0,C1,t); \
    { float a=MX3(C0[0],C0[1],C1[0]),b=MX3(C0[2],C0[3],C1[1]); a=MX3(a,C1[2],C1[3]); \
      _Pragma("unroll") for(int r=4;r<16;r+=4){a=MX3(a,C0[r],C0[r+1]);b=MX3(b,C0[r+2],C0[r+3]);a=MX3(a,C1[r],C1[r+1]);b=MX3(b,C1[r+2],C1[r+3]);} \
      float rm=__builtin_fmaxf(a,b); { auto rr=__builtin_amdgcn_permlane32_swap(__float_as_uint(rm),__float_as_uint(rm),false,false); rm=__builtin_fmaxf(__uint_as_float(rr[0]),__uint_as_float(rr[1])); } \
      resc=false; \
      if(__builtin_expect(__any(rm>(float)THRL),0)){ const float dl=__builtin_fmaxf(rm,0.f); mhat+=dl; \
        _Pragma("unroll") for(int r=0;r<16;++r){C0[r]-=dl;C1[r]-=dl;} \
        _Pragma("unroll") for(int r=0;r<16;++r)negm[r]=-mhat; asm volatile("":"+v"(negm)); \
        const float f=__builtin_amdgcn_exp2f(-dl); l_reg*=f; if(hi==0)wsf[r32]=f; resc=true; } } \
    SBAR(); \
    GAPB(o[0]=__builtin_amdgcn_mfma_f32_32x32x16_bf16(PAF(0),VFR(0),o[0],0,0,0), C0,0); \
    GAPB(o[1]=__builtin_amdgcn_mfma_f32_32x32x16_bf16(PAF(0),VFR(4),o[1],0,0,0), C0,4); \
    KRD(GL,0); GAPB(o[0]=__builtin_amdgcn_mfma_f32_32x32x16_bf16(PAF(1),VFR(1),o[0],0,0,0), C0,8); \
    KRD(GL,1); GAPB(o[1]=__builtin_amdgcn_mfma_f32_32x32x16_bf16(PAF(1),VFR(5),o[1],0,0,0), C0,12); \
    KRD(GL,2); GAPB(o[0]=__builtin_amdgcn_mfma_f32_32x32x16_bf16(PAF(2),VFR(2),o[0],0,0,0), C1,0); \
    KRD(GL,3); GAPB(o[1]=__builtin_amdgcn_mfma_f32_32x32x16_bf16(PAF(2),VFR(6),o[1],0,0,0), C1,4); \
    GAPB(o[0]=__builtin_amdgcn_mfma_f32_32x32x16_bf16(PAF(3),VFR(3),o[0],0,0,0), C1,8); \
    GAPB(o[1]=__builtin_amdgcn_mfma_f32_32x32x16_bf16(PAF(3),VFR(7),o[1],0,0,0), C1,12); \
    }while(0)
  #define VRD2(i) do{ vlo[i]=vtr(vp_+(8192+((i)>>2)*4096+((i)&3)*1024)); vhi[i]=vtr(vp_+(8192+((i)>>2)*4096+((i)&3)*1024+512)); }while(0)
  #define STEP128(C0,C1,P0,P1,t,GK,GV,GL) do{ SBAR(); \
    const lds_cptr vp_=vp0+VS*sl_prev; \
    float sacc=(P0[0]+P0[1]); \
    GAPA(C0=__builtin_amdgcn_mfma_f32_32x32x16_bf16(kf[0],qr[0],negm,0,0,0), P0[2],P0[3],P0[4],P0[5],     pw0[0]=PKW(P0,0), pw0[1]=PKW(P0,2), pw0); \
    GAPA(C1=__builtin_amdgcn_mfma_f32_32x32x16_bf16(kf[1],qr[0],negm,0,0,0), P0[6],P0[7],P0[8],P0[9],     pw0[2]=PKW(P0,4), pw0[3]=PKW(P0,6), pw0); \
    GAPA(C0=__builtin_amdgcn_mfma_f32_32x32x16_bf16(kf[2],qr[1],C0,0,0,0),   P0[10],P0[11],P0[12],P0[13], pw1[0]=PKW(P0,8), pw1[1]=PKW(P0,10), pw1); \
    GAPA(C1=__builtin_amdgcn_mfma_f32_32x32x16_bf16(kf[3],qr[1],C1,0,0,0),   P0[14],P0[15],P1[0],P1[1],   pw1[2]=PKW(P0,12),pw1[3]=PKW(P0,14), pw1); \
    GAPA(C0=__builtin_amdgcn_mfma_f32_32x32x16_bf16(kf[4],qr[2],C0,0,0,0),   P1[2],P1[3],P1[4],P1[5],     pw2[0]=PKW(P1,0), pw2[1]=PKW(P1,2), pw2); \
    GAPA(C1=__builtin_amdgcn_mfma_f32_32x32x16_bf16(kf[5],qr[2],C1,0,0,0),   P1[6],P1[7],P1[8],P1[9],     pw2[2]=PKW(P1,4), pw2[3]=PKW(P1,6), pw2); \
    GAPA(C0=__builtin_amdgcn_mfma_f32_32x32x16_bf16(kf[6],qr[3],C0,0,0,0),   P1[10],P1[11],P1[12],P1[13], pw3[0]=PKW(P1,8), pw3[1]=PKW(P1,10), pw3); \
    GAPA(C1=__builtin_amdgcn_mfma_f32_32x32x16_bf16(kf[7],qr[3],C1,0,0,0),   P1[14],P1[15],0.f,0.f,       pw3[2]=PKW(P1,12),pw3[3]=PKW(P1,14), pw3); \
    l_reg+=sacc; \
    if(GK){DMA_K((t)+3,sl_cur);} if(GV){DMA_V((t)+1,sl_next);} \
    CMASK(C0,C1,t); \
    { float a=MX3(C0[0],C0[1],C1[0]),b=MX3(C0[2],C0[3],C1[1]); a=MX3(a,C1[2],C1[3]); \
      _Pragma("unroll") for(int r=4;r<16;r+=4){a=MX3(a,C0[r],C0[r+1]);b=MX3(b,C0[r+2],C0[r+3]);a=MX3(a,C1[r],C1[r+1]);b=MX3(b,C1[r+2],C1[r+3]);} \
      float rm=__builtin_fmaxf(a,b); { auto rr=__builtin_amdgcn_permlane32_swap(__float_as_uint(rm),__float_as_uint(rm),false,false); rm=__builtin_fmaxf(__uint_as_float(rr[0]),__uint_as_float(rr[1])); } \
      resc=false; \
      if(__builtin_expect(__any(rm>(float)THRL),0)){ const float dl=__builtin_fmaxf(rm,0.f); mhat+=dl; \
        _Pragma("unroll") for(int r=0;r<16;++r){C0[r]-=dl;C1[r]-=dl;} \
        _Pragma("unroll") for(int r=0;r<16;++r)negm[r]=-mhat; asm volatile("":"+v"(negm)); \
        const float f=__builtin_amdgcn_exp2f(-dl); l_reg*=f; if(hi==0)wsf[r32]=f; resc=true; } } \
    SBAR(); \
    VRD(0); VRD(4); VRD(1); VRD(5); SBAR(); \
    GAPC(o[0]=__builtin_amdgcn_mfma_f32_32x32x16_bf16(PAF(0),VFR(0),o[0],0,0,0), C0,0); VRD(2); SBAR(); \
    GAPC(o[1]=__builtin_amdgcn_mfma_f32_32x32x16_bf16(PAF(0),VFR(4),o[1],0,0,0), C0,2); VRD(6); SBAR(); \
    KRD(GL,0); GAPC(o[0]=__builtin_amdgcn_mfma_f32_32x32x16_bf16(PAF(1),VFR(1),o[0],0,0,0), C0,4); VRD(3); SBAR(); \
    KRD(GL,1); GAPC(o[1]=__builtin_amdgcn_mfma_f32_32x32x16_bf16(PAF(1),VFR(5),o[1],0,0,0), C0,6); VRD(7); SBAR(); \
    KRD(GL,2); GAPC(o[0]=__builtin_amdgcn_mfma_f32_32x32x16_bf16(PAF(2),VFR(2),o[0],0,0,0), C0,8); VRD2(0); SBAR(); \
    KRD(GL,3); GAPC(o[1]=__builtin_amdgcn_mfma_f32_32x32x16_bf16(PAF(2),VFR(6),o[1],0,0,0), C0,10); VRD2(4); SBAR(); \
    GAPC(o[0]=__builtin_amdgcn_mfma_f32_32x32x16_bf16(PAF(3),VFR(3),o[0],0,0,0), C0,12); VRD2(1); SBAR(); \
    GAPC(o[1]=__builtin_amdgcn_mfma_f32_32x32x16_bf16(PAF(3),VFR(7),o[1],0,0,0), C0,14); VRD2(5); SBAR(); \
    GAPC(o[2]=__builtin_amdgcn_mfma_f32_32x32x16_bf16(PAF(0),VFR(0),o[2],0,0,0), C1,0); VRD2(2); SBAR(); \
    GAPC(o[3]=__builtin_amdgcn_mfma_f32_32x32x16_bf16(PAF(0),VFR(4),o[3],0,0,0), C1,2); VRD2(6); SBAR(); \
    GAPC(o[2]=__builtin_amdgcn_mfma_f32_32x32x16_bf16(PAF(1),VFR(1),o[2],0,0,0), C1,4); VRD2(3); SBAR(); \
    GAPC(o[3]=__builtin_amdgcn_mfma_f32_32x32x16_bf16(PAF(1),VFR(5),o[3],0,0,0), C1,6); VRD2(7); SBAR(); \
    GAPC(o[2]=__builtin_amdgcn_mfma_f32_32x32x16_bf16(PAF(2),VFR(2),o[2],0,0,0), C1,8); \
    GAPC(o[3]=__builtin_amdgcn_mfma_f32_32x32x16_bf16(PAF(2),VFR(6),o[3],0,0,0), C1,10); \
    GAPC(o[2]=__builtin_amdgcn_mfma_f32_32x32x16_bf16(PAF(3),VFR(3),o[2],0,0,0), C1,12); \
    GAPC(o[3]=__builtin_amdgcn_mfma_f32_32x32x16_bf16(PAF(3),VFR(7),o[3],0,0,0), C1,14); \
    }while(0)
  #define STEPX(...) do{ if constexpr(DV128){ STEP128(__VA_ARGS__); } else { STEP(__VA_ARGS__); } }while(0)
  int t=1;
  #undef CMASK
  #define CMASK(P0,P1,t) do{}while(0)
  for(;t+5<NT;t+=2){
    STEPX(pB0,pB1,pA0,pA1,t,true,true,true);     WB2(); RESC(); ROT();
    STEPX(pA0,pA1,pB0,pB1,t+1,true,true,true);   WB2(); RESC(); ROT();
  }
  #undef CMASK
  #define CMASK(P0,P1,t) do{}while(0)
  #define ENDW(tt) do{ if((tt)+3<NT){WB2();} else if((tt)+2<NT){WB1();} else {WAIT_BAR(0);} }while(0)
  for(;t+1<NT;t+=2){
    STEPX(pB0,pB1,pA0,pA1,t,(t+3<NT),(t+1<NT),(t+1<NT));       ENDW(t);   RESC(); ROT();
    STEPX(pA0,pA1,pB0,pB1,t+1,(t+4<NT),(t+2<NT),(t+2<NT));     ENDW(t+1); RESC(); ROT();
  }
  STEPX(pB0,pB1,pA0,pA1,NT-1,false,false,false); RESC();
  { float sacc=pB0[0]+pB0[1]; _Pragma("unroll") for(int r=2;r<16;++r)sacc+=pB0[r]; _Pragma("unroll") for(int r=0;r<16;++r)sacc+=pB1[r]; l_reg+=sacc;
    pw0=(u32x4){PKW(pB0,0),PKW(pB0,2),PKW(pB0,4),PKW(pB0,6)};pw1=(u32x4){PKW(pB0,8),PKW(pB0,10),PKW(pB0,12),PKW(pB0,14)};pw2=(u32x4){PKW(pB1,0),PKW(pB1,2),PKW(pB1,4),PKW(pB1,6)};pw3=(u32x4){PKW(pB1,8),PKW(pB1,10),PKW(pB1,12),PKW(pB1,14)};
    int lane_d=lane; asm volatile("":"+v"(lane_d)); const int vb0=(int)(lds0+LDS_V)+((lane_d>>4)&1)*32+(lane_d&3)*8+(4*(lane_d>>5)+((lane_d&15)>>2))*64;
    SBAR(); pv(o,vb0+VS*sl_cur,PAF(0),PAF(1),PAF(2),PAF(3)); if constexpr(DV128){ pv(o+2,vb0+VS*sl_cur+8192,PAF(0),PAF(1),PAF(2),PAF(3)); } }
  #undef PKW
  #undef PAF
  #undef VFR
  #undef PIN
  #undef MX3
  #undef GAPA
  #undef GAPB
  #undef GAPC
  #undef EX
  #undef VRD
  #undef KRD
  #undef STEP
  #undef STEP128
  #undef STEPX
  #undef VRD2
  #undef WB2
  #undef WB1
  #undef ENDW
  {auto rr=__builtin_amdgcn_permlane32_swap(__float_as_uint(l_reg),__float_as_uint(l_reg),false,false);l_reg=__uint_as_float(rr[0])+__uint_as_float(rr[1]);}
  if(hi==0)wsf[32+r32]=l_reg;asm volatile("s_waitcnt lgkmcnt(0)":::"memory");
  float rli[16];
  #pragma unroll
  for(int r=0;r<16;++r)rli[r]=__builtin_amdgcn_rcpf(wsf[32+crow(r,hi)]);
  bf16*Ow=Ob+(long)(wid*QBLK)*PO;
  { bf16*stg=(bf16*)(shm+L_OST)+wid*2048;
    #pragma unroll
    for(int hf=0;hf<VS;++hf){
      #pragma unroll
      for(int r=0;r<16;++r){const int orow=crow(r,hi);
        #pragma unroll
        for(int d0=0;d0<2;++d0)stg[orow*64+d0*32+r32]=__float2bfloat16(o[2*hf+d0][r]*rli[r]);}
      asm volatile("s_waitcnt lgkmcnt(0)":::"memory");
      #pragma unroll
      for(int i=0;i<4;++i){const int row=i*8+(lane>>3),ch=lane&7; const u32x4 v=*(const u32x4*)(stg+row*64+ch*8); ATTN_STORE16(Ow+(long)row*PO+hf*64+ch*8,v);}
      asm volatile("s_waitcnt lgkmcnt(0)":::"memory"); } }
  asm volatile("s_waitcnt lgkmcnt(0)\n\ts_barrier":::"memory");
  #undef DMA_K
  #undef DMA_V
  #undef CMASK
  #undef START
  #undef RESC
  #undef ROT
}
constexpr int ATTN_LDS_BYTES=LDS_BYTES;
#undef SBAR
#undef WAIT_BAR
}
#include <hip/hip_cooperative_groups.h>
namespace cg = cooperative_groups;
#define LAS __attribute__((address_space(3)))
typedef unsigned short bf16_t;
typedef unsigned v4u __attribute__((ext_vector_type(4)));
typedef unsigned v2u __attribute__((ext_vector_type(2)));
typedef float f32x4 __attribute__((ext_vector_type(4)));
typedef float cf __attribute__((ext_vector_type(2)));

constexpr int NTHR = 512;
constexpr int DMOD = 1024, NBATCH = 4, SEQ = 8192, CTXL = 256, DEPTH = 4;
constexpr int ML = NBATCH * SEQ, MC = NBATCH * CTXL, MT = ML + MC;
constexpr int INW = 2816, DFF = 2816, NKEY = SEQ + CTXL;
constexpr float EPSF = 1e-6f;
constexpr int FFTN = 16384;

constexpr size_t MiB = 1u << 20;
constexpr size_t WS_MOD = 1 * MiB;
constexpr size_t WS_LAM = 1 * MiB + 512 * 1024;
constexpr size_t WS_ROPE = WS_LAM + 256;
constexpr size_t WS_TW = 1 * MiB + 768 * 1024;
constexpr size_t WS_WIN = 2 * MiB, WS_WOUT = WS_WIN + (size_t)INW * 1024 * 2, WS_WUP = WS_WOUT + 2 * MiB, WS_WDN = WS_WUP + (size_t)2 * DFF * 1024 * 2;
constexpr size_t WS_CTXX = 26 * MiB;
constexpr size_t WS_FILT = 30 * MiB, WS_FILTC = 62 * MiB;
constexpr size_t WS_H = 64 * MiB;
constexpr size_t WS_KF = 64 * MiB;
constexpr size_t WS_RAW = 130 * MiB;
constexpr size_t WS_YRAW = 130 * MiB;
constexpr size_t WS_YH = 213 * MiB, WS_YHC = 245 * MiB;
constexpr size_t WS_QA = 312 * MiB, WS_KA = 329 * MiB, WS_VA = 338 * MiB, WS_QD = 347 * MiB, WS_KD = 380 * MiB, WS_VD = 413 * MiB;
constexpr size_t WS_HYR = 446 * MiB, WS_HYRC = 494 * MiB;
constexpr size_t WS_G = 130 * MiB;
constexpr size_t WS_END = 496 * MiB;
static_assert(WS_WDN + (size_t)DFF * 1024 * 2 <= WS_CTXX, "weights");
static_assert(WS_H + (size_t)MT * 1024 * 2 <= WS_RAW && WS_RAW + (size_t)MT * INW * 2 <= WS_QA, "map1");
static_assert(WS_YRAW + (size_t)MT * 1280 * 2 <= WS_YH && WS_G + (size_t)MT * DFF * 2 <= WS_QA, "map2");
constexpr int LDS_BYTES = 147456;
#ifndef PHM
#define PHM 0xffff
#endif
#define PH(b) ((PHM >> (b)) & 1)
#ifndef REP_ATT
#define REP_ATT 1
#endif
#ifndef REP_HY
#define REP_HY 1
#endif
#ifndef REP_GEMM
#define REP_GEMM 1
#endif
#ifndef REP_PREP
#define REP_PREP 1
#endif
#ifndef REP_PP
#define REP_PP 1
#endif
#ifndef REP_MERGE
#define REP_MERGE 1
#endif
#ifndef REP_N2
#define REP_N2 1
#endif
#ifndef REP_GLU
#define REP_GLU 1
#endif
#ifndef REP_GEMM2
#define REP_GEMM2 1
#endif
#ifndef REP_PRO
#define REP_PRO 1
#endif
#ifndef PROBE_PLAIN_LAUNCH
#define PROBE_PLAIN_LAUNCH 0
#endif
#ifndef EXTRA_SYNC
#define EXTRA_SYNC 0
#endif

__device__ __forceinline__ unsigned f2bf(float f) { unsigned u = __builtin_bit_cast(unsigned, f); return (u + 0x7fffu + ((u >> 16) & 1u)) >> 16; }
__device__ __forceinline__ unsigned pk2(float lo, float hi) { return f2bf(lo) | (f2bf(hi) << 16); }
__device__ __forceinline__ float bf2f(bf16_t u) { return __uint_as_float((unsigned)u << 16); }
__device__ __forceinline__ float bflo(unsigned w) { return __uint_as_float(w << 16); }
__device__ __forceinline__ float bfhi(unsigned w) { return __uint_as_float(w & 0xffff0000u); }
__device__ __forceinline__ float shx(float v, int m, int lane) { return __builtin_bit_cast(float, __builtin_amdgcn_ds_bpermute((lane ^ m) << 2, __builtin_bit_cast(int, v))); }
__device__ __forceinline__ float wave_sum(float v) {
    const int lane = lane_id_v();
#pragma unroll
    for (int o = 1; o < 64; o <<= 1) v += shx(v, o, lane);
    return v;
}
__device__ __forceinline__ float block_sum(float v, LAS float* RED, int tid) {
    v = wave_sum(v); __syncthreads(); if ((tid & 63) == 0) RED[tid >> 6] = v; __syncthreads();
    float s = 0.f;
#pragma unroll
    for (int w = 0; w < 8; ++w) s += RED[w];
    return s;
}

struct EpiGateRes {
    static constexpr bool PERM = false, AFTER_DRAIN = false;
    const float* base_lat; float* out_lat; const float* base_ctx; float* out_ctx; const float* gate; int row_off;
    __device__ __forceinline__ void operator()(const pg8::f32x4 (&acc)[2][2][4][2], const pg8::Unit& u, int wr, int wc, int fr, int fq) const {
        const int col0 = u.pn * 256 + wc * 32 + 4 * fq;
#pragma unroll
        for (int ai = 0; ai < 2; ++ai)
#pragma unroll
            for (int m = 0; m < 4; ++m) {
                const int r = row_off + u.pm * 256 + ai * 128 + wr * 64 + m * 16 + fr;
                const bool lat = r < ML; const int bi = lat ? (r >> 13) : 4;
                const size_t off = lat ? (size_t)r * 1024 : (size_t)(r - ML) * 1024;
                const float* bp = (lat ? base_lat : base_ctx) + off + col0; float* op = (lat ? out_lat : out_ctx) + off + col0;
                const float* gp = gate + bi * 6144 + col0;
#pragma unroll
                for (int bj = 0; bj < 2; ++bj)
#pragma unroll
                    for (int n = 0; n < 2; ++n) {
                        const pg8::f32x4 g4 = *(const pg8::f32x4*)(gp + bj * 128 + n * 16), b4 = *(const pg8::f32x4*)(bp + bj * 128 + n * 16);
                        *(pg8::f32x4*)(op + bj * 128 + n * 16) = b4 + g4 * acc[ai][bj][m][n];
                    }
            }
    }
};

__device__ __forceinline__ float dpp_ror1(float v) { return __builtin_bit_cast(float, __builtin_amdgcn_update_dpp(0, __builtin_bit_cast(int, v), 0x121, 0xF, 0xF, false)); }
__device__ __forceinline__ float dpp_rol1(float v) { return __builtin_bit_cast(float, __builtin_amdgcn_update_dpp(0, __builtin_bit_cast(int, v), 0x12F, 0xF, 0xF, false)); }
struct EpiGlu {
    static constexpr bool PERM = true, AFTER_DRAIN = false;
    bf16_t* G; const float* cw; const float* cb; int nrows;
    __device__ __forceinline__ void operator()(const pg8::f32x4 (&acc)[2][2][4][2], const pg8::Unit& u, int wr, int wc, int fr, int fq) const {
        const int ch0 = u.pn * 128 + wc * 32 + 8 * fq;
        float w0[8], w1[8], w2[8], bb[8];
#pragma unroll
        for (int hq = 0; hq < 2; ++hq) { const pg8::f32x4 q0 = *(const pg8::f32x4*)(cw + ch0 + 4 * hq), q1 = *(const pg8::f32x4*)(cw + DFF + ch0 + 4 * hq), q2 = *(const pg8::f32x4*)(cw + 2 * DFF + ch0 + 4 * hq), q3 = *(const pg8::f32x4*)(cb + ch0 + 4 * hq);
#pragma unroll
            for (int e = 0; e < 4; ++e) { w0[4 * hq + e] = q0[e]; w1[4 * hq + e] = q1[e]; w2[4 * hq + e] = q2[e]; bb[4 * hq + e] = q3[e]; } }
#pragma unroll
        for (int ai = 0; ai < 2; ++ai) {
            const int kb = u.pm * 4 + ai * 2 + wr;
#pragma unroll
            for (int m = 0; m < 4; ++m) {
                const int rl = 16 * m + fr, gr = 62 * kb - 1 + rl;
                bool first, last; if (gr < ML) { const int t = gr & 8191; first = t == 0; last = t == 8191; } else { const int t = (gr - ML) & 255; first = t == 0; last = t == 255; }
                float res[8];
#pragma unroll
                for (int n = 0; n < 2; ++n)
#pragma unroll
                    for (int e = 0; e < 4; ++e) {
                        const float x0 = acc[ai][0][m][n][e];
                        const float ru = dpp_ror1(x0), rd = dpp_rol1(x0);
                        const float rum = dpp_ror1(acc[ai][0][m > 0 ? m - 1 : 0][n][e]), rdp = dpp_rol1(acc[ai][0][m < 3 ? m + 1 : 3][n][e]);
                        float xu = fr == 0 ? rum : ru, xd = fr == 15 ? rdp : rd;
                        xu = first ? 0.f : xu; xd = last ? 0.f : xd;
                        const int c = 4 * n + e;
                        const float x = w0[c] * xu + w1[c] * x0 + w2[c] * xd + bb[c];
                        const float u2 = -2.302208198f * (x + 0.044715f * x * x * x);
                        res[c] = x * __builtin_amdgcn_rcpf(1.0f + __builtin_amdgcn_exp2f(u2)) * acc[ai][1][m][n][e];
                    }
                if (rl >= 1 && rl <= 62 && gr < nrows) { v4u o; o.x = pk2(res[0], res[1]); o.y = pk2(res[2], res[3]); o.z = pk2(res[4], res[5]); o.w = pk2(res[6], res[7]);
                    *(v4u*)(G + (size_t)gr * DFF + ch0) = o; }
            }
        }
    }
};

struct EpiInProj {
    static constexpr bool PERM = true, AFTER_DRAIN = false;
    bf16_t *qa, *ka, *va, *qd, *kd, *vd, *hyr, *hyrc; const float *qn_a, *kn_a, *qn_d, *kn_d; const cf* rope;
    __device__ __forceinline__ void operator()(const pg8::f32x4 (&acc)[2][2][4][2], const pg8::Unit& u, int wr, int wc, int fr, int fq) const {
        const int pn = u.pn, lane = fr + 16 * fq;
        bool normed, keyrow; const float* gain = qn_a; float scale = 1.f; bf16_t* dbase; int dpitch, dcol, nh = 1, hidx = 0;
        if (pn == 0) { normed = true; gain = qn_a; scale = attn_body::C2; dbase = qa; dpitch = 256; keyrow = false; dcol = wc * 64; }
        else if (pn == 1) { keyrow = true; dpitch = 64; nh = 2; dcol = 0; if (wc < 2) { normed = true; gain = kn_a; dbase = ka; hidx = wc; } else { normed = false; dbase = va; hidx = wc - 2; } }
        else if (pn < 5) { normed = false; dbase = hyr; dpitch = 0; keyrow = false; dcol = (pn - 2) * 256 + wc * 64; }
        else if (pn < 7) { normed = true; gain = qn_d; scale = attn_body::C2; dbase = qd; dpitch = 512; keyrow = false; dcol = ((pn - 5) * 4 + wc) * 64; }
        else if (pn < 9) { normed = true; gain = kn_d; dbase = kd; dpitch = 64; keyrow = true; nh = 8; hidx = (pn - 7) * 4 + wc; dcol = 0; }
        else { normed = false; dbase = vd; dpitch = 128; keyrow = true; nh = 4; hidx = (pn - 9) * 2 + (wc >> 1); dcol = (wc & 1) * 64; }
        pg8::f32x4 gg[2][2];
#pragma unroll
        for (int bj = 0; bj < 2; ++bj)
#pragma unroll
            for (int n = 0; n < 2; ++n) gg[bj][n] = *(const pg8::f32x4*)(gain + 32 * bj + 8 * fq + 4 * n);
#pragma unroll
        for (int ai = 0; ai < 2; ++ai)
#pragma unroll
            for (int m = 0; m < 4; ++m) {
                const int r = u.pm * 256 + ai * 128 + wr * 64 + m * 16 + fr;
                const bool lat = r < ML; int b, t; if (lat) { b = r >> 13; t = r & 8191; } else { b = (r - ML) >> 8; t = (r - ML) & 255; }
                const size_t drow = keyrow ? (size_t)(b * nh + hidx) * NKEY + (lat ? 256 + t : t) : (size_t)r;
                if (pn >= 2 && pn < 5) {
                    bf16_t* cbp = lat ? hyr + (size_t)b * 768 * 8192 + t : hyrc + (size_t)b * 768 * 256 + t; const size_t cst = lat ? 8192 : 256;
#pragma unroll
                    for (int bj = 0; bj < 2; ++bj)
#pragma unroll
                        for (int n = 0; n < 2; ++n)
#pragma unroll
                            for (int e = 0; e < 4; ++e) cbp[(size_t)(dcol + 32 * bj + 8 * fq + 4 * n + e) * cst] = (bf16_t)f2bf(acc[ai][bj][m][n][e]);
                    continue;
                }
                bf16_t* dp = dbase + drow * dpitch + dcol + 8 * fq;
                float rinv = 1.f;
                if (normed) { float ss = 0.f;
#pragma unroll
                    for (int bj = 0; bj < 2; ++bj)
#pragma unroll
                        for (int n = 0; n < 2; ++n) { const pg8::f32x4 x = acc[ai][bj][m][n]; ss += (x[0] * x[0] + x[1] * x[1]) + (x[2] * x[2] + x[3] * x[3]); }
                    ss += shx(ss, 16, lane); ss += shx(ss, 32, lane);
                    rinv = scale / sqrtf(ss * (1.0f / 64.0f) + EPSF); }
#pragma unroll
                for (int bj = 0; bj < 2; ++bj) {
                    pg8::f32x4 y0 = acc[ai][bj][m][0], y1 = acc[ai][bj][m][1];
                    if (normed) {
                        y0 = y0 * rinv * gg[bj][0]; y1 = y1 * rinv * gg[bj][1];
                        if (lat) { const int p = bj == 0 ? (t >> 6) : (t & 63); const pg8::f32x4* rp = (const pg8::f32x4*)(rope + p * 16 + 4 * fq); const pg8::f32x4 c01 = rp[0], c23 = rp[1];
                            const pg8::f32x4 z0 = {y0[0] * c01[0] - y0[1] * c01[1], y0[0] * c01[1] + y0[1] * c01[0], y0[2] * c01[2] - y0[3] * c01[3], y0[2] * c01[3] + y0[3] * c01[2]};
                            const pg8::f32x4 z1 = {y1[0] * c23[0] - y1[1] * c23[1], y1[0] * c23[1] + y1[1] * c23[0], y1[2] * c23[2] - y1[3] * c23[3], y1[2] * c23[3] + y1[3] * c23[2]};
                            y0 = z0; y1 = z1; }
                    }
                    v4u o; o.x = pk2(y0[0], y0[1]); o.y = pk2(y0[2], y0[3]); o.z = pk2(y1[0], y1[1]); o.w = pk2(y1[2], y1[3]);
                    *(v4u*)(dp + 32 * bj) = o;
                }
            }
    }
};

template <int PERM_UP = 0> __device__ __forceinline__ void transpose_item(const float* W, int K, int N, bf16_t* WT, LAS float* scr, int item, int lane) {
    const int nblk = N / 32, kb = item / nblk, nb = item % nblk, k0 = 64 * kb, n0 = 32 * nb;
#pragma unroll 8
    for (int i = 0; i < 32; ++i) { const int kk = 2 * i + (lane >> 5); scr[kk * 33 + (lane & 31)] = W[(size_t)(k0 + kk) * N + n0 + (lane & 31)]; }
    asm volatile("s_waitcnt lgkmcnt(0)" ::: "memory");
    const int c = lane & 7;
#pragma unroll
    for (int j = 0; j < 4; ++j) { const int n = (lane >> 3) + 8 * j; const LAS float* s = scr + (8 * c) * 33 + n;
        v4u o; o.x = pk2(s[0 * 33], s[1 * 33]); o.y = pk2(s[2 * 33], s[3 * 33]); o.z = pk2(s[4 * 33], s[5 * 33]); o.w = pk2(s[6 * 33], s[7 * 33]);
        int row = n0 + n; if (PERM_UP == 2) { const int nl = row & 255; row = (row & ~255) + 128 * ((nl >> 5) & 1) + 32 * (nl >> 6) + (nl & 31); }
        if (PERM_UP == 1) { const bool isv = row >= DFF; const int ch = isv ? row - DFF : row; row = (ch >> 7) * 256 + (isv ? 128 : 0) + (ch & 127); }
        *(v4u*)(WT + (size_t)row * K + k0 + 8 * c) = o; }
    asm volatile("s_waitcnt lgkmcnt(0)" ::: "memory");
}

__device__ __forceinline__ void norm_mod(const float* xl, const float* xc, const float* g, const float* mod, int shoff, int scoff, bf16_t* H, int nrows, int gw, int NGW, int lane) {
    for (int r = gw; r < nrows; r += 4 * NGW) {
        int rr[4]; const float* xp[4]; const float* mp[4];
#pragma unroll
        for (int k = 0; k < 4; ++k) { const int rk = r + k * NGW; rr[k] = rk < nrows ? rk : r; xp[k] = rr[k] < ML ? xl + (size_t)rr[k] * 1024 : xc + (size_t)(rr[k] - ML) * 1024; mp[k] = mod + (rr[k] < ML ? (rr[k] >> 13) : 4) * 6144; }
        f32x4 v[4][4]; float ss[4];
#pragma unroll
        for (int k = 0; k < 4; ++k)
#pragma unroll
            for (int j = 0; j < 4; ++j) v[k][j] = ((const f32x4*)xp[k])[lane + 64 * j];
#pragma unroll
        for (int k = 0; k < 4; ++k) { ss[k] = 0.f;
#pragma unroll
            for (int j = 0; j < 4; ++j) ss[k] += (v[k][j].x * v[k][j].x + v[k][j].y * v[k][j].y) + (v[k][j].z * v[k][j].z + v[k][j].w * v[k][j].w); }
#pragma unroll
        for (int o = 1; o < 64; o <<= 1) {
#pragma unroll
            for (int k = 0; k < 4; ++k) ss[k] += shx(ss[k], o, lane); }
#pragma unroll
        for (int j = 0; j < 4; ++j) { const int col = 4 * lane + 256 * j;
            const f32x4 g4 = *(const f32x4*)(g + col);
#pragma unroll
            for (int k = 0; k < 4; ++k) { if (k == 0 || r + k * NGW < nrows) {
                const float rinv = 1.0f / sqrtf(ss[k] * (1.0f / 1024.0f) + EPSF);
                const f32x4 sc4 = *(const f32x4*)(mp[k] + scoff + col), sh4 = *(const f32x4*)(mp[k] + shoff + col); const f32x4 o = (v[k][j] * rinv * g4) * (sc4 + 1.0f) + sh4;
                v2u w; w.x = pk2(o.x, o.y); w.y = pk2(o.z, o.w); *(v2u*)(H + (size_t)rr[k] * 1024 + col) = w; } }
        }
    }
}

__device__ __forceinline__ cf mk2(float x, float y) { cf r; r.x = x; r.y = y; return r; }
__device__ __forceinline__ cf cmul(cf a, cf b) { return mk2(a.x * b.x - a.y * b.y, a.x * b.y + a.y * b.x); }
__device__ __forceinline__ cf cmulc(cf a, cf b) { return mk2(a.x * b.x + a.y * b.y, a.y * b.x - a.x * b.y); }
__device__ __forceinline__ cf ld_f2_l2(const cf* p) {
    const unsigned long long w = __hip_atomic_load((const unsigned long long*)p, __ATOMIC_RELAXED, __HIP_MEMORY_SCOPE_AGENT);
    return mk2(__uint_as_float((unsigned)w), __uint_as_float((unsigned)(w >> 32)));
}
__device__ __forceinline__ int PX(int i) { return i + (i >> 6); }
__device__ __forceinline__ cf twid(float frac) { return mk2(__builtin_amdgcn_cosf(frac), -__builtin_amdgcn_sinf(frac)); }
__device__ __forceinline__ void bfly4_fwd(cf& a0, cf& a1, cf& a2, cf& a3) {
    const cf s02 = a0 + a2, d02 = a0 - a2, s13 = a1 + a3, d13 = a1 - a3;
    a0 = s02 + s13; a2 = s02 - s13; a1 = mk2(d02.x + d13.y, d02.y - d13.x); a3 = mk2(d02.x - d13.y, d02.y + d13.x);
}
__device__ __forceinline__ void bfly4_inv(cf& a0, cf& a1, cf& a2, cf& a3) {
    const cf s02 = a0 + a2, d02 = a0 - a2, s13 = a1 + a3, d13 = a1 - a3;
    a0 = s02 + s13; a2 = s02 - s13; a1 = mk2(d02.x - d13.y, d02.y + d13.x); a3 = mk2(d02.x + d13.y, d02.y - d13.x);
}
template <int LG, bool INV> __device__ __forceinline__ void fft_pass2(LAS cf* X, int tid) {
    constexpr int L = 1 << LG, L16 = L >> 4, L4 = L >> 2; constexpr float fL = 1.0f / (float)L;
#pragma unroll 1
    for (int i = 0; i < 2; ++i) {
        const int it = tid + 512 * i; int g, j;
        if (LG == 14) { g = 0; j = it; } else if (LG == 10) { j = it & 63; g = it >> 6; } else { g = it & 255; j = it >> 8; }
        const int base = g * L + j;
        cf e[4][4];
#pragma unroll
        for (int r = 0; r < 4; ++r)
#pragma unroll
            for (int m = 0; m < 4; ++m) e[r][m] = X[PX(base + r * L16 + m * L4)];
        const cf v1 = twid((float)(4 * j) * fL), v2 = cmul(v1, v1), v3 = cmul(v2, v1);
        if (!INV) {
#pragma unroll
            for (int r = 0; r < 4; ++r) { bfly4_fwd(e[r][0], e[r][1], e[r][2], e[r][3]);
                const cf w1 = twid((float)(j + r * L16) * fL), w2 = cmul(w1, w1), w3 = cmul(w2, w1);
                e[r][1] = cmul(e[r][1], w1); e[r][2] = cmul(e[r][2], w2); e[r][3] = cmul(e[r][3], w3); }
#pragma unroll
            for (int p = 0; p < 4; ++p) { bfly4_fwd(e[0][p], e[1][p], e[2][p], e[3][p]); e[1][p] = cmul(e[1][p], v1); e[2][p] = cmul(e[2][p], v2); e[3][p] = cmul(e[3][p], v3); }
        } else {
#pragma unroll
            for (int p = 0; p < 4; ++p) { e[1][p] = cmulc(e[1][p], v1); e[2][p] = cmulc(e[2][p], v2); e[3][p] = cmulc(e[3][p], v3); bfly4_inv(e[0][p], e[1][p], e[2][p], e[3][p]); }
#pragma unroll
            for (int r = 0; r < 4; ++r) { const cf w1 = twid((float)(j + r * L16) * fL), w2 = cmul(w1, w1), w3 = cmul(w2, w1);
                e[r][1] = cmulc(e[r][1], w1); e[r][2] = cmulc(e[r][2], w2); e[r][3] = cmulc(e[r][3], w3); bfly4_inv(e[r][0], e[r][1], e[r][2], e[r][3]); }
        }
#pragma unroll
        for (int r = 0; r < 4; ++r)
#pragma unroll
            for (int m = 0; m < 4; ++m) X[PX(base + r * L16 + m * L4)] = e[r][m];
    }
    __syncthreads();
}
__device__ __forceinline__ void fft_last_fwd(LAS cf* X, int tid, cf* KFW, float bias, float scale) {
#pragma unroll 2
    for (int i = 0; i < 8; ++i) { const int it = tid + 512 * i, g = it & 255, k = it >> 8, base = g * 64 + 4 * k;
        cf e0 = X[PX(base)], e1 = X[PX(base + 1)], e2 = X[PX(base + 2)], e3 = X[PX(base + 3)];
        bfly4_fwd(e0, e1, e2, e3);
        if (KFW) { cf* o = KFW + (4 * k) * 256 + g; o[0] = mk2((e0.x + bias) * scale, e0.y * scale); o[256] = mk2((e1.x + bias) * scale, e1.y * scale); o[512] = mk2((e2.x + bias) * scale, e2.y * scale); o[768] = mk2((e3.x + bias) * scale, e3.y * scale); }
        else { X[PX(base)] = e0; X[PX(base + 1)] = e1; X[PX(base + 2)] = e2; X[PX(base + 3)] = e3; } }
    __syncthreads();
}
__device__ __forceinline__ void fft_first_inv_mul(LAS cf* X, int tid, const cf* KFR) {
#pragma unroll 2
    for (int i = 0; i < 8; ++i) { const int it = tid + 512 * i, g = it & 255, k = it >> 8, base = g * 64 + 4 * k; const cf* q = KFR + (4 * k) * 256 + g;
        cf e0 = cmul(X[PX(base)], ld_f2_l2(q)), e1 = cmul(X[PX(base + 1)], ld_f2_l2(q + 256)), e2 = cmul(X[PX(base + 2)], ld_f2_l2(q + 512)), e3 = cmul(X[PX(base + 3)], ld_f2_l2(q + 768));
        bfly4_inv(e0, e1, e2, e3);
        X[PX(base)] = e0; X[PX(base + 1)] = e1; X[PX(base + 2)] = e2; X[PX(base + 3)] = e3; }
    __syncthreads();
}
__device__ __forceinline__ void fft_mid_mul(LAS cf* X, int tid, const cf* KFR) {
#pragma unroll 2
    for (int i = 0; i < 8; ++i) { const int it = tid + 512 * i, g = it & 255, k = it >> 8, base = g * 64 + 4 * k; const cf* q = KFR + (4 * k) * 256 + g;
        cf e0 = X[PX(base)], e1 = X[PX(base + 1)], e2 = X[PX(base + 2)], e3 = X[PX(base + 3)];
        const cf k0 = ld_f2_l2(q), k1 = ld_f2_l2(q + 256), k2 = ld_f2_l2(q + 512), k3 = ld_f2_l2(q + 768);
        bfly4_fwd(e0, e1, e2, e3);
        e0 = cmul(e0, k0); e1 = cmul(e1, k1); e2 = cmul(e2, k2); e3 = cmul(e3, k3);
        bfly4_inv(e0, e1, e2, e3);
        X[PX(base)] = e0; X[PX(base + 1)] = e1; X[PX(base + 2)] = e2; X[PX(base + 3)] = e3; }
    __syncthreads();
}
__device__ __forceinline__ void fft_fwd_lds(LAS cf* X, int tid) { fft_pass2<14, false>(X, tid); fft_pass2<10, false>(X, tid); fft_pass2<6, false>(X, tid); }
__device__ __forceinline__ void fft_inv_lds(LAS cf* X, int tid) { fft_pass2<6, true>(X, tid); fft_pass2<10, true>(X, tid); fft_pass2<14, true>(X, tid); }
__device__ __forceinline__ void conv8(const bf16_t* p, int c, int n, float w0, float w1, float w2, float b, float (&o)[8]) {
    const v4u v = *(const v4u*)(p + 8 * c);
    const float um = c > 0 ? bf2f(p[8 * c - 1]) : 0.f, up = 8 * c + 8 < n ? bf2f(p[8 * c + 8]) : 0.f;
    const float u0 = bflo(v.x), u1 = bfhi(v.x), u2 = bflo(v.y), u3 = bfhi(v.y), u4 = bflo(v.z), u5 = bfhi(v.z), u6 = bflo(v.w), u7 = bfhi(v.w);
    o[0] = w0 * um + w1 * u0 + w2 * u1 + b; o[1] = w0 * u0 + w1 * u1 + w2 * u2 + b; o[2] = w0 * u1 + w1 * u2 + w2 * u3 + b; o[3] = w0 * u2 + w1 * u3 + w2 * u4 + b;
    o[4] = w0 * u3 + w1 * u4 + w2 * u5 + b; o[5] = w0 * u4 + w1 * u5 + w2 * u6 + b; o[6] = w0 * u5 + w1 * u6 + w2 * u7 + b; o[7] = w0 * u6 + w1 * u7 + w2 * up + b;
}
__device__ __forceinline__ float hy_in(const bf16_t* p, int t, int n, float w0, float w1, float w2, float b) {
    const float um = t > 0 ? bf2f(p[t - 1]) : 0.f, u0 = bf2f(p[t]), up = t < n - 1 ? bf2f(p[t + 1]) : 0.f;
    return w0 * um + w1 * u0 + w2 * up + b;
}

#define XB_TMO      128
#define XB_XCNT(j)  (256  + 64 * (j))
#define XB_XSUB(j)  (1280 + 64 * (j))
#define XB_XGEN(j)  (2304 + 64 * (j))
#define XB_TOP      3328
#define XB_TOPGEN   3392
#define XCD_BAR_WORDS 3456
#define XB_SPIN_CAP (1u << 18)

__device__ __forceinline__ unsigned xb_ld(unsigned* p)              { return __hip_atomic_load(p, __ATOMIC_RELAXED, __HIP_MEMORY_SCOPE_AGENT); }
__device__ __forceinline__ unsigned xb_add(unsigned* p, unsigned v) { return __hip_atomic_fetch_add(p, v, __ATOMIC_RELAXED, __HIP_MEMORY_SCOPE_AGENT); }
__device__ __forceinline__ unsigned xb_xcc_id() { return (unsigned)__builtin_amdgcn_s_getreg((3 << 11) | 20) & 0xFu; }
#define XB_SPIN(cond, bar) do { unsigned _sp = 0; while (cond) { __builtin_amdgcn_s_sleep(1); \
    if ((++_sp & 255u) == 0u) { if (xb_ld(&(bar)[XB_TMO])) break; if (_sp > XB_SPIN_CAP) { atomicAdd(&(bar)[XB_TMO], 1u); break; } } } } while (0)

struct XcdBarrier {
    unsigned* bar; unsigned x;
    volatile LAS unsigned* st;
};

__device__ __forceinline__ XcdBarrier xcd_barrier_post(unsigned* bar, volatile LAS unsigned* st) {
    XcdBarrier b; b.bar = bar; b.x = xb_xcc_id(); b.st = st;
    if (threadIdx.x == 0) (void)xb_add(&bar[XB_XCNT(b.x)], 1u);
    return b;
}
__device__ __forceinline__ void xcd_barrier_complete(unsigned* bar, unsigned x, unsigned& nloc, unsigned& nx) {
    const unsigned G = gridDim.x * gridDim.y * gridDim.z;
    unsigned sum, cnt, mine, sp = 0u;
    for (;;) {
        sum = 0u; cnt = 0u; mine = 0u;
#pragma unroll
        for (unsigned j = 0; j < 16; ++j) { const unsigned c = xb_ld(&bar[XB_XCNT(j)]); sum += c; cnt += (c > 0u) ? 1u : 0u; mine = (j == x) ? c : mine; }
        if (sum == G) break;
        __builtin_amdgcn_s_sleep(1);
        if ((++sp & 255u) == 0u) { if (xb_ld(&bar[XB_TMO])) break; if (sp > XB_SPIN_CAP) { atomicAdd(&bar[XB_TMO], 1u); break; } }
    }
    nloc = mine > 0u ? mine : 1u; nx = cnt > 0u ? cnt : 1u;
}

__device__ __forceinline__ void xcd_barrier(const XcdBarrier& b, const int wave0) {
    asm volatile("s_waitcnt vmcnt(0)" ::: "memory");
    __syncthreads();
    if (wave0 == 0 && lane_id_v() == 0) {
        unsigned* bar = b.bar;
        __builtin_amdgcn_s_waitcnt(0);
        unsigned nloc = b.st[0], nx = b.st[1];
        if (nloc == 0u) { xcd_barrier_complete(bar, b.x, nloc, nx); b.st[0] = nloc; b.st[1] = nx; }
        const unsigned old = xb_add(&bar[XB_XSUB(b.x)], 1u);
        const unsigned gen = old / nloc;
        if (old + 1u == (gen + 1u) * nloc) {
            __builtin_amdgcn_fence(__ATOMIC_RELEASE, "agent");
            asm volatile("s_waitcnt vmcnt(0)" ::: "memory");
            const unsigned og = xb_add(&bar[XB_TOP], 1u);
            const unsigned tg = og / nx;
            if (og + 1u == (tg + 1u) * nx) xb_add(&bar[XB_TOPGEN], 1u);
            else XB_SPIN(xb_ld(&bar[XB_TOPGEN]) == tg, bar);
            __builtin_amdgcn_fence(__ATOMIC_ACQUIRE, "agent");
            xb_add(&bar[XB_XGEN(b.x)], 1u);
            asm volatile("s_waitcnt vmcnt(0)" ::: "memory");
        } else {
            XB_SPIN(xb_ld(&bar[XB_XGEN(b.x)]) == gen, bar);
            __builtin_amdgcn_fence(__ATOMIC_ACQUIRE, "agent");
            asm volatile("s_waitcnt vmcnt(0)" ::: "memory");
        }
    }
    __syncthreads();
}


struct Args { const float* in[33]; float* out; unsigned char* ws; };
__device__ __forceinline__ unsigned char* wsb(unsigned char* p) { asm volatile("" : "+s"(p)); return p; }
__device__ __forceinline__ int opq(int i) { asm volatile("" : "+s"(i)); return i; }

#define MOD ((float*)(wsb(a.ws) + WS_MOD))
#define LAM ((float*)(wsb(a.ws) + WS_LAM))
#define ROPE ((cf*)(wsb(a.ws) + WS_ROPE))
#define TW ((cf*)(wsb(a.ws) + WS_TW))
#define WIN ((bf16_t*)(wsb(a.ws) + WS_WIN))
#define WOUT ((bf16_t*)(wsb(a.ws) + WS_WOUT))
#define WUP ((bf16_t*)(wsb(a.ws) + WS_WUP))
#define WDN ((bf16_t*)(wsb(a.ws) + WS_WDN))
#define CTXX ((float*)(wsb(a.ws) + WS_CTXX))
#define FILT ((float*)(wsb(a.ws) + WS_FILT))
#define FILTC ((float*)(wsb(a.ws) + WS_FILTC))
#define H ((bf16_t*)(wsb(a.ws) + WS_H))
#define KFB ((cf*)(wsb(a.ws) + WS_KF))
#define RAW ((bf16_t*)(wsb(a.ws) + WS_RAW))
#define YRAW ((bf16_t*)(wsb(a.ws) + WS_YRAW))
#define YH ((float*)(wsb(a.ws) + WS_YH))
#define YHC ((float*)(wsb(a.ws) + WS_YHC))
#define QA ((bf16_t*)(wsb(a.ws) + WS_QA))
#define KA ((bf16_t*)(wsb(a.ws) + WS_KA))
#define VA ((bf16_t*)(wsb(a.ws) + WS_VA))
#define QD ((bf16_t*)(wsb(a.ws) + WS_QD))
#define KD ((bf16_t*)(wsb(a.ws) + WS_KD))
#define VD ((bf16_t*)(wsb(a.ws) + WS_VD))
#define HYR ((bf16_t*)(wsb(a.ws) + WS_HYR))
#define HYRC ((bf16_t*)(wsb(a.ws) + WS_HYRC))
#define GB ((bf16_t*)(wsb(a.ws) + WS_G))
#define OUT (a.out)
__device__ __forceinline__ void prep_work(const Args& a, LAS unsigned char* lds, const int lp, const bool needc, const int widx, const int nwg, const bool do_main, const bool do_dn, const int tid, const int lane, const int wave) {
    LAS float* scr = (LAS float*)(lds + wave * 16384);
    constexpr int I_IN = 16 * 88, I_OUT = 16 * 32, I_UP = 16 * 176, I_DN = 44 * 32;
    for (int it = (do_main ? 0 : I_IN + I_OUT + I_UP) + widx * 8 + wave; it < (do_dn ? I_IN + I_OUT + I_UP + I_DN : I_IN + I_OUT + I_UP); it += nwg * 8) {
        int r = it;
        if (r < I_IN) { transpose_item<2>(a.in[opq(8)] + (size_t)lp * 1024 * INW, 1024, INW, WIN, scr, r, lane); continue; } r -= I_IN;
        if (r < I_OUT) { transpose_item(a.in[opq(28)] + (size_t)lp * 1024 * 1024, 1024, 1024, WOUT, scr, r, lane); continue; } r -= I_OUT;
        if (r < I_UP) { transpose_item<1>(a.in[opq(29)] + (size_t)lp * 1024 * 2 * DFF, 1024, 2 * DFF, WUP, scr, r, lane); continue; } r -= I_UP;
        transpose_item(a.in[opq(32)] + (size_t)lp * DFF * 1024, DFF, 1024, WDN, scr, r, lane);
    }
    __syncthreads();
    if (do_main) {
    const float* fw1 = a.in[opq(19)] + lp * 33 * 64; const float* fb1 = a.in[opq(20)] + lp * 64; const float* fw2 = a.in[opq(21)] + lp * 64 * 64; const float* fb2 = a.in[opq(22)] + lp * 64;
    const float* fw3 = a.in[opq(23)] + (size_t)lp * 64 * 1024; const float* fb3 = a.in[opq(24)] + lp * 1024; const float* freq = a.in[opq(25)] + lp * 64;
    LAS float* Z = (LAS float*)lds; LAS float* H1 = Z + 33 * 33; LAS float* H2 = H1 + 33 * 64; LAS float* W1 = H2 + 33 * 64; LAS float* W2 = W1 + 33 * 64; LAS float* FB = W2 + 64 * 64;
    for (int i = tid; i < 33 * 64; i += NTHR) W1[i] = fw1[i];
    for (int i = tid; i < 64 * 64; i += NTHR) W2[i] = fw2[i];
    if (tid < 64) { FB[tid] = fb1[tid]; FB[64 + tid] = fb2[tid]; FB[128 + tid] = freq[tid]; }
    const int npos = needc ? 33 : 32;
    for (int item = widx; item < 256; item += nwg) {
        __syncthreads();
        for (int i = tid; i < npos * 33; i += NTHR) { const int p = i / 33, e = i - p * 33; const bool isc = p == 32; const int n = isc ? item : item * 32 + p; const float NP = isc ? 256.0f : 8192.0f; float val;
            if (e == 0) val = (float)n / (NP - 1.0f);
            else { const int k = (e - 1) & 15; const float band = 1e-4f + (float)k * ((15.0f - 1e-4f) / 15.0f); const float w = 6.283185307179586f * (float)n / NP; const float arg = band * w;
                val = (e <= 16) ? cosf(arg) : -sinf(arg); }
            Z[i] = val; }
        __syncthreads();
        for (int i = tid; i < npos * 64; i += NTHR) { const int p = i >> 6, j = i & 63; float s = FB[j];
#pragma unroll
            for (int e = 0; e < 33; ++e) s += Z[p * 33 + e] * W1[e * 64 + j];
            H1[i] = sinf(FB[128 + j] * s); }
        __syncthreads();
        for (int i = tid; i < npos * 64; i += NTHR) { const int p = i >> 6, j = i & 63; float s = FB[64 + j];
#pragma unroll 16
            for (int e = 0; e < 64; ++e) s += H1[p * 64 + e] * W2[e * 64 + j];
            H2[i] = sinf(FB[128 + j] * s); }
        __syncthreads();
#pragma unroll 1
        for (int half = 0; half < 2; ++half) { const int q = tid + 512 * half, c = q & 255;
            float w[64];
#pragma unroll
            for (int e = 0; e < 64; ++e) w[e] = fw3[(size_t)e * 1024 + q];
            const float b3 = fb3[q], adelta = 3.0701134573253945f + (float)c * ((15.350567286626973f - 3.0701134573253945f) / 255.0f);
#pragma unroll 1
            for (int p = 0; p < npos; ++p) { float s = b3;
#pragma unroll
                for (int e = 0; e < 64; ++e) s += H2[p * 64 + e] * w[e];
                const bool isc = p == 32; const int n = isc ? item : item * 32 + p; const float t = (float)n / (isc ? 255.0f : 8191.0f);
                float* dst = isc ? FILTC + (size_t)q * 256 : FILT + (size_t)q * 8192;
                dst[n] = s * expf(-t * adelta); }
        }
    }
    __syncthreads();
    }
}

__global__ void __launch_bounds__(NTHR, 2) fwd_mega(Args a) {
    extern __shared__ __attribute__((aligned(16))) unsigned char lds_raw[];
    cg::grid_group grid = cg::this_grid();
    LAS unsigned char* lds = (LAS unsigned char*)lds_raw;
    const int G = gridDim.x, bx = blockIdx.x;
    const int NGW = G * 8;
const int wave0 = __builtin_amdgcn_readfirstlane(threadIdx.x >> 6);
#define PHASE_IDS int tid = wave0 * 64 + lane_id_v(); asm volatile("" : "+v"(tid)); const int lane = tid & 63, wave = __builtin_amdgcn_readfirstlane(tid >> 6); const int gw = bx * 8 + wave; (void)lane; (void)gw;

    volatile LAS unsigned* MISC = (volatile LAS unsigned*)(lds + 147392);
    if (threadIdx.x < 16) MISC[threadIdx.x] = 0u;
    __syncthreads();
    const XcdBarrier xbar = xcd_barrier_post((unsigned*)a.ws, MISC + 8);
    if (threadIdx.x == 0) MISC[2] = xb_add((unsigned*)a.ws + 4096 + 64 * xbar.x, 1u);
    {
        PHASE_IDS
        LAS float* S = (LAS float*)lds; LAS float* RED = S + 5 * 1024;
        const float* c = a.in[opq(1)]; const float* cctx = a.in[opq(3)];
        for (int i = tid; i < 5 * 1024; i += NTHR) { const float v = i < 4096 ? c[i] : cctx[i - 4096]; S[i] = v / (1.f + expf(-v)); }
        __syncthreads();
        const float* wmod = a.in[opq(6)]; const float* bmod = a.in[opq(7)];
        for (int item = bx; item < 384; item += G) {
            const int l = item / 96, cgi = item % 96, ks = tid >> 6, jl = tid & 63, col = cgi * 64 + jl;
            const float* w = wmod + ((size_t)l * 1024 + ks * 128) * 6144 + col;
            float a0 = 0.f, a1 = 0.f, a2 = 0.f, a3 = 0.f, a4 = 0.f;
#pragma unroll 8
            for (int k = 0; k < 128; ++k) { const float wv = w[(size_t)k * 6144]; const int kk = ks * 128 + k;
                a0 += S[kk] * wv; a1 += S[1024 + kk] * wv; a2 += S[2048 + kk] * wv; a3 += S[3072 + kk] * wv; a4 += S[4096 + kk] * wv; }
            RED[(ks * 5 + 0) * 64 + jl] = a0; RED[(ks * 5 + 1) * 64 + jl] = a1; RED[(ks * 5 + 2) * 64 + jl] = a2; RED[(ks * 5 + 3) * 64 + jl] = a3; RED[(ks * 5 + 4) * 64 + jl] = a4;
            __syncthreads();
            if (tid < 320) { const int bi = tid >> 6, j = tid & 63; float s = bmod[l * 6144 + cgi * 64 + j];
#pragma unroll
                for (int k2 = 0; k2 < 8; ++k2) s += RED[(k2 * 5 + bi) * 64 + j];
                MOD[((size_t)l * 5 + bi) * 6144 + cgi * 64 + j] = s; }
            __syncthreads();
        }
        if (bx == 0 && wave < 4) { const int l = wave;
            const float s1 = wave_sum(a.in[opq(13)][l * 64 + lane] * a.in[opq(14)][l * 64 + lane]), s2 = wave_sum(a.in[opq(15)][l * 64 + lane] * a.in[opq(16)][l * 64 + lane]);
            if (lane == 0) LAM[l] = expf(s1) - expf(s2) + (0.8f - 0.6f * expf(-0.3f * (float)l)); }
        const int gt = bx * NTHR + tid;
        if (gt < 2048) { const int p = gt >> 4, f = gt & 15; const float inv = powf(10000.0f, -(float)f / 16.0f); float sn, cs; sincosf((float)p * inv, &sn, &cs); ROPE[gt] = mk2(cs, sn); }
        for (int m = gt; m < FFTN; m += G * NTHR) { float sn, cs; sincospif((float)m / 8192.0f, &sn, &cs); TW[m] = mk2(cs, -sn); }
    }
    if (PROBE_PLAIN_LAUNCH) xcd_barrier(xbar, wave0); else grid.sync();
    if (threadIdx.x == 0) {
        bool ok = (G % 8 == 0) && xbar.x < 8u;
        for (int j = 0; j < 8; ++j) ok = ok && (xb_ld((unsigned*)a.ws + 4096 + 64 * j) == (unsigned)(G / 8));
        const unsigned rk = MISC[2];
        MISC[0] = ok ? rk * 8u + xbar.x : (unsigned)bx;
        MISC[1] = ok ? xbar.x * (unsigned)(G / 8) + rk : (unsigned)((G % 8 == 0) ? (bx % 8) * (G / 8) + bx / 8 : bx);
    }
    __syncthreads();
    const int cbx = __builtin_amdgcn_readfirstlane((int)MISC[0]), vcu = __builtin_amdgcn_readfirstlane((int)MISC[1]);

    for (int l = 0; l < DEPTH; ++l) {
        const bool need_ctx = l < DEPTH - 1;
        const float* xl = l == 0 ? a.in[opq(0)] : OUT; const float* xc = l == 0 ? a.in[opq(2)] : CTXX;
        const float* modl = MOD + (size_t)l * 5 * 6144;
        for (int rep_ = 0; rep_ < REP_PREP; ++rep_) {
            PHASE_IDS
            __syncthreads();
            prep_work(a, lds, l, need_ctx, bx, G, l == 0, true, tid, lane, wave);
            norm_mod(xl, xc, a.in[opq(4)] + l * 1024, modl, 0, 1024, H, MT, gw, NGW, lane);
        }
        xcd_barrier(xbar, wave0);
        {
            pg8::Gemm g{H, WIN, MT, INW, 1024}; pg8::StaticOrder S; S.init(MT, INW, G, cbx);
            EpiInProj E{QA, KA, VA, QD, KD, VD, HYR, HYRC, a.in[opq(9)] + l * 64, a.in[opq(10)] + l * 64, a.in[opq(11)] + l * 64, a.in[opq(12)] + l * 64, ROPE};
            pg8::gemm_phase<EpiInProj, pg8::StaticOrder, PG8_ALIGN, PG8_SP2>(lds, g, S, E, wave0);
        }
        xcd_barrier(xbar, wave0);
        {
            PHASE_IDS
            LAS cf* X = (LAS cf*)lds; LAS float* RED = (LAS float*)(lds + 135168);
            const float* cw = a.in[opq(17)] + l * 3 * 768; const float* cb = a.in[opq(18)] + l * 768; const float* hb_ = a.in[opq(26)] + l * 512;
            for (int rep_ = 0; rep_ < REP_HY; ++rep_) for (int c = vcu; c < 256; c += G) {
                const float wv0 = cw[c], wv1 = cw[768 + c], wv2 = cw[1536 + c], bv = cb[c];
                const float wa0 = cw[256 + c], wa1 = cw[768 + 256 + c], wa2 = cw[1536 + 256 + c], ba = cb[256 + c];
                const float wb0 = cw[512 + c], wb1 = cw[768 + 512 + c], wb2 = cw[1536 + 512 + c], bb = cb[512 + c];
                const float bias1 = hb_[c], bias2 = hb_[256 + c];
                cf* KF = KFB + (size_t)c * 2 * FFTN;
                const int cw = 8 * (lane & 7) + (lane >> 3);
                for (int o = 0; o < 2; ++o) {
                    const float* hf = FILT + ((size_t)(0 * 2 + o) * 256 + c) * 8192; const float* hb = FILT + ((size_t)(1 * 2 + o) * 256 + c) * 8192;
                    float s = 0.f; for (int i = tid; i < 8192; i += NTHR) s += fabsf(hf[i]) + fabsf(hb[i]);
                    s = block_sum(s, RED, tid); const float inv = 1.0f / (s + EPSF);
                    for (int i = tid; i < 8192; i += NTHR) { X[PX(i)] = mk2(hf[i] * inv, 0.f); X[PX(8192 + i)] = (i == 0) ? mk2(0.f, 0.f) : mk2(hb[8192 - i] * inv, 0.f); }
                    __syncthreads();
                    fft_fwd_lds(X, tid);
                    fft_last_fwd(X, tid, KF + o * FFTN, o == 0 ? bias1 : bias2, 1.0f / FFTN);
                }
                __threadfence(); __syncthreads();
                for (int bp = 0; bp < 2; ++bp) {
                    const int b0 = 2 * bp, b1 = b0 + 1;
                    const bf16_t* pv0 = HYR + ((size_t)b0 * 768 + c) * 8192; const bf16_t* pv1 = HYR + ((size_t)b1 * 768 + c) * 8192;
#pragma unroll 1
                    for (int k = 0; k < 2; ++k) { const int ch = 64 * (wave + 8 * k) + cw; float u0[8], u1[8];
                        conv8(pv0, ch, 8192, wv0, wv1, wv2, bv, u0); conv8(pv1, ch, 8192, wv0, wv1, wv2, bv, u1);
#pragma unroll
                        for (int e = 0; e < 8; ++e) { X[PX(8 * ch + e)] = mk2(u0[e], u1[e]); X[PX(8192 + 8 * ch + e)] = mk2(0.f, 0.f); } }
                    __syncthreads();
                    fft_fwd_lds(X, tid); fft_mid_mul(X, tid, KF); fft_inv_lds(X, tid);
#pragma unroll 1
                    for (int k = 0; k < 2; ++k) { const int ch = 64 * (wave + 8 * k) + cw; float a0_[8], a1_[8];
                        conv8(pv0 + 256 * 8192, ch, 8192, wa0, wa1, wa2, ba, a0_); conv8(pv1 + 256 * 8192, ch, 8192, wa0, wa1, wa2, ba, a1_);
#pragma unroll
                        for (int e = 0; e < 8; ++e) { const cf cv = X[PX(8 * ch + e)]; X[PX(8 * ch + e)] = mk2(a0_[e] * cv.x, a1_[e] * cv.y); X[PX(8192 + 8 * ch + e)] = mk2(0.f, 0.f); } }
                    __syncthreads();
                    fft_fwd_lds(X, tid); fft_mid_mul(X, tid, KF + FFTN); fft_inv_lds(X, tid);
#pragma unroll 1
                    for (int k = 0; k < 2; ++k) { const int ch = 64 * (wave + 8 * k) + cw; float x0_[8], x1_[8];
                        conv8(pv0 + 512 * 8192, ch, 8192, wb0, wb1, wb2, bb, x0_); conv8(pv1 + 512 * 8192, ch, 8192, wb0, wb1, wb2, bb, x1_);
                        f32x4 o0a, o0b, o1a, o1b;
#pragma unroll
                        for (int e = 0; e < 4; ++e) { const cf ca = X[PX(8 * ch + e)], cb2 = X[PX(8 * ch + 4 + e)]; o0a[e] = x0_[e] * ca.x; o1a[e] = x1_[e] * ca.y; o0b[e] = x0_[4 + e] * cb2.x; o1b[e] = x1_[4 + e] * cb2.y; }
                        float* y0p = YH + ((size_t)b0 * 256 + c) * 8192 + 8 * ch; float* y1p = YH + ((size_t)b1 * 256 + c) * 8192 + 8 * ch;
                        *(f32x4*)y0p = o0a; *(f32x4*)(y0p + 4) = o0b; *(f32x4*)y1p = o1a; *(f32x4*)(y1p + 4) = o1b; }
                    __syncthreads();
                }
                if (need_ctx) {
                    int tidc = tid; asm volatile("" : "+v"(tidc));
                    LAS float* KC = (LAS float*)lds; LAS float* U = KC + 1024; LAS float* XA = U + 1024; LAS float* XB = XA + 1024; LAS float* Z1 = XB + 1024;
                    for (int o = 0; o < 2; ++o) {
                        const float* hf = FILTC + ((size_t)(0 * 2 + o) * 256 + c) * 256; const float* hb = FILTC + ((size_t)(1 * 2 + o) * 256 + c) * 256;
                        const float f_ = tid < 256 ? hf[tid] : 0.f, b_ = tid < 256 ? hb[tid] : 0.f;
                        float s = fabsf(f_) + fabsf(b_);
                        s = block_sum(s, RED, tid); const float inv = 1.0f / (s + EPSF);
                        if (tid < 256) { KC[o * 512 + 255 + tid] = f_ * inv; if (tid > 0) KC[o * 512 + 255 - tid] = b_ * inv; }
                    }
#pragma unroll 1
                    for (int k = 0; k < 2; ++k) { const int i = tidc + 512 * k, b = i >> 8, t = i & 255; const bf16_t* p = HYRC + ((size_t)b * 768 + c) * 256;
                        U[i] = hy_in(p, t, 256, wv0, wv1, wv2, bv); XA[i] = hy_in(p + 256 * 256, t, 256, wa0, wa1, wa2, ba); XB[i] = hy_in(p + 512 * 256, t, 256, wb0, wb1, wb2, bb); }
                    __syncthreads();
#pragma unroll 1
                    for (int k = 0; k < 2; ++k) { const int i = tidc + 512 * k, b = i >> 8, t = i & 255; float acc = 0.f; const LAS float* kp = KC + 255 + t; const LAS float* up = U + b * 256;
#pragma unroll 8
                        for (int s = 0; s < 256; ++s) acc += kp[-s] * up[s];
                        Z1[i] = XA[i] * (acc + bias1 * U[i]); }
                    __syncthreads();
#pragma unroll 1
                    for (int k = 0; k < 2; ++k) { const int i = tidc + 512 * k, b = i >> 8, t = i & 255; float acc = 0.f; const LAS float* kp = KC + 512 + 255 + t; const LAS float* up = Z1 + b * 256;
#pragma unroll 8
                        for (int s = 0; s < 256; ++s) acc += kp[-s] * up[s];
                        YHC[((size_t)b * 256 + c) * 256 + t] = XB[i] * (acc + bias2 * Z1[i]); }
                    __syncthreads();
                }
            }
            for (int rep_ = 0; rep_ < REP_ATT; ++rep_) {
                const int nA = 16 * 32 + (need_ctx ? 16 : 0), nC = 32 * 32 + (need_ctx ? 32 : 0);
                for (int u = vcu; u < nA; u += G) {
                    const bool isc = u >= 16 * 32; const int hu = isc ? u - 16 * 32 : (u >> 5), qb = u & 31, b = hu >> 2, k = hu & 3, row0 = isc ? ML + b * 256 : b * 8192 + qb * 256;
                    attn_body::attn_unit<8, false, 256, 64, 64, 1280>((const attn_body::bf16*)(QA + k * 64 + (size_t)row0 * 256), (const attn_body::bf16*)(KA + (size_t)(b * 2 + (k >> 1)) * NKEY * 64), (const attn_body::bf16*)(VA + (size_t)(b * 2 + (k >> 1)) * NKEY * 64),
                        (attn_body::bf16*)(YRAW + k * 64 + (size_t)row0 * 1280), isc ? 4 : 132, (char*)lds_raw, wave0);
                }
                for (int u = vcu; u < nC; u += G) {
                    const bool isc = u >= 32 * 32; const int hu = isc ? u - 32 * 32 : (u >> 5), qb = u & 31, b = hu >> 3, h = (hu & 7) >> 1, j = hu & 1, row0 = isc ? ML + b * 256 : b * 8192 + qb * 256;
                    attn_body::attn_unit<8, true, 512, 64, 128, 1280>((const attn_body::bf16*)(QD + (h * 2 + j) * 64 + (size_t)row0 * 512), (const attn_body::bf16*)(KD + (size_t)(b * 8 + h * 2 + j) * NKEY * 64), (const attn_body::bf16*)(VD + (size_t)(b * 4 + h) * NKEY * 128),
                        (attn_body::bf16*)(YRAW + 256 + j * 512 + h * 128 + (size_t)row0 * 1280), isc ? 4 : 132, (char*)lds_raw, wave0);
                }
            }
        }
        xcd_barrier(xbar, wave0);
        for (int rep_ = 0; rep_ < REP_MERGE; ++rep_) {
            PHASE_IDS
            LAS float* S = (LAS float*)lds;
            const float* go = a.in[opq(27)] + l * 1024;
            const float lam = LAM[l], lam_init = 0.8f - 0.6f * expf(-0.3f * (float)l);
            const int ntile = need_ctx ? 528 : 512;
            for (int tl = bx; tl < ntile; tl += G) {
                const int r0 = tl * 64; const float* yb; int cstride;
                if (r0 < ML) { yb = YH + (size_t)(r0 >> 13) * 256 * 8192 + (r0 & 8191); cstride = 8192; } else { const int rr = r0 - ML; yb = YHC + (size_t)(rr >> 8) * 256 * 256 + (rr & 255); cstride = 256; }
                for (int i = 0; i < 32; ++i) { const int c = i * 8 + wave; S[lane * 257 + c] = yb[(size_t)c * cstride + lane]; }
                __syncthreads();
                for (int k = 0; k < 8; ++k) {
                    const int row = wave * 8 + k, r = r0 + row; const bf16_t* yr = YRAW + (size_t)r * 1280; bf16_t* hr = H + (size_t)r * 1024;
                    { const v2u w = *(const v2u*)(yr + 4 * lane); const float y0 = bflo(w.x), y1 = bfhi(w.x), y2 = bflo(w.y), y3 = bfhi(w.y);
                      const float ss = wave_sum(y0 * y0 + y1 * y1 + y2 * y2 + y3 * y3); const float rinv = 1.0f / sqrtf(ss * (1.0f / 256.0f) + EPSF);
                      const f32x4 g4 = *(const f32x4*)(go + 4 * lane); v2u o; o.x = pk2(y0 * rinv * g4.x, y1 * rinv * g4.y); o.y = pk2(y2 * rinv * g4.z, y3 * rinv * g4.w); *(v2u*)(hr + 4 * lane) = o; }
                    { const float y0 = S[row * 257 + 4 * lane], y1 = S[row * 257 + 4 * lane + 1], y2 = S[row * 257 + 4 * lane + 2], y3 = S[row * 257 + 4 * lane + 3];
                      const float ss = wave_sum(y0 * y0 + y1 * y1 + y2 * y2 + y3 * y3); const float rinv = 1.0f / sqrtf(ss * (1.0f / 256.0f) + EPSF);
                      const f32x4 g4 = *(const f32x4*)(go + 256 + 4 * lane); v2u o; o.x = pk2(y0 * rinv * g4.x, y1 * rinv * g4.y); o.y = pk2(y2 * rinv * g4.z, y3 * rinv * g4.w); *(v2u*)(hr + 256 + 4 * lane) = o; }
                    { const v4u w0 = *(const v4u*)(yr + 256 + 8 * lane), w1 = *(const v4u*)(yr + 768 + 8 * lane);
                      float d[8];
                      d[0] = bflo(w0.x) - lam * bflo(w1.x); d[1] = bfhi(w0.x) - lam * bfhi(w1.x); d[2] = bflo(w0.y) - lam * bflo(w1.y); d[3] = bfhi(w0.y) - lam * bfhi(w1.y);
                      d[4] = bflo(w0.z) - lam * bflo(w1.z); d[5] = bfhi(w0.z) - lam * bfhi(w1.z); d[6] = bflo(w0.w) - lam * bflo(w1.w); d[7] = bfhi(w0.w) - lam * bfhi(w1.w);
                      float ss = 0.f;
#pragma unroll
                      for (int q = 0; q < 8; ++q) ss += d[q] * d[q];
                      ss += shx(ss, 1, lane); ss += shx(ss, 2, lane); ss += shx(ss, 4, lane); ss += shx(ss, 8, lane);
                      const float rinv = (1.0f - lam_init) / sqrtf(ss * (1.0f / 128.0f) + EPSF);
                      const f32x4 ga = *(const f32x4*)(go + 512 + 8 * lane), gb = *(const f32x4*)(go + 512 + 8 * lane + 4);
                      v4u o; o.x = pk2(d[0] * rinv * ga.x, d[1] * rinv * ga.y); o.y = pk2(d[2] * rinv * ga.z, d[3] * rinv * ga.w); o.z = pk2(d[4] * rinv * gb.x, d[5] * rinv * gb.y); o.w = pk2(d[6] * rinv * gb.z, d[7] * rinv * gb.w);
                      *(v4u*)(hr + 512 + 8 * lane) = o; }
                }
                __syncthreads();
            }
        }
        xcd_barrier(xbar, wave0);
        for (int es_ = 0; es_ < EXTRA_SYNC; ++es_) xcd_barrier(xbar, wave0);
        const int M5 = need_ctx ? MT : ML;
        {
            pg8::Gemm g{H, WOUT, M5, 1024, 1024}; pg8::StaticOrder S; S.init(M5, 1024, G, cbx);
            EpiGateRes E{xl, OUT, xc, CTXX, modl + 2048, 0};
            pg8::gemm_phase<EpiGateRes, pg8::StaticOrder, PG8_ALIGN, PG8_SP2>(lds, g, S, E, wave0);
            for (int rep_ = 1; rep_ < REP_GEMM2; ++rep_) { EpiGateRes E2{OUT, OUT, CTXX, CTXX, (const float*)(wsb(a.ws) + 65536), 0}; pg8::gemm_phase<EpiGateRes, pg8::StaticOrder, PG8_ALIGN, PG8_SP2>(lds, g, S, E2, wave0); }
        }
        xcd_barrier(xbar, wave0);
        for (int rep_ = 0; rep_ < REP_N2; ++rep_) { PHASE_IDS norm_mod(OUT, CTXX, a.in[opq(5)] + l * 1024, modl, 3072, 4096, H, M5, gw, NGW, lane); }
        xcd_barrier(xbar, wave0);
        {
            const int ntm = (M5 + 247) / 248;
            pg8::Gemm g{H - 1024, WUP, ntm * 256, 2 * DFF, 1024}; pg8::StaticOrder S; S.init(ntm * 256, 2 * DFF, G, cbx);
            EpiGlu E{GB, a.in[opq(30)] + (size_t)l * 3 * DFF, a.in[opq(31)] + l * DFF, M5};
            pg8::gemm_phase<EpiGlu, pg8::StaticOrder, PG8_ALIGN, PG8_SP2, true>(lds, g, S, E, wave0);
        }
        xcd_barrier(xbar, wave0);
        {
            pg8::Gemm g{GB, WDN, M5, 1024, DFF}; pg8::StaticOrder S; S.init(M5, 1024, G, cbx);
            EpiGateRes E{OUT, OUT, CTXX, CTXX, modl + 5120, 0};
            pg8::gemm_phase<EpiGateRes, pg8::StaticOrder, PG8_ALIGN, PG8_SP2>(lds, g, S, E, wave0);
            if (l + 1 < DEPTH) { const int units = (M5 >> 8) * 4, first = units % G;
                if (cbx >= first) { PHASE_IDS __syncthreads(); prep_work(a, lds, l + 1, l + 1 < DEPTH - 1, cbx - first, G - first, true, false, tid, lane, wave); } }
        }
        xcd_barrier(xbar, wave0);
    }
}

extern "C" void kernel_launch(void* const* d_in, const int* in_sizes, int n_in, void* d_out, int out_size, void* d_ws, size_t ws_size, hipStream_t stream) {
    static int grid = 0;
    if (grid == 0) {
        if (n_in != 33 || out_size != ML * DMOD || ws_size < WS_END) { fprintf(stderr, "kernel_launch: unexpected shapes: n_in %d out %d ws %zu (need %zu)\n", n_in, out_size, ws_size, (size_t)WS_END); grid = -1; return; }
        int dev = 0, cus = 0, per_cu = 0;
        if (hipGetDevice(&dev) != hipSuccess || hipDeviceGetAttribute(&cus, hipDeviceAttributeMultiprocessorCount, dev) != hipSuccess) { grid = -1; return; }
        if (hipFuncSetAttribute((const void*)fwd_mega, hipFuncAttributeMaxDynamicSharedMemorySize, LDS_BYTES) != hipSuccess) { fprintf(stderr, "kernel_launch: hipFuncSetAttribute failed\n"); grid = -1; return; }
        if (hipOccupancyMaxActiveBlocksPerMultiprocessor(&per_cu, (const void*)fwd_mega, NTHR, LDS_BYTES) != hipSuccess || per_cu < 1) { fprintf(stderr, "kernel_launch: occupancy query says %d\n", per_cu); }
        (void)hipGetLastError();
        grid = cus;
    }
    if (grid < 0) return;
    Args a{};
    for (int i = 0; i < 33; ++i) a.in[i] = (const float*)d_in[i];
    a.out = (float*)d_out; a.ws = (unsigned char*)d_ws;
    if (hipMemsetAsync(d_ws, 0, 32768, stream) != hipSuccess) { fprintf(stderr, "kernel_launch: memset failed\n"); return; }
    void* args[] = {&a};
#if PROBE_PLAIN_LAUNCH
    hipLaunchKernelGGL(fwd_mega, dim3(grid), dim3(NTHR), LDS_BYTES, stream, a); const hipError_t e = hipPeekAtLastError(); (void)args;
#else
    const hipError_t e = hipLaunchCooperativeKernel((const void*)fwd_mega, dim3(grid), dim3(NTHR), args, LDS_BYTES, stream);
#endif
    if (e != hipSuccess) fprintf(stderr, "kernel_launch: cooperative launch failed: %s (grid %d)\n", hipGetErrorString(e), grid);
}
```

```cpp
#include <hip/hip_runtime.h>
#include <cstdio>
#include <cstdint>
__device__ __forceinline__ int lane_id_v() { int l; asm volatile("v_mbcnt_lo_u32_b32 %0, -1, 0\n\tv_mbcnt_hi_u32_b32 %0, -1, %0" : "=v"(l)); return l; }
namespace pg8 {
#define PG8_LAS __attribute__((address_space(3)))
typedef unsigned short bf16_t;
typedef short bf16x8 __attribute__((ext_vector_type(8)));
typedef float f32x4 __attribute__((ext_vector_type(4)));
typedef unsigned u32x4 __attribute__((ext_vector_type(4)));
constexpr int BM = 256, BK = 64, HALF = 128, HTB = HALF * BK * 2  , STAGE_BYTES = 8 * HTB, NXCD = 8, WGM = 8;

__host__ __device__ __forceinline__ int lds_byte(int r, int c) { const int st = (r >> 4) * 2 + (c >> 5), rr = r & 15, cc = c & 31, ob = rr * 64 + cc * 2; return st * 1024 + (ob ^ (((ob >> 9) & 1) << 5)); }
__host__ __device__ __forceinline__ void stage_rc(int b, int& R, int& C) { const int st = b / 1024, sb = b % 1024, swz = sb ^ (((sb >> 9) & 1) << 5); R = (st >> 1) * 16 + swz / 64; C = (st & 1) * 32 + (swz % 64) / 2; }
__host__ __device__ __forceinline__ int perm32(int rho) { const int n = rho >> 4, i = rho & 15; return 8 * (i >> 2) + 4 * n + (i & 3); }

struct Unit { int pm, pn; };
struct Gemm { const bf16_t* A; const bf16_t* Bt; int M, N, K; };

struct StaticOrder {
    int nM, nN, nwg, G, c;
    __host__ __device__ void init(int M, int N, int G_, int c_) { nM = M / BM; nN = N / BM; nwg = nM * nN; G = G_; c = c_; }
    __host__ __device__ bool next(int i, Unit& u) const {
        const long L = (long)i * G + c; if (L >= nwg) return false;
        int wgid = (int)L; { const int q = nwg / NXCD, r = nwg % NXCD, xcd = wgid % NXCD, off = wgid / NXCD; wgid = (xcd < r ? xcd * (q + 1) : r * (q + 1) + (xcd - r) * q) + off; }
        const int nig = WGM * nN, gid = wgid / nig, fm = gid * WGM, gsz = (nM - fm) < WGM ? (nM - fm) : WGM;
        u.pm = fm + ((wgid % nig) % gsz); u.pn = (wgid % nig) / gsz; return true;
    }
    __device__ __forceinline__ void a_ready(const Unit&) const {}
    __device__ __forceinline__ void done(const Unit&) const {}
};

__device__ __forceinline__ unsigned cvt_pk_bf16(float lo, float hi) { unsigned r; asm volatile("v_cvt_pk_bf16_f32 %0, %1, %2" : "=v"(r) : "v"(lo), "v"(hi)); return r; }
typedef float f32x2 __attribute__((ext_vector_type(2)));
__device__ __forceinline__ f32x2 gelu_pk(f32x2 v) {
    const f32x2 av = __builtin_elementwise_abs(v), d = av * 0.2316418882f + 1.0f;
    f32x2 t; t.x = __builtin_amdgcn_rcpf(d.x); t.y = __builtin_amdgcn_rcpf(d.y);
    f32x2 q = t * 0.5307027145f + (-0.7265760135f); q = q * t + 0.7107068705f; q = q * t + (-0.142248368f); q = q * t + 0.127414796f; q = q * t;
    const f32x2 s = (v * v) * (-0.72134752044f);
    f32x2 e; e.x = __builtin_amdgcn_exp2f(s.x); e.y = __builtin_amdgcn_exp2f(s.y);
    const f32x2 m = v * (q * e), r = v - m;
    f32x2 o; o.x = v.x < 0.f ? m.x : r.x; o.y = v.y < 0.f ? m.y : r.y; return o;
}

template <int ACT  > struct EpiBf16 {
    static constexpr bool PERM = true, AFTER_DRAIN = false; static_assert(ACT == 0 || ACT == 1, "EpiBf16: ACT is 0 (none) or 1 (gelu_pk)");
    bf16_t* O; int ldc; const float* bias; int split_cols; size_t split_stride; float scale0;
    __device__ __forceinline__ void operator()(const f32x4 (&acc)[2][2][4][2], const Unit& u, int wr, int wc, int fr, int fq) const {
        const int row0 = u.pm * BM + wr * 64 + fr; int colt = u.pn * BM; bf16_t* base = O;
        float sc = 1.f; if (split_cols) { const int t = colt / split_cols; base += (size_t)t * split_stride; colt -= t * split_cols; if (t == 0) sc = scale0; }
        const int col0 = colt + wc * 32 + 8 * fq, bcol0 = u.pn * BM + wc * 32 + 8 * fq;
        f32x4 bv[2][2];
#pragma unroll
        for (int bj = 0; bj < 2; ++bj)
#pragma unroll
            for (int n = 0; n < 2; ++n) bv[bj][n] = bias ? *(const f32x4*)(bias + bcol0 + bj * HALF + 4 * n) : (f32x4){0.f, 0.f, 0.f, 0.f};
#pragma unroll
        for (int ai = 0; ai < 2; ++ai)
#pragma unroll
            for (int m = 0; m < 4; ++m) { bf16_t* rowp = base + (size_t)(row0 + ai * HALF + m * 16) * ldc + col0;
#pragma unroll
                for (int bj = 0; bj < 2; ++bj) { f32x4 v0 = acc[ai][bj][m][0] + bv[bj][0], v1 = acc[ai][bj][m][1] + bv[bj][1];
                    if (ACT == 1) { f32x2 a = gelu_pk((f32x2){v0[0], v0[1]}), b = gelu_pk((f32x2){v0[2], v0[3]}), c = gelu_pk((f32x2){v1[0], v1[1]}), d = gelu_pk((f32x2){v1[2], v1[3]});
                        v0 = (f32x4){a.x, a.y, b.x, b.y}; v1 = (f32x4){c.x, c.y, d.x, d.y}; }
                    v0 = v0 * sc; v1 = v1 * sc; u32x4 w; w.x = cvt_pk_bf16(v0[0], v0[1]); w.y = cvt_pk_bf16(v0[2], v0[3]); w.z = cvt_pk_bf16(v1[0], v1[1]); w.w = cvt_pk_bf16(v1[2], v1[3]);
                    *(u32x4*)(rowp + bj * HALF) = w; } }
    }
};
template <class Epi, class Sched, bool ALIGN_EPI = false, bool SP2 = false, bool HALO = false>
__device__ __forceinline__ void gemm_phase(PG8_LAS unsigned char* lds, const Gemm g, const Sched& S, const Epi& E, const int wave0) {
    int tid_o = wave0 * 64 + lane_id_v(); asm volatile("" : "+v"(tid_o));
    const int tid = tid_o, wid = __builtin_amdgcn_readfirstlane(tid >> 6), lane = tid & 63, wr = wid >> 2, wc = wid & 3, fr = lane & 15, fq = lane >> 4;
    const int K = g.K, nt = K / BK;
    unsigned voffA[2], voffB[2];
#pragma unroll
    for (int i = 0; i < 2; ++i) { int R, C; stage_rc(tid * 16 + i * 8192, R, C); const int Rb = Epi::PERM ? ((R & ~31) + perm32(R & 31)) : R;
        voffA[i] = HALO ? (unsigned)(((R & 63) + 62 * (R >> 6)) * K + C) * 2u : (unsigned)(R * K + C) * 2u; voffB[i] = (unsigned)(Rb * K + C) * 2u; }
    const size_t kstep = (size_t)(BK * 2);
    const size_t hstep = (size_t)HALF * K * 2;
    const size_t tstep = 2 * hstep;
    const size_t hstepA = HALO ? (size_t)124 * K * 2 : hstep, tstepA = 2 * hstepA;
    const unsigned ldsw = (unsigned)wid * 1024u;
    const int aoff = lds_byte(wr * 64 + fr, fq * 8), boff = lds_byte(wc * 32 + fr, fq * 8);
#define PG8_SA(b, h) (((b) * 2 + (h)) * HTB)
#define PG8_SB(b, h) ((4 + (b) * 2 + (h)) * HTB)
#define PG8_STAGE(bufoff, gbase, voff) do { _Pragma("unroll") for (int _i = 0; _i < 2; ++_i) \
        __builtin_amdgcn_global_load_lds((const unsigned*)((const char*)(gbase) + (voff)[_i]), (PG8_LAS unsigned*)(lds + (bufoff) + ldsw + _i * 8192), 16, 0, 0); } while (0)
#define PG8_LDA(dst, b, h) do { _Pragma("unroll") for (int m = 0; m < 4; ++m) _Pragma("unroll") for (int k = 0; k < 2; ++k) dst[m][k] = *(const PG8_LAS bf16x8*)(lds + PG8_SA(b, h) + aoff + m * 2048 + k * 1024); } while (0)
#define PG8_LDB(dst, b, h) do { _Pragma("unroll") for (int n = 0; n < 2; ++n) _Pragma("unroll") for (int k = 0; k < 2; ++k) dst[n][k] = *(const PG8_LAS bf16x8*)(lds + PG8_SB(b, h) + boff + n * 2048 + k * 1024); } while (0)
#define PG8_MMA(ai, bj, At, Bt) do { __builtin_amdgcn_s_setprio(1); _Pragma("unroll") for (int m = 0; m < 4; ++m) _Pragma("unroll") for (int n = 0; n < 2; ++n) _Pragma("unroll") for (int k = 0; k < 2; ++k) \
        acc[ai][bj][m][n] = __builtin_amdgcn_mfma_f32_16x16x32_bf16(Bt[n][k], At[m][k], acc[ai][bj][m][n], 0, 0, 0); __builtin_amdgcn_s_setprio(0); } while (0)
#define PG8_WAIT_V(n) asm volatile("s_waitcnt vmcnt(" #n ")" ::: "memory")
#define PG8_WAIT_L(n) asm volatile("s_waitcnt lgkmcnt(" #n ")" ::: "memory")
#define PG8_BAR __builtin_amdgcn_s_barrier()
#define PG8_SCHED __builtin_amdgcn_sched_barrier(0)
    Unit cur, nxt; int ui = 0;
    if (!S.next(0, cur)) return;
    f32x4 acc[2][2][4][2];
#pragma unroll
    for (int a = 0; a < 2; ++a)
#pragma unroll
        for (int b = 0; b < 2; ++b)
#pragma unroll
            for (int m = 0; m < 4; ++m)
#pragma unroll
                for (int n = 0; n < 2; ++n) acc[a][b][m][n] = (f32x4){0.f, 0.f, 0.f, 0.f};
    bf16x8 At[4][2], B0[2][2], B1[2][2];
    const char* cA = (const char*)g.A + (size_t)cur.pm * tstepA; const char* cB = (const char*)g.Bt + (size_t)cur.pn * tstep;
    S.a_ready(cur);
    if constexpr (SP2) {
        PG8_STAGE(PG8_SB(0, 0), cB, voffB); PG8_STAGE(PG8_SB(0, 1), cB + hstep, voffB); PG8_STAGE(PG8_SA(0, 0), cA, voffA); PG8_STAGE(PG8_SA(0, 1), cA + hstepA, voffA);
        if (wr == 1) PG8_BAR;
        PG8_WAIT_V(2); PG8_BAR;
        PG8_STAGE(PG8_SB(1, 0), cB + kstep, voffB); PG8_STAGE(PG8_SA(1, 0), cA + kstep, voffA); PG8_STAGE(PG8_SB(1, 1), cB + hstep + kstep, voffB);
        PG8_WAIT_V(6); PG8_BAR;
    } else {
        PG8_STAGE(PG8_SB(0, 0), cB, voffB); PG8_STAGE(PG8_SA(0, 0), cA, voffA); PG8_STAGE(PG8_SB(0, 1), cB + hstep, voffB); PG8_STAGE(PG8_SA(0, 1), cA + hstepA, voffA);
        if (wr == 1) PG8_BAR;
        PG8_WAIT_V(4); PG8_BAR;
        PG8_STAGE(PG8_SB(1, 0), cB + kstep, voffB); PG8_STAGE(PG8_SA(1, 0), cA + kstep, voffA); PG8_STAGE(PG8_SB(1, 1), cB + hstep + kstep, voffB);
        PG8_WAIT_V(6); PG8_BAR;
    }
    for (;;) {
        const bool has_next = S.next(ui + 1, nxt);
        const char* nA = has_next ? (const char*)g.A + (size_t)nxt.pm * tstepA : cA; const char* nB = has_next ? (const char*)g.Bt + (size_t)nxt.pn * tstep : cB;
        for (int t = 0; t < nt; t += 2) {
            const bool last = (t == nt - 2);
            const char* a1 = cA + (size_t)(t + 1) * kstep;
            const char* a2 = last ? nA : cA + (size_t)(t + 2) * kstep; const char* b2 = last ? nB : cB + (size_t)(t + 2) * kstep;
            const char* a3 = a2 + kstep; const char* b3 = b2 + kstep;
            if (last && has_next) S.a_ready(nxt);
            if constexpr (SP2) {
            PG8_LDB(B0, 0, 0); PG8_LDB(B1, 0, 1); PG8_SCHED; PG8_LDA(At, 0, 0); PG8_STAGE(PG8_SA(1, 1), a1 + hstepA, voffA);
            PG8_WAIT_V(8); PG8_WAIT_L(0); PG8_BAR; PG8_MMA(0, 0, At, B0); PG8_MMA(0, 1, At, B1); PG8_BAR; PG8_SCHED;
            PG8_LDA(At, 0, 1); PG8_STAGE(PG8_SB(0, 0), b2, voffB); PG8_STAGE(PG8_SB(0, 1), b2 + hstep, voffB); PG8_STAGE(PG8_SA(0, 0), a2, voffA);
            PG8_WAIT_V(8); PG8_WAIT_L(0); PG8_BAR; PG8_MMA(1, 0, At, B0); PG8_MMA(1, 1, At, B1); PG8_BAR; PG8_SCHED;
            PG8_LDB(B0, 1, 0); PG8_LDB(B1, 1, 1); PG8_SCHED; PG8_LDA(At, 1, 0); PG8_STAGE(PG8_SA(0, 1), a2 + hstepA, voffA);
            PG8_WAIT_V(8); PG8_WAIT_L(0); PG8_BAR; PG8_MMA(0, 0, At, B0); PG8_MMA(0, 1, At, B1); PG8_BAR; PG8_SCHED;
            PG8_LDA(At, 1, 1); PG8_STAGE(PG8_SB(1, 0), b3, voffB); PG8_STAGE(PG8_SB(1, 1), b3 + hstep, voffB); PG8_STAGE(PG8_SA(1, 0), a3, voffA);
            PG8_WAIT_V(8); PG8_WAIT_L(0); PG8_BAR; PG8_MMA(1, 0, At, B0); PG8_MMA(1, 1, At, B1); PG8_BAR; PG8_SCHED;
            } else {
            PG8_LDB(B0, 0, 0); PG8_SCHED; PG8_LDA(At, 0, 0); PG8_STAGE(PG8_SA(1, 1), a1 + hstepA, voffA);
            PG8_WAIT_L(8); PG8_BAR; PG8_WAIT_L(0); PG8_MMA(0, 0, At, B0); PG8_BAR; PG8_SCHED;
            PG8_LDB(B1, 0, 1); PG8_STAGE(PG8_SB(0, 0), b2, voffB);
            PG8_BAR; PG8_WAIT_L(0); PG8_MMA(0, 1, At, B1); PG8_BAR;
            PG8_LDA(At, 0, 1); PG8_STAGE(PG8_SA(0, 0), a2, voffA);
            PG8_BAR; PG8_WAIT_L(0); PG8_MMA(1, 0, At, B0); PG8_BAR; PG8_SCHED;
            PG8_STAGE(PG8_SB(0, 1), b2 + hstep, voffB);
            PG8_WAIT_V(6); PG8_BAR; PG8_MMA(1, 1, At, B1); PG8_BAR;
            PG8_LDB(B0, 1, 0); PG8_SCHED; PG8_LDA(At, 1, 0); PG8_STAGE(PG8_SA(0, 1), a2 + hstepA, voffA);
            PG8_WAIT_L(8); PG8_BAR; PG8_WAIT_L(0); PG8_MMA(0, 0, At, B0); PG8_BAR; PG8_SCHED;
            PG8_LDB(B1, 1, 1); PG8_STAGE(PG8_SB(1, 0), b3, voffB);
            PG8_BAR; PG8_WAIT_L(0); PG8_MMA(0, 1, At, B1); PG8_BAR;
            PG8_LDA(At, 1, 1); PG8_STAGE(PG8_SA(1, 0), a3, voffA);
            PG8_BAR; PG8_WAIT_L(0); PG8_MMA(1, 0, At, B0); PG8_BAR; PG8_SCHED;
            PG8_STAGE(PG8_SB(1, 1), b3 + hstep, voffB);
            PG8_WAIT_V(6); PG8_BAR; PG8_MMA(1, 1, At, B1); PG8_BAR;
            }
        }
        if constexpr (ALIGN_EPI) { if (wr == 0) PG8_BAR; }
        if constexpr (!Epi::AFTER_DRAIN) { E(acc, cur, wr, wc, fr, fq); S.done(cur); }
        if (!has_next) break;
#pragma unroll
        for (int a = 0; a < 2; ++a)
#pragma unroll
            for (int b = 0; b < 2; ++b)
#pragma unroll
                for (int m = 0; m < 4; ++m)
#pragma unroll
                    for (int n = 0; n < 2; ++n) acc[a][b][m][n] = (f32x4){0.f, 0.f, 0.f, 0.f};
        cur = nxt; cA = nA; cB = nB; ++ui;
        if constexpr (ALIGN_EPI) { if (wr == 1) PG8_BAR; }
    }
    PG8_WAIT_V(0);
    if constexpr (!ALIGN_EPI) { if (wr == 0) PG8_BAR; }
    PG8_BAR;
    if constexpr (Epi::AFTER_DRAIN) { E.fused(acc, cur, wr, wc, fr, fq, lds, wid, lane); S.done(cur); }
#undef PG8_SA
#undef PG8_SB
#undef PG8_STAGE
#undef PG8_LDA
#undef PG8_LDB
#undef PG8_MMA
#undef PG8_WAIT_V
#undef PG8_WAIT_L
#undef PG8_BAR
#undef PG8_SCHED
}
}

#ifndef PG8_SP2
#define PG8_SP2 true
#endif
#ifndef PG8_ALIGN
#define PG8_ALIGN true
#endif
#include <hip/hip_bf16.h>
#include <cmath>
namespace attn_body {
using bf16=__hip_bfloat16;
using bf16x8=__attribute__((ext_vector_type(8)))short;
using s16x4=__attribute__((ext_vector_type(4)))short;
using f32x16=__attribute__((ext_vector_type(16)))float;
using u32x4=__attribute__((ext_vector_type(4)))unsigned;
constexpr int D=64;
constexpr int NW=8,QBLK=32,QB=QBLK*NW,KVBLK=64;
constexpr int ATTN_UNIT_ROWS=QB;
__device__ __forceinline__ int crow(int r,int hi){return (r&3)+8*(r>>2)+4*hi;}
#define SBAR() __builtin_amdgcn_sched_barrier(0)
__device__ __forceinline__ void cmask(f32x16&p0,f32x16&p1,int jb,int qrel,int hi){
  const float NEG=-INFINITY; int kb=64*jb+4*hi;
  #pragma unroll
  for(int r=0;r<16;++r){int kv=kb+(r&3)+8*(r>>2); if(kv>qrel)p0[r]=NEG; if(kv+32>qrel)p1[r]=NEG;}
}

constexpr int NSLOT=3, SLOTB=8192;
constexpr int LDS_K=0, LDS_V=NSLOT*SLOTB, LDS_WS=2*NSLOT*SLOTB, LDS_OST=LDS_WS+NW*64*4, LDS_BYTES=LDS_OST+NW*4096;
constexpr float C2=0.125f*1.4426950408889634f;
__device__ __forceinline__ void glds16(const void*gsrc,unsigned lds_dst){unsigned keep;
  asm volatile("s_mov_b32 %0, m0\n\ts_mov_b32 m0, %2\n\ts_nop 0\n\tglobal_load_lds_dwordx4 %1, off\n\ts_mov_b32 m0, %0":"=&s"(keep):"v"(gsrc),"s"(lds_dst):"memory");}
__device__ __forceinline__ float max3f(float a,float b,float c){float r;asm("v_max3_f32 %0, %1, %2, %3":"=v"(r):"v"(a),"v"(b),"v"(c));return r;}
__device__ __forceinline__ float max2f(float a,float b){float r;asm("v_max_f32_e32 %0, %1, %2":"=v"(r):"v"(a),"v"(b));return r;}
__device__ __forceinline__ float fadd_s(float a,float b){float r;asm("v_add_f32_e32 %0, %1, %2":"=v"(r):"v"(a),"v"(b));return r;}
__device__ __forceinline__ float fsub_s(float a,float b){float r;asm("v_sub_f32_e32 %0, %1, %2":"=v"(r):"v"(a),"v"(b));return r;}
typedef float f32x2_t __attribute__((ext_vector_type(2))); typedef __bf16 bf16x2_t __attribute__((ext_vector_type(2)));
__device__ __forceinline__ unsigned cvtpk_s(float lo,float hi){f32x2_t v={lo,hi};bf16x2_t b=__builtin_convertvector(v,bf16x2_t);return __builtin_bit_cast(unsigned,b);}
#define WAIT_BAR(N) asm volatile("s_waitcnt vmcnt(" #N ") lgkmcnt(0)\n\ts_barrier":::"memory")

__device__ __forceinline__ void qkt(f32x16&p0,f32x16&p1,const char*Kslot,const bf16x8*qr,const f32x16&negm,int r32,int hi){
  const char*kb=Kslot+hi*1024+r32*16;
  #pragma unroll
  for(int d0=0;d0<4;++d0){
    const bf16x8 b0=*reinterpret_cast<const bf16x8*>(kb+d0*2048);
    const bf16x8 b1=*reinterpret_cast<const bf16x8*>(kb+d0*2048+512);
    if(d0==0){p0=__builtin_amdgcn_mfma_f32_32x32x16_bf16(b0,qr[0],negm,0,0,0);p1=__builtin_amdgcn_mfma_f32_32x32x16_bf16(b1,qr[0],negm,0,0,0);}
    else{p0=__builtin_amdgcn_mfma_f32_32x32x16_bf16(b0,qr[d0],p0,0,0,0);p1=__builtin_amdgcn_mfma_f32_32x32x16_bf16(b1,qr[d0],p1,0,0,0);}}
}
typedef __attribute__((address_space(3))) const char* lds_cptr;
typedef short v4i16_t __attribute__((ext_vector_type(4)));
__device__ __forceinline__ void kload8(bf16x8*kf,lds_cptr kp){
  kf[0]=*(const __attribute__((address_space(3))) bf16x8*)(kp);      kf[1]=*(const __attribute__((address_space(3))) bf16x8*)(kp+512);
  kf[2]=*(const __attribute__((address_space(3))) bf16x8*)(kp+2048); kf[3]=*(const __attribute__((address_space(3))) bf16x8*)(kp+2560);
  kf[4]=*(const __attribute__((address_space(3))) bf16x8*)(kp+4096); kf[5]=*(const __attribute__((address_space(3))) bf16x8*)(kp+4608);
  kf[6]=*(const __attribute__((address_space(3))) bf16x8*)(kp+6144); kf[7]=*(const __attribute__((address_space(3))) bf16x8*)(kp+6656);
}
__device__ __forceinline__ void kload2(bf16x8*kf,lds_cptr kp,int j){ kf[2*j]=*(const __attribute__((address_space(3))) bf16x8*)(kp+j*2048); kf[2*j+1]=*(const __attribute__((address_space(3))) bf16x8*)(kp+j*2048+512); }
__device__ __forceinline__ s16x4 vtr(lds_cptr p){ return __builtin_bit_cast(s16x4,__builtin_amdgcn_ds_read_tr16_b64_v4i16((__attribute__((address_space(3))) v4i16_t*)p)); }
__device__ __forceinline__ float rowmax(const f32x16&p0,const f32x16&p1){
  float a=max3f(p0[0],p0[1],p1[0]),b=max3f(p0[2],p0[3],p1[1]);a=max3f(a,p1[2],p1[3]);
  #pragma unroll
  for(int r=4;r<16;r+=4){a=max3f(a,p0[r],p0[r+1]);b=max3f(b,p0[r+2],p0[r+3]);a=max3f(a,p1[r],p1[r+1]);b=max3f(b,p1[r+2],p1[r+3]);}
  const float m=max2f(a,b);
  auto rr=__builtin_amdgcn_permlane32_swap(__float_as_uint(m),__float_as_uint(m),false,false);
  return max2f(__uint_as_float(rr[0]),__uint_as_float(rr[1]));
}
__device__ __forceinline__ void pv(f32x16*o,int vb,bf16x8 pa0,bf16x8 pa1,bf16x8 pa2,bf16x8 pa3){
  #pragma unroll
  for(int d0=0;d0<2;++d0){s16x4 lo[4],hi[4];
    #pragma unroll
    for(int ks=0;ks<4;++ks){
      asm volatile("ds_read_b64_tr_b16 %0,%1 offset:%c2":"=&v"(lo[ks]):"v"(vb),"i"(d0*4096+ks*1024):"memory");
      asm volatile("ds_read_b64_tr_b16 %0,%1 offset:%c2":"=&v"(hi[ks]):"v"(vb),"i"(d0*4096+ks*1024+512):"memory");}
    asm volatile("s_waitcnt lgkmcnt(0)":::"memory");SBAR();
    #define PK(k) (bf16x8){lo[k][0],lo[k][1],lo[k][2],lo[k][3],hi[k][0],hi[k][1],hi[k][2],hi[k][3]}
    o[d0]=__builtin_amdgcn_mfma_f32_32x32x16_bf16(pa0,PK(0),o[d0],0,0,0);
    o[d0]=__builtin_amdgcn_mfma_f32_32x32x16_bf16(pa1,PK(1),o[d0],0,0,0);
    o[d0]=__builtin_amdgcn_mfma_f32_32x32x16_bf16(pa2,PK(2),o[d0],0,0,0);
    o[d0]=__builtin_amdgcn_mfma_f32_32x32x16_bf16(pa3,PK(3),o[d0],0,0,0);
    #undef PK
  }
}

#ifndef ATTN_STORE16
#define ATTN_STORE16(p,v) (*(u32x4*)(p)=(v))
#endif
template<int THRL,bool DV128,int PQ,int PK,int PV,int PO> __device__ __forceinline__ void attn_unit(const bf16*Qb,const bf16*__restrict__ Kb,const bf16*__restrict__ Vb,bf16*Ob,const int NT,char*shm,const int wave0){
  int tid_o=wave0*64+lane_id_v(); asm volatile("":"+v"(tid_o)); const int tid=tid_o,lane=tid&63,r32=lane&31,hi=lane>>5; const int wid=__builtin_amdgcn_readfirstlane(tid>>6);
  const bf16*Qw=Qb+(long)(wid*QBLK)*PQ;
  const bf16*Kh=Kb,*Vh=Vb;
  const unsigned lds0=(unsigned)(uintptr_t)shm;
  constexpr int VS=DV128?2:1, L_WS=LDS_V+NSLOT*SLOTB*VS, L_OST=L_WS+NW*64*4;
  float*wsf=(float*)(shm+L_WS)+wid*64;
  const bf16*ksrc=Kh+(long)lane*PK+wid*8;
  const bf16*vsrc=Vh+(long)(16*(wid&3)+(lane>>2))*PV+(wid>>2)*32+(lane&3)*8;
  const unsigned kdst=lds0+LDS_K+wid*1024, vdst=lds0+LDS_V+wid*1024;
  #define DMA_K(t,slot) glds16(ksrc+(long)(t)*KVBLK*PK,(unsigned)__builtin_amdgcn_readfirstlane(kdst+(slot)))
  #define DMA_V(t,slot) do{ glds16(vsrc+(long)(t)*KVBLK*PV,(unsigned)__builtin_amdgcn_readfirstlane(vdst+VS*(slot))); if constexpr(DV128){ glds16(vsrc+64+(long)(t)*KVBLK*PV,(unsigned)__builtin_amdgcn_readfirstlane(vdst+VS*(slot)+8192)); } }while(0)
  const char*Kbase=shm+LDS_K; bf16x8 kf[8];
  const lds_cptr shm3=(lds_cptr)shm; const lds_cptr kp0=shm3+LDS_K+hi*1024+r32*16; const lds_cptr vp0=shm3+LDS_V+((lane>>4)&1)*32+(lane&3)*8+(4*hi+((lane&15)>>2))*64;
  DMA_K(0,0);DMA_V(0,0);DMA_K(1,SLOTB);
  bf16x8 qr[4];
  #pragma unroll
  for(int d0=0;d0<4;++d0)qr[d0]=*reinterpret_cast<const bf16x8*>(&Qw[(long)r32*PQ+d0*16+hi*8]);
  float mhat=0.f,l_reg=0.f;f32x16 o[4];o[0]=f32x16{};o[1]=f32x16{};o[2]=f32x16{};o[3]=f32x16{};f32x16 negm=f32x16{};asm volatile("":"+v"(negm));
  #define CMASK(P0,P1,t) do{}while(0)
  bool resc=false;
  #define START(P0,P1) do{ const float rm=rowmax(P0,P1); resc=false; \
    { const float dl=rm; mhat=fadd_s(mhat,dl); \
      _Pragma("unroll") for(int r=0;r<16;++r){P0[r]=fsub_s(P0[r],dl);P1[r]=fsub_s(P1[r],dl);} \
      _Pragma("unroll") for(int r=0;r<16;++r)negm[r]=-mhat; asm volatile("":"+v"(negm)); } \
    _Pragma("unroll") for(int r=0;r<16;++r)P0[r]=__builtin_amdgcn_exp2f(P0[r]); }while(0)
  #define RESC() do{ if(resc){ asm volatile("s_waitcnt lgkmcnt(0)":::"memory"); \
      _Pragma("unroll") for(int d_=0;d_<2*VS;++d_) _Pragma("unroll") for(int r=0;r<16;++r)o[d_][r]*=wsf[crow(r,hi)]; } }while(0)
  f32x16 pA0,pA1,pB0,pB1;
  int sl_prev=0,sl_cur=0,sl_next=SLOTB;
  #define ROT() do{sl_prev=sl_cur;sl_cur=sl_next;sl_next=(sl_next==(NSLOT-1)*SLOTB)?0:sl_next+SLOTB;}while(0)
  DMA_K(2,2*SLOTB);
  WAIT_BAR(3);
  qkt(pA0,pA1,Kbase,qr,negm,r32,hi);asm volatile("s_nop 15\n\ts_nop 7":"+v"(pA0),"+v"(pA1));CMASK(pA0,pA1,0);
  START(pA0,pA1);
  _Pragma("unroll") for(int r=0;r<16;++r)pA1[r]=__builtin_amdgcn_exp2f(pA1[r]);
  WAIT_BAR(0);
  DMA_K(3,0);DMA_V(1,SLOTB);
  ROT();
  kload8(kf,kp0+sl_cur);
  #define WB2() do{ if constexpr(DV128){WAIT_BAR(3);}else{WAIT_BAR(2);} }while(0)
  #define WB1() do{ if constexpr(DV128){WAIT_BAR(2);}else{WAIT_BAR(1);} }while(0)
  WB2();
  s16x4 vlo[8],vhi[8]; u32x4 pw0,pw1,pw2,pw3;
  #define PKW(P,B) cvtpk_s(P[B],P[B+1])
  #define PAF(k) __builtin_bit_cast(bf16x8,pw##k)
  #define VFR(i) (bf16x8){vlo[i][0],vlo[i][1],vlo[i][2],vlo[i][3],vhi[i][0],vhi[i][1],vhi[i][2],vhi[i][3]}
  #define PIN(x) asm volatile("":"+v"(x))
  #define MX3(a,b,c) __builtin_fmaxf(__builtin_fmaxf((a),(b)),(c))
  #define GAPA(MF,A0,A1,A2,A3,W0,W1,PW) do{ MF; sacc+=A0; sacc+=A1; sacc+=A2; sacc+=A3; PIN(sacc); W0; W1; PIN(PW); SBAR(); }while(0)
  #define EX(v) __builtin_amdgcn_exp2f(v)
  #define GAPC(MF,X,B) do{ MF; X[B]=EX(X[B]); X[B+1]=EX(X[B+1]); PIN(X); SBAR(); }while(0)
  #define GAPB(MF,X,B) do{ MF; X[B]=EX(X[B]); X[B+1]=EX(X[B+1]); X[B+2]=EX(X[B+2]); X[B+3]=EX(X[B+3]); PIN(X); SBAR(); }while(0)
  #define VRD(i) do{ vlo[i]=vtr(vp_+(((i)>>2)*4096+((i)&3)*1024)); vhi[i]=vtr(vp_+(((i)>>2)*4096+((i)&3)*1024+512)); }while(0)
  #define KRD(G,j) do{ if(G){ kload2(kf,kp0+sl_next,j); SBAR(); } }while(0)
  #define STEP(C0,C1,P0,P1,t,GK,GV,GL) do{ SBAR(); \
    const lds_cptr vp_=vp0+VS*sl_prev; \
    VRD(0); SBAR(); float sacc=(P0[0]+P0[1]); \
    GAPA(C0=__builtin_amdgcn_mfma_f32_32x32x16_bf16(kf[0],qr[0],negm,0,0,0), P0[2],P0[3],P0[4],P0[5],     pw0[0]=PKW(P0,0), pw0[1]=PKW(P0,2), pw0); \
    VRD(4); SBAR(); GAPA(C1=__builtin_amdgcn_mfma_f32_32x32x16_bf16(kf[1],qr[0],negm,0,0,0), P0[6],P0[7],P0[8],P0[9],     pw0[2]=PKW(P0,4), pw0[3]=PKW(P0,6), pw0); \
    VRD(1); SBAR(); GAPA(C0=__builtin_amdgcn_mfma_f32_32x32x16_bf16(kf[2],qr[1],C0,0,0,0),   P0[10],P0[11],P0[12],P0[13], pw1[0]=PKW(P0,8), pw1[1]=PKW(P0,10), pw1); \
    VRD(5); SBAR(); GAPA(C1=__builtin_amdgcn_mfma_f32_32x32x16_bf16(kf[3],qr[1],C1,0,0,0),   P0[14],P0[15],P1[0],P1[1],   pw1[2]=PKW(P0,12),pw1[3]=PKW(P0,14), pw1); \
    VRD(2); SBAR(); GAPA(C0=__builtin_amdgcn_mfma_f32_32x32x16_bf16(kf[4],qr[2],C0,0,0,0),   P1[2],P1[3],P1[4],P1[5],     pw2[0]=PKW(P1,0), pw2[1]=PKW(P1,2), pw2); \
    VRD(6); SBAR(); GAPA(C1=__builtin_amdgcn_mfma_f32_32x32x16_bf16(kf[5],qr[2],C1,0,0,0),   P1[6],P1[7],P1[8],P1[9],     pw2[2]=PKW(P1,4), pw2[3]=PKW(P1,6), pw2); \
    VRD(3); SBAR(); GAPA(C0=__builtin_amdgcn_mfma_f32_32x32x16_bf16(kf[6],qr[3],C0,0,0,0),   P1[10],P1[11],P1[12],P1[13], pw3[0]=PKW(P1,8), pw3[1]=PKW(P1,10), pw3); \
    VRD(7); SBAR(); GAPA(C1=__builtin_amdgcn_mfma_f32_32x32x16_bf16(kf[7],qr[3],C1,0,0,0),   P1[14],P1[15],0.f,0.f,       pw3[2]=PKW(P1,12),pw3[3]=PKW(P1,14), pw3); \
    l_reg+=sacc; \
    if(GK){DMA_K((t)+3,sl_cur);} if(GV){DMA_V((t)+1,sl_next);} \
    CMASK(C0,C1,t); \
    { float a=MX3(C0[0],C0[1],C1[0]),b=MX3(C0[2],C0[3],C1[1]); a=MX3(a,C1[2],C1[3]); \
      _Pragma("unroll") for(int r=4;r<16;r+=4){a=MX3(a,C0[r],C0[r+1]);b=MX3(b,C0[r+2],C0[r+3]);a=MX3(a,C1[r],C1[r+1]);b=MX3(b,C1[r+2],C1[r+3]);} \
      float rm=__builtin_fmaxf(a,b); { auto rr=__builtin_amdgcn_permlane32_swap(__float_as_uint(rm),__float_as_uint(rm),false,false); rm=__builtin_fmaxf(__uint_as_float(rr[0]),__uint_as_float(rr[1])); } \
      resc=false; \
      if(__builtin_expect(__any(rm>(float)THRL),0)){ const float dl=__builtin_fmaxf(rm,0.f); mhat+=dl; \
        _Pragma("unroll") for(int r=0;r<16;++r){C0[r]-=dl;C1[r]-=dl;} \
        _Pragma("unroll") for(int r=0;r<16;++r)negm[r]=-mhat; asm volatile("":"+v"(negm)); \
        const float f=__builtin_amdgcn_exp2f(-dl); l_reg*=f; if(hi==0)wsf[r32]=f; resc=true; } } \
    SBAR(); \
    GAPB(o[0]=__builtin_amdgcn_mfma_f32_32x32x16_bf16(PAF(0),VFR(0),o[0],0,0,0), C0,0); \
    GAPB(o[1]=__builtin_amdgcn_mfma_f32_32x32x16_bf16(PAF(0),VFR(4),o[1],0,0,0), C0,4); \
    KRD(GL,0); GAPB(o[0]=__builtin_amdgcn_mfma_f32_32x32x16_bf16(PAF(1),VFR(1),o[0],0,0,0), C0,8); \
    KRD(GL,1); GAPB(o[1]=__builtin_amdgcn_mfma_f32_32x32x16_bf16(PAF(1),VFR(5),o[1],0,0,0), C0,12); \
    KRD(GL,2); GAPB(o[0]=__builtin_amdgcn_mfma_f32_32x32x16_bf16(PAF(2),VFR(2),o[0],0,0,0), C1,0); \
    KRD(GL,3); GAPB(o[1]=__builtin_amdgcn_mfma_f32_32x32x16_bf16(PAF(2),VFR(6),o[1],0,0,0), C1,4); \
    GAPB(o[0]=__builtin_amdgcn_mfma_f32_32x32x16_bf16(PAF(3),VFR(3),o[0],0,0,0), C1,8); \
    GAPB(o[1]=__builtin_amdgcn_mfma_f32_32x32x16_bf16(PAF(3),VFR(7),o[1],0,0,0), C1,12); \
    }while(0)
  #define VRD2(i) do{ vlo[i]=vtr(vp_+(8192+((i)>>2)*4096+((i)&3)*1024)); vhi[i]=vtr(vp_+(8192+((i)>>2)*4096+((i)&3)*1024+512)); }while(0)
  #define STEP128(C0,C1,P0,P1,t,GK,GV,GL) do{ SBAR(); \
    const lds_cptr vp_=vp0+VS*sl_prev; \
    float sacc=(P0[0]+P0[1]); \
    GAPA(C0=__builtin_amdgcn_mfma_f32_32x32x16_bf16(kf[0],qr[0],negm,0,0,0), P0[2],P0[3],P0[4],P0[5],     pw0[0]=PKW(P0,0), pw0[1]=PKW(P0,2), pw0); \
    GAPA(C1=__builtin_amdgcn_mfma_f32_32x32x16_bf16(kf[1],qr[0],negm,0,0,0), P0[6],P0[7],P0[8],P0[9],     pw0[2]=PKW(P0,4), pw0[3]=PKW(P0,6), pw0); \
    GAPA(C0=__builtin_amdgcn_mfma_f32_32x32x16_bf16(kf[2],qr[1],C0,0,0,0),   P0[10],P0[11],P0[12],P0[13], pw1[0]=PKW(P0,8), pw1[1]=PKW(P0,10), pw1); \
    GAPA(C1=__builtin_amdgcn_mfma_f32_32x32x16_bf16(kf[3],qr[1],C1,0,0,0),   P0[14],P0[15],P1[0],P1[1],   pw1[2]=PKW(P0,12),pw1[3]=PKW(P0,14), pw1); \
    GAPA(C0=__builtin_amdgcn_mfma_f32_32x32x16_bf16(kf[4],qr[2],C0,0,0,0),   P1[2],P1[3],P1[4],P1[5],     pw2[0]=PKW(P1,0), pw2[1]=PKW(P1,2), pw2); \
    GAPA(C1=__builtin_amdgcn_mfma_f32_32x32x16_bf16(kf[5],qr[2],C1,0,0,0),   P1[6],P1[7],P1[8],P1[9],     pw2[2]=PKW(P1,4), pw2[3]=PKW(P1,6), pw2); \
    GAPA(C0=__builtin_amdgcn_mfma_f32_32x32x16_bf16(kf[6],qr[3],C0,0,0,0),   P1[10],P1[11],P1[12],P1[13], pw3[0]=PKW(P1,8), pw3[1]=PKW(P1,10), pw3); \
    GAPA(C1=__builtin_amdgcn_mfma_f32_32x32x16_bf16(kf[7],qr[3],C1,0,0,0),   P1[14],P1[15],0.f,0.f,       pw3[2]=PKW(P1,12),pw3[3]=PKW(P1,14), pw3); \
    l_reg+=sacc; \
    if(GK){DMA_K((t)+3,sl_cur);} if(GV){DMA_V((t)+1,sl_next);} \
    CMASK(C0,C1,t); \
    { float a=MX3(C0[0],C0[1],C1[0]),b=MX3(C0[2],C0[3],C1[1]); a=MX3(a,C1[2],C1[3]); \
      _Pragma("unroll") for(int r=4;r<16;r+=4){a=MX3(a,C0[r],C0[r+1]);b=MX3(b,C0[r+2],C0[r+3]);a=MX3(a,C1[r],C1[r+1]);b=MX3(b,C1[r+2],C1[r+3]);} \
      float rm=__builtin_fmaxf(a,b); { auto rr=__builtin_amdgcn_permlane32_swap(__float_as_uint(rm),__float_as_uint(rm),false,false); rm=__builtin_fmaxf(__uint_as_float(rr[0]),__uint_as_float(rr[1])); } \
      resc=false; \
      if(__builtin_expect(__any(rm>(float)THRL),0)){ const float dl=__builtin_fmaxf(rm,0.f); mhat+=dl; \
        _Pragma("unroll") for(int r=0;r<16;++r){C0[r]-=dl;C1[r]-=dl;} \
        _Pragma("unroll") for(int r=0;r<16;++r)negm[r]=-mhat; asm volatile("":"+v"(negm)); \
        const float f=__builtin_amdgcn_exp2f(-dl); l_reg*=f; if(hi==0)wsf[r32]=f; resc=true; } } \
    SBAR(); \
    VRD(0); VRD(4); VRD(1); VRD(5); SBAR(); \
    GAPC(o[0]=__builtin_amdgcn_mfma_f32_32x32x16_bf16(PAF(0),VFR(0),o[0],0,0,0), C0,0); VRD(2); SBAR(); \
    GAPC(o[1]=__builtin_amdgcn_mfma_f32_32x32x16_bf16(PAF(0),VFR(4),o[1],0,0,0), C0,2); VRD(6); SBAR(); \
    KRD(GL,0); GAPC(o[0]=__builtin_amdgcn_mfma_f32_32x32x16_bf16(PAF(1),VFR(1),o[0],0,0,0), C0,4); VRD(3); SBAR(); \
    KRD(GL,1); GAPC(o[1]=__builtin_amdgcn_mfma_f32_32x32x16_bf16(PAF(1),VFR(5),o[1],0,0,0), C0,6); VRD(7); SBAR(); \
    KRD(GL,2); GAPC(o[0]=__builtin_amdgcn_mfma_f32_32x32x16_bf16(PAF(2),VFR(2),o[0],0,0,0), C0,8); VRD2(0); SBAR(); \
    KRD(GL,3); GAPC(o[1]=__builtin_amdgcn_mfma_f32_32x32x16_bf16(PAF(2),VFR(6),o[1],0,0,0), C0,10); VRD2(4); SBAR(); \
    GAPC(o[0]=__builtin_amdgcn_mfma_f32_32x32x16_bf16(PAF(3),VFR(3),o[0],0,0,0), C0,12); VRD2(1); SBAR(); \
    GAPC(o[1]=__builtin_amdgcn_mfma_f32_32x32x16_bf16(PAF(3),VFR(7),o[1],0,0,0), C0,14); VRD2(5); SBAR(); \
    GAPC(o[2]=__builtin_amdgcn_mfma_f32_32x32x16_bf16(PAF(0),VFR(0),o[2],0,0,0), C1,0); VRD2(2); SBAR(); \
    GAPC(o[3]=__builtin_amdgcn_mfma_f32_32x32x16_bf16(PAF(0),VFR(4),o[3],0,0,0), C1,2); VRD2(6); SBAR(); \
    GAPC(o[2]=__builtin_amdgcn_mfma_f32_32x32x16_bf16(PAF(1),VFR(1),o[2],0,0,0), C1,4); VRD2(3); SBAR(); \
    GAPC(o[3]=__builtin_amdgcn_mfma_f32_32x32x16_bf16(PAF(1),VFR(5),o[3],0,0,0), C1,6); VRD2(7); SBAR(); \
    GAPC(o[2]=__builtin_amdgcn_mfma_f32_32x32x16_bf16(PAF(2),VFR(2),o[2],0,0,0), C1,8); \
    GAPC(o[3]=__builtin_amdgcn_mfma_f32_32x32x16_bf16(PAF(2),VFR(6),o[3],0,0,0), C1,10); \
    GAPC(o[2]=__builtin_amdgcn_mfma_f32_32x32x16_bf16(PAF(3),VFR(3),o[2],0,0,0), C1,12); \
    GAPC(o[3]=__builtin_amdgcn_mfma_f32_32x32x16_bf16(PAF(3),VFR(7),o[3],0,0,0), C1,14); \
    }while(0)
  #define STEPX(...) do{ if constexpr(DV128){ STEP128(__VA_ARGS__); } else { STEP(__VA_ARGS__); } }while(0)
  int t=1;
  #undef CMASK
  #define CMASK(P0,P1,t) do{}while(0)
  for(;t+5<NT;t+=2){
    STEPX(pB0,pB1,pA0,pA1,t,true,true,true);     WB2(); RESC(); ROT();
    STEPX(pA0,pA1,pB0,pB1,t+1,true,true,true);   WB2(); RESC(); ROT();
  }
  #undef CMASK
  #define CMASK(P0,P1,t) do{}while(0)
  #define ENDW(tt) do{ if((tt)+3<NT){WB2();} else if((tt)+2<NT){WB1();} else {WAIT_BAR(0);} }while(0)
  for(;t+1<NT;t+=2){
    STEPX(pB0,pB1,pA0,pA1,t,(t+3<NT),(t+1<NT),(t+1<NT));       ENDW(t);   RESC(); ROT();
    STEPX(pA0,pA1,pB0,pB1,t+1,(t+4<NT),(t+2<NT),(t+2<NT));     ENDW(t+1); RESC(); ROT();
  }
  STEPX(pB0,pB1,pA0,pA1,NT-1,false,false,false); RESC();
  { float sacc=pB0[0]+pB0[1]; _Pragma("unroll") for(int r=2;r<16;++r)sacc+=pB0[r]; _Pragma("unroll") for(int r=0;r<16;++r)sacc+=pB1[r]; l_reg+=sacc;
    pw0=(u32x4){PKW(pB0,0),PKW(pB0,2),PKW(pB0,4),PKW(pB0,6)};pw1=(u32x4){PKW(pB0,8),PKW(pB0,10),PKW(pB0,12),PKW(pB0,14)};pw2=(u32x4){PKW(pB1,0),PKW(pB1,2),PKW(pB1,4),PKW(pB1,6)};pw3=(u32x4){PKW(pB1,8),PKW(pB1,10),PKW(pB1,12),PKW(pB1,14)};
    int lane_d=lane; asm volatile("":"+v"(lane_d)); const int vb0=(int)(lds0+LDS_V)+((lane_d>>4)&1)*32+(lane_d&3)*8+(4*(lane_d>>5)+((lane_d&15)>>2))*64;
    SBAR(); pv(o,vb0+VS*sl_cur,PAF(0),PAF(1),PAF(2),PAF(3)); if constexpr(DV128){ pv(o+2,vb0+VS*sl_cur+8192,PAF(0),PAF(1),PAF(2),PAF(3)); } }
  #undef PKW
  #undef PAF
  #undef VFR
  #undef PIN
  #undef MX3
  #undef GAPA
  #undef GAPB
  #undef GAPC
  #undef EX
  #undef VRD
  #undef KRD
  #undef STEP
  #undef STEP128
  #undef STEPX
  #undef VRD2
  #undef WB2
  #undef WB1
  #undef ENDW
  {auto rr=__builtin_amdgcn_permlane32_swap(__float_as_uint(l_reg),__float_as_uint(l_reg),false,false);l_reg=__uint_as_float(rr[0])+__uint_as_float(rr[1]);}
  if(hi==0)wsf[32+r32]=l_reg;asm volatile("s_waitcnt lgkmcnt(0)":::"memory");
  float rli[16];
  #pragma unroll
  for(int r=0;r<16;++r)rli[r]=__builtin_amdgcn_rcpf(wsf[32+crow(r,hi)]);
  bf16*Ow=Ob+(long)(wid*QBLK)*PO;
  { bf16*stg=(bf16*)(shm+L_OST)+wid*2048;
    #pragma unroll
    for(int hf=0;hf<VS;++hf){
      #pragma unroll
      for(int r=0;r<16;++r){const int orow=crow(r,hi);
        #pragma unroll
        for(int d0=0;d0<2;++d0)stg[orow*64+d0*32+r32]=__float2bfloat16(o[2*hf+d0][r]*rli[r]);}
      asm volatile("s_waitcnt lgkmcnt(0)":::"memory");
      #pragma unroll
      for(int i=0;i<4;++i){const int row=i*8+(lane>>3),ch=lane&7; const u32x4 v=*(const u32x4*)(stg+row*64+ch*8); ATTN_STORE16(Ow+(long)row*PO+hf*64+ch*8,v);}
      asm volatile("s_waitcnt lgkmcnt(0)":::"memory"); } }
  asm volatile("s_waitcnt lgkmcnt(0)\n\ts_barrier":::"memory");
  #undef DMA_K
  #undef DMA_V
  #undef CMASK
  #undef START
  #undef RESC
  #undef ROT
}
constexpr int ATTN_LDS_BYTES=LDS_BYTES;
#undef SBAR
#undef WAIT_BAR
}
#include <hip/hip_cooperative_groups.h>
namespace cg = cooperative_groups;
#define LAS __attribute__((address_space(3)))
typedef unsigned short bf16_t;
typedef unsigned v4u __attribute__((ext_vector_type(4)));
typedef unsigned v2u __attribute__((ext_vector_type(2)));
typedef float f32x4 __attribute__((ext_vector_type(4)));
typedef float cf __attribute__((ext_vector_type(2)));

constexpr int NTHR = 512;
constexpr int DMOD = 1024, NBATCH = 4, SEQ = 8192, CTXL = 256, DEPTH = 4;
constexpr int ML = NBATCH * SEQ, MC = NBATCH * CTXL, MT = ML + MC;
constexpr int INW = 2816, DFF = 2816, NKEY = SEQ + CTXL;
constexpr float EPSF = 1e-6f;
constexpr int FFTN = 16384;

constexpr size_t MiB = 1u << 20;
constexpr size_t WS_MOD = 1 * MiB;
constexpr size_t WS_LAM = 1 * MiB + 512 * 1024;
constexpr size_t WS_ROPE = WS_LAM + 256;
constexpr size_t WS_TW = 1 * MiB + 768 * 1024;
constexpr size_t WS_WIN = 2 * MiB, WS_WOUT = WS_WIN + (size_t)INW * 1024 * 2, WS_WUP = WS_WOUT + 2 * MiB, WS_WDN = WS_WUP + (size_t)2 * DFF * 1024 * 2;
constexpr size_t WS_CTXX = 26 * MiB;
constexpr size_t WS_FILT = 30 * MiB, WS_FILTC = 62 * MiB;
constexpr size_t WS_H = 64 * MiB;
constexpr size_t WS_KF = 64 * MiB;
constexpr size_t WS_RAW = 130 * MiB;
constexpr size_t WS_YRAW = 130 * MiB;
constexpr size_t WS_YH = 213 * MiB, WS_YHC = 245 * MiB;
constexpr size_t WS_QA = 312 * MiB, WS_KA = 329 * MiB, WS_VA = 338 * MiB, WS_QD = 347 * MiB, WS_KD = 380 * MiB, WS_VD = 413 * MiB;
constexpr size_t WS_HYR = 446 * MiB, WS_HYRC = 494 * MiB;
constexpr size_t WS_G = 130 * MiB;
constexpr size_t WS_END = 496 * MiB;
static_assert(WS_WDN + (size_t)DFF * 1024 * 2 <= WS_CTXX, "weights");
static_assert(WS_H + (size_t)MT * 1024 * 2 <= WS_RAW && WS_RAW + (size_t)MT * INW * 2 <= WS_QA, "map1");
static_assert(WS_YRAW + (size_t)MT * 1280 * 2 <= WS_YH && WS_G + (size_t)MT * DFF * 2 <= WS_QA, "map2");
constexpr int LDS_BYTES = 147456;
#ifndef PHM
#define PHM 0xffff
#endif
#define PH(b) ((PHM >> (b)) & 1)
#ifndef REP_ATT
#define REP_ATT 1
#endif
#ifndef REP_HY
#define REP_HY 1
#endif
#ifndef REP_GEMM
#define REP_GEMM 1
#endif
#ifndef REP_PREP
#define REP_PREP 1
#endif
#ifndef REP_PP
#define REP_PP 1
#endif
#ifndef REP_MERGE
#define REP_MERGE 1
#endif
#ifndef REP_N2
#define REP_N2 1
#endif
#ifndef REP_GLU
#define REP_GLU 1
#endif
#ifndef REP_GEMM2
#define REP_GEMM2 1
#endif
#ifndef REP_PRO
#define REP_PRO 1
#endif
#ifndef PROBE_PLAIN_LAUNCH
#define PROBE_PLAIN_LAUNCH 0
#endif
#ifndef EXTRA_SYNC
#define EXTRA_SYNC 0
#endif

__device__ __forceinline__ unsigned f2bf(float f) { unsigned u = __builtin_bit_cast(unsigned, f); return (u + 0x7fffu + ((u >> 16) & 1u)) >> 16; }
__device__ __forceinline__ unsigned pk2(float lo, float hi) { return f2bf(lo) | (f2bf(hi) << 16); }
__device__ __forceinline__ float bf2f(bf16_t u) { return __uint_as_float((unsigned)u << 16); }
__device__ __forceinline__ float bflo(unsigned w) { return __uint_as_float(w << 16); }
__device__ __forceinline__ float bfhi(unsigned w) { return __uint_as_float(w & 0xffff0000u); }
__device__ __forceinline__ float shx(float v, int m, int lane) { return __builtin_bit_cast(float, __builtin_amdgcn_ds_bpermute((lane ^ m) << 2, __builtin_bit_cast(int, v))); }
__device__ __forceinline__ float wave_sum(float v) {
    const int lane = lane_id_v();
#pragma unroll
    for (int o = 1; o < 64; o <<= 1) v += shx(v, o, lane);
    return v;
}
__device__ __forceinline__ float block_sum(float v, LAS float* RED, int tid) {
    v = wave_sum(v); __syncthreads(); if ((tid & 63) == 0) RED[tid >> 6] = v; __syncthreads();
    float s = 0.f;
#pragma unroll
    for (int w = 0; w < 8; ++w) s += RED[w];
    return s;
}

struct EpiGateRes {
    static constexpr bool PERM = false, AFTER_DRAIN = false;
    const float* base_lat; float* out_lat; const float* base_ctx; float* out_ctx; const float* gate; int row_off;
    __device__ __forceinline__ void operator()(const pg8::f32x4 (&acc)[2][2][4][2], const pg8::Unit& u, int wr, int wc, int fr, int fq) const {
        const int col0 = u.pn * 256 + wc * 32 + 4 * fq;
#pragma unroll
        for (int ai = 0; ai < 2; ++ai)
#pragma unroll
            for (int m = 0; m < 4; ++m) {
                const int r = row_off + u.pm * 256 + ai * 128 + wr * 64 + m * 16 + fr;
                const bool lat = r < ML; const int bi = lat ? (r >> 13) : 4;
                const size_t off = lat ? (size_t)r * 1024 : (size_t)(r - ML) * 1024;
                const float* bp = (lat ? base_lat : base_ctx) + off + col0; float* op = (lat ? out_lat : out_ctx) + off + col0;
                const float* gp = gate + bi * 6144 + col0;
#pragma unroll
                for (int bj = 0; bj < 2; ++bj)
#pragma unroll
                    for (int n = 0; n < 2; ++n) {
                        const pg8::f32x4 g4 = *(const pg8::f32x4*)(gp + bj * 128 + n * 16), b4 = *(const pg8::f32x4*)(bp + bj * 128 + n * 16);
                        *(pg8::f32x4*)(op + bj * 128 + n * 16) = b4 + g4 * acc[ai][bj][m][n];
                    }
            }
    }
};

__device__ __forceinline__ float dpp_ror1(float v) { return __builtin_bit_cast(float, __builtin_amdgcn_update_dpp(0, __builtin_bit_cast(int, v), 0x121, 0xF, 0xF, false)); }
__device__ __forceinline__ float dpp_rol1(float v) { return __builtin_bit_cast(float, __builtin_amdgcn_update_dpp(0, __builtin_bit_cast(int, v), 0x12F, 0xF, 0xF, false)); }
struct EpiGlu {
    static constexpr bool PERM = true, AFTER_DRAIN = false;
    bf16_t* G; const float* cw; const float* cb; int nrows;
    __device__ __forceinline__ void operator()(const pg8::f32x4 (&acc)[2][2][4][2], const pg8::Unit& u, int wr, int wc, int fr, int fq) const {
        const int ch0 = u.pn * 128 + wc * 32 + 8 * fq;
        float w0[8], w1[8], w2[8], bb[8];
#pragma unroll
        for (int hq = 0; hq < 2; ++hq) { const pg8::f32x4 q0 = *(const pg8::f32x4*)(cw + ch0 + 4 * hq), q1 = *(const pg8::f32x4*)(cw + DFF + ch0 + 4 * hq), q2 = *(const pg8::f32x4*)(cw + 2 * DFF + ch0 + 4 * hq), q3 = *(const pg8::f32x4*)(cb + ch0 + 4 * hq);
#pragma unroll
            for (int e = 0; e < 4; ++e) { w0[4 * hq + e] = q0[e]; w1[4 * hq + e] = q1[e]; w2[4 * hq + e] = q2[e]; bb[4 * hq + e] = q3[e]; } }
#pragma unroll
        for (int ai = 0; ai < 2; ++ai) {
            const int kb = u.pm * 4 + ai * 2 + wr;
            float ruP[8], rdC[8];
#pragma unroll
            for (int c = 0; c < 8; ++c) { ruP[c] = 0.f; rdC[c] = dpp_rol1(acc[ai][0][0][c >> 2][c & 3]); }
#pragma unroll
            for (int m = 0; m < 4; ++m) {
                const int rl = 16 * m + fr, gr = 62 * kb - 1 + rl;
                bool first, last; if (gr < ML) { const int t = gr & 8191; first = t == 0; last = t == 8191; } else { const int t = (gr - ML) & 255; first = t == 0; last = t == 255; }
                float res[8];
#pragma unroll
                for (int c = 0; c < 8; ++c) {
                    const int n = c >> 2, e = c & 3;
                    const float x0 = acc[ai][0][m][n][e];
                    const float ruC = dpp_ror1(x0), rdN = m < 3 ? dpp_rol1(acc[ai][0][m < 3 ? m + 1 : 3][n][e]) : 0.f;
                    float xu = fr == 0 ? ruP[c] : ruC, xd = fr == 15 ? rdN : rdC[c];
                    xu = first ? 0.f : xu; xd = last ? 0.f : xd;
                    ruP[c] = ruC; rdC[c] = rdN;
                    const float x = w0[c] * xu + w1[c] * x0 + w2[c] * xd + bb[c];
                    const float u2 = -2.302208198f * (x + 0.044715f * x * x * x);
                    res[c] = x * __builtin_amdgcn_rcpf(1.0f + __builtin_amdgcn_exp2f(u2)) * acc[ai][1][m][n][e];
                }
                if (rl >= 1 && rl <= 62 && gr < nrows) { v4u o; o.x = pk2(res[0], res[1]); o.y = pk2(res[2], res[3]); o.z = pk2(res[4], res[5]); o.w = pk2(res[6], res[7]);
                    *(v4u*)(G + (size_t)gr * DFF + ch0) = o; }
            }
        }
    }
};

struct EpiInProj {
    static constexpr bool PERM = true, AFTER_DRAIN = false;
    bf16_t *qa, *ka, *va, *qd, *kd, *vd, *hyr, *hyrc; const float *qn_a, *kn_a, *qn_d, *kn_d; const cf* rope;
    __device__ __forceinline__ void operator()(const pg8::f32x4 (&acc)[2][2][4][2], const pg8::Unit& u, int wr, int wc, int fr, int fq) const {
        const int pn = u.pn, lane = fr + 16 * fq;
        bool normed, keyrow; const float* gain = qn_a; float scale = 1.f; bf16_t* dbase; int dpitch, dcol, nh = 1, hidx = 0;
        if (pn == 0) { normed = true; gain = qn_a; scale = attn_body::C2; dbase = qa; dpitch = 256; keyrow = false; dcol = wc * 64; }
        else if (pn == 1) { keyrow = true; dpitch = 64; nh = 2; dcol = 0; if (wc < 2) { normed = true; gain = kn_a; dbase = ka; hidx = wc; } else { normed = false; dbase = va; hidx = wc - 2; } }
        else if (pn < 5) { normed = false; dbase = hyr; dpitch = 0; keyrow = false; dcol = (pn - 2) * 256 + wc * 64; }
        else if (pn < 7) { normed = true; gain = qn_d; scale = attn_body::C2; dbase = qd; dpitch = 512; keyrow = false; dcol = ((pn - 5) * 4 + wc) * 64; }
        else if (pn < 9) { normed = true; gain = kn_d; dbase = kd; dpitch = 64; keyrow = true; nh = 8; hidx = (pn - 7) * 4 + wc; dcol = 0; }
        else { normed = false; dbase = vd; dpitch = 128; keyrow = true; nh = 4; hidx = (pn - 9) * 2 + (wc >> 1); dcol = (wc & 1) * 64; }
        pg8::f32x4 gg[2][2];
#pragma unroll
        for (int bj = 0; bj < 2; ++bj)
#pragma unroll
            for (int n = 0; n < 2; ++n) gg[bj][n] = *(const pg8::f32x4*)(gain + 32 * bj + 8 * fq + 4 * n);
#pragma unroll
        for (int ai = 0; ai < 2; ++ai)
#pragma unroll
            for (int m = 0; m < 4; ++m) {
                const int r = u.pm * 256 + ai * 128 + wr * 64 + m * 16 + fr;
                const bool lat = r < ML; int b, t; if (lat) { b = r >> 13; t = r & 8191; } else { b = (r - ML) >> 8; t = (r - ML) & 255; }
                const size_t drow = keyrow ? (size_t)(b * nh + hidx) * NKEY + (lat ? 256 + t : t) : (size_t)r;
                if (pn >= 2 && pn < 5) {
                    bf16_t* cbp = lat ? hyr + (size_t)b * 768 * 8192 + t : hyrc + (size_t)b * 768 * 256 + t; const size_t cst = lat ? 8192 : 256;
#pragma unroll
                    for (int bj = 0; bj < 2; ++bj)
#pragma unroll
                        for (int n = 0; n < 2; ++n)
#pragma unroll
                            for (int e = 0; e < 4; ++e) cbp[(size_t)(dcol + 32 * bj + 8 * fq + 4 * n + e) * cst] = (bf16_t)f2bf(acc[ai][bj][m][n][e]);
                    continue;
                }
                bf16_t* dp = dbase + drow * dpitch + dcol + 8 * fq;
                float rinv = 1.f;
                if (normed) { float ss = 0.f;
#pragma unroll
                    for (int bj = 0; bj < 2; ++bj)
#pragma unroll
                        for (int n = 0; n < 2; ++n) { const pg8::f32x4 x = acc[ai][bj][m][n]; ss += (x[0] * x[0] + x[1] * x[1]) + (x[2] * x[2] + x[3] * x[3]); }
                    ss += shx(ss, 16, lane); ss += shx(ss, 32, lane);
                    rinv = scale * __builtin_amdgcn_rsqf(ss * (1.0f / 64.0f) + EPSF); }
#pragma unroll
                for (int bj = 0; bj < 2; ++bj) {
                    pg8::f32x4 y0 = acc[ai][bj][m][0], y1 = acc[ai][bj][m][1];
                    if (normed) {
                        y0 = y0 * rinv * gg[bj][0]; y1 = y1 * rinv * gg[bj][1];
                        if (lat) { const int p = bj == 0 ? (t >> 6) : (t & 63); const pg8::f32x4* rp = (const pg8::f32x4*)(rope + p * 16 + 4 * fq); const pg8::f32x4 c01 = rp[0], c23 = rp[1];
                            const pg8::f32x4 z0 = {y0[0] * c01[0] - y0[1] * c01[1], y0[0] * c01[1] + y0[1] * c01[0], y0[2] * c01[2] - y0[3] * c01[3], y0[2] * c01[3] + y0[3] * c01[2]};
                            const pg8::f32x4 z1 = {y1[0] * c23[0] - y1[1] * c23[1], y1[0] * c23[1] + y1[1] * c23[0], y1[2] * c23[2] - y1[3] * c23[3], y1[2] * c23[3] + y1[3] * c23[2]};
                            y0 = z0; y1 = z1; }
                    }
                    v4u o; o.x = pk2(y0[0], y0[1]); o.y = pk2(y0[2], y0[3]); o.z = pk2(y1[0], y1[1]); o.w = pk2(y1[2], y1[3]);
                    *(v4u*)(dp + 32 * bj) = o;
                }
            }
    }
};

template <int PERM_UP = 0> __device__ __forceinline__ void transpose_item(const float* W, int K, int N, bf16_t* WT, LAS float* scr, int item, int lane) {
    const int nblk = N / 32, kb = item / nblk, nb = item % nblk, k0 = 64 * kb, n0 = 32 * nb;
#pragma unroll 8
    for (int i = 0; i < 32; ++i) { const int kk = 2 * i + (lane >> 5); scr[kk * 33 + (lane & 31)] = W[(size_t)(k0 + kk) * N + n0 + (lane & 31)]; }
    asm volatile("s_waitcnt lgkmcnt(0)" ::: "memory");
    const int c = lane & 7;
#pragma unroll
    for (int j = 0; j < 4; ++j) { const int n = (lane >> 3) + 8 * j; const LAS float* s = scr + (8 * c) * 33 + n;
        v4u o; o.x = pk2(s[0 * 33], s[1 * 33]); o.y = pk2(s[2 * 33], s[3 * 33]); o.z = pk2(s[4 * 33], s[5 * 33]); o.w = pk2(s[6 * 33], s[7 * 33]);
        int row = n0 + n; if (PERM_UP == 2) { const int nl = row & 255; row = (row & ~255) + 128 * ((nl >> 5) & 1) + 32 * (nl >> 6) + (nl & 31); }
        if (PERM_UP == 1) { const bool isv = row >= DFF; const int ch = isv ? row - DFF : row; row = (ch >> 7) * 256 + (isv ? 128 : 0) + (ch & 127); }
        *(v4u*)(WT + (size_t)row * K + k0 + 8 * c) = o; }
    asm volatile("s_waitcnt lgkmcnt(0)" ::: "memory");
}

__device__ __forceinline__ void norm_mod(const float* xl, const float* xc, const float* g, const float* mod, int shoff, int scoff, bf16_t* H, int nrows, int gw, int NGW, int lane) {
    for (int r = gw; r < nrows; r += 4 * NGW) {
        int rr[4]; const float* xp[4]; const float* mp[4];
#pragma unroll
        for (int k = 0; k < 4; ++k) { const int rk = r + k * NGW; rr[k] = rk < nrows ? rk : r; xp[k] = rr[k] < ML ? xl + (size_t)rr[k] * 1024 : xc + (size_t)(rr[k] - ML) * 1024; mp[k] = mod + (rr[k] < ML ? (rr[k] >> 13) : 4) * 6144; }
        f32x4 v[4][4]; float ss[4];
#pragma unroll
        for (int k = 0; k < 4; ++k)
#pragma unroll
            for (int j = 0; j < 4; ++j) v[k][j] = ((const f32x4*)xp[k])[lane + 64 * j];
#pragma unroll
        for (int k = 0; k < 4; ++k) { ss[k] = 0.f;
#pragma unroll
            for (int j = 0; j < 4; ++j) ss[k] += (v[k][j].x * v[k][j].x + v[k][j].y * v[k][j].y) + (v[k][j].z * v[k][j].z + v[k][j].w * v[k][j].w); }
#pragma unroll
        for (int o = 1; o < 64; o <<= 1) {
#pragma unroll
            for (int k = 0; k < 4; ++k) ss[k] += shx(ss[k], o, lane); }
#pragma unroll
        for (int j = 0; j < 4; ++j) { const int col = 4 * lane + 256 * j;
            const f32x4 g4 = *(const f32x4*)(g + col);
#pragma unroll
            for (int k = 0; k < 4; ++k) { if (k == 0 || r + k * NGW < nrows) {
                const float rinv = 1.0f / sqrtf(ss[k] * (1.0f / 1024.0f) + EPSF);
                const f32x4 sc4 = *(const f32x4*)(mp[k] + scoff + col), sh4 = *(const f32x4*)(mp[k] + shoff + col); const f32x4 o = (v[k][j] * rinv * g4) * (sc4 + 1.0f) + sh4;
                v2u w; w.x = pk2(o.x, o.y); w.y = pk2(o.z, o.w); *(v2u*)(H + (size_t)rr[k] * 1024 + col) = w; } }
        }
    }
}

__device__ __forceinline__ cf mk2(float x, float y) { cf r; r.x = x; r.y = y; return r; }
__device__ __forceinline__ cf cmul(cf a, cf b) { return mk2(a.x * b.x - a.y * b.y, a.x * b.y + a.y * b.x); }
__device__ __forceinline__ cf cmulc(cf a, cf b) { return mk2(a.x * b.x + a.y * b.y, a.y * b.x - a.x * b.y); }
__device__ __forceinline__ cf ld_f2_l2(const cf* p) {
    const unsigned long long w = __hip_atomic_load((const unsigned long long*)p, __ATOMIC_RELAXED, __HIP_MEMORY_SCOPE_AGENT);
    return mk2(__uint_as_float((unsigned)w), __uint_as_float((unsigned)(w >> 32)));
}
__device__ __forceinline__ int PX(int i) { return i + (i >> 6); }
__device__ __forceinline__ cf twid(float frac) { return mk2(__builtin_amdgcn_cosf(frac), -__builtin_amdgcn_sinf(frac)); }
__device__ __forceinline__ void bfly4_fwd(cf& a0, cf& a1, cf& a2, cf& a3) {
    const cf s02 = a0 + a2, d02 = a0 - a2, s13 = a1 + a3, d13 = a1 - a3;
    a0 = s02 + s13; a2 = s02 - s13; a1 = mk2(d02.x + d13.y, d02.y - d13.x); a3 = mk2(d02.x - d13.y, d02.y + d13.x);
}
__device__ __forceinline__ void bfly4_inv(cf& a0, cf& a1, cf& a2, cf& a3) {
    const cf s02 = a0 + a2, d02 = a0 - a2, s13 = a1 + a3, d13 = a1 - a3;
    a0 = s02 + s13; a2 = s02 - s13; a1 = mk2(d02.x - d13.y, d02.y + d13.x); a3 = mk2(d02.x + d13.y, d02.y - d13.x);
}
template <int LG, bool INV> __device__ __forceinline__ void fft_pass2(LAS cf* X, int tid) {
    constexpr int L = 1 << LG, L16 = L >> 4, L4 = L >> 2; constexpr float fL = 1.0f / (float)L;
#pragma unroll 1
    for (int i = 0; i < 2; ++i) {
        const int it = tid + 512 * i; int g, j;
        if (LG == 14) { g = 0; j = it; } else if (LG == 10) { j = it & 63; g = it >> 6; } else { g = it & 255; j = it >> 8; }
        const int base = g * L + j;
        cf e[4][4];
#pragma unroll
        for (int r = 0; r < 4; ++r)
#pragma unroll
            for (int m = 0; m < 4; ++m) e[r][m] = X[PX(base + r * L16 + m * L4)];
        const cf v1 = twid((float)(4 * j) * fL), v2 = cmul(v1, v1), v3 = cmul(v2, v1);
        if (!INV) {
#pragma unroll
            for (int r = 0; r < 4; ++r) { bfly4_fwd(e[r][0], e[r][1], e[r][2], e[r][3]);
                const cf w1 = twid((float)(j + r * L16) * fL), w2 = cmul(w1, w1), w3 = cmul(w2, w1);
                e[r][1] = cmul(e[r][1], w1); e[r][2] = cmul(e[r][2], w2); e[r][3] = cmul(e[r][3], w3); }
#pragma unroll
            for (int p = 0; p < 4; ++p) { bfly4_fwd(e[0][p], e[1][p], e[2][p], e[3][p]); e[1][p] = cmul(e[1][p], v1); e[2][p] = cmul(e[2][p], v2); e[3][p] = cmul(e[3][p], v3); }
        } else {
#pragma unroll
            for (int p = 0; p < 4; ++p) { e[1][p] = cmulc(e[1][p], v1); e[2][p] = cmulc(e[2][p], v2); e[3][p] = cmulc(e[3][p], v3); bfly4_inv(e[0][p], e[1][p], e[2][p], e[3][p]); }
#pragma unroll
            for (int r = 0; r < 4; ++r) { const cf w1 = twid((float)(j + r * L16) * fL), w2 = cmul(w1, w1), w3 = cmul(w2, w1);
                e[r][1] = cmulc(e[r][1], w1); e[r][2] = cmulc(e[r][2], w2); e[r][3] = cmulc(e[r][3], w3); bfly4_inv(e[r][0], e[r][1], e[r][2], e[r][3]); }
        }
#pragma unroll
        for (int r = 0; r < 4; ++r)
#pragma unroll
            for (int m = 0; m < 4; ++m) X[PX(base + r * L16 + m * L4)] = e[r][m];
    }
    __syncthreads();
}
__device__ __forceinline__ void fft_last_fwd(LAS cf* X, int tid, cf* KFW, float bias, float scale) {
#pragma unroll 2
    for (int i = 0; i < 8; ++i) { const int it = tid + 512 * i, g = it & 255, k = it >> 8, base = g * 64 + 4 * k;
        cf e0 = X[PX(base)], e1 = X[PX(base + 1)], e2 = X[PX(base + 2)], e3 = X[PX(base + 3)];
        bfly4_fwd(e0, e1, e2, e3);
        if (KFW) { cf* o = KFW + (4 * k) * 256 + g; o[0] = mk2((e0.x + bias) * scale, e0.y * scale); o[256] = mk2((e1.x + bias) * scale, e1.y * scale); o[512] = mk2((e2.x + bias) * scale, e2.y * scale); o[768] = mk2((e3.x + bias) * scale, e3.y * scale); }
        else { X[PX(base)] = e0; X[PX(base + 1)] = e1; X[PX(base + 2)] = e2; X[PX(base + 3)] = e3; } }
    __syncthreads();
}
__device__ __forceinline__ void fft_first_inv_mul(LAS cf* X, int tid, const cf* KFR) {
#pragma unroll 2
    for (int i = 0; i < 8; ++i) { const int it = tid + 512 * i, g = it & 255, k = it >> 8, base = g * 64 + 4 * k; const cf* q = KFR + (4 * k) * 256 + g;
        cf e0 = cmul(X[PX(base)], ld_f2_l2(q)), e1 = cmul(X[PX(base + 1)], ld_f2_l2(q + 256)), e2 = cmul(X[PX(base + 2)], ld_f2_l2(q + 512)), e3 = cmul(X[PX(base + 3)], ld_f2_l2(q + 768));
        bfly4_inv(e0, e1, e2, e3);
        X[PX(base)] = e0; X[PX(base + 1)] = e1; X[PX(base + 2)] = e2; X[PX(base + 3)] = e3; }
    __syncthreads();
}
__device__ __forceinline__ void fft_mid_mul(LAS cf* X, int tid, const cf* KFR) {
#pragma unroll 2
    for (int i = 0; i < 8; ++i) { const int it = tid + 512 * i, g = it & 255, k = it >> 8, base = g * 64 + 4 * k; const cf* q = KFR + (4 * k) * 256 + g;
        cf e0 = X[PX(base)], e1 = X[PX(base + 1)], e2 = X[PX(base + 2)], e3 = X[PX(base + 3)];
        const cf k0 = ld_f2_l2(q), k1 = ld_f2_l2(q + 256), k2 = ld_f2_l2(q + 512), k3 = ld_f2_l2(q + 768);
        bfly4_fwd(e0, e1, e2, e3);
        e0 = cmul(e0, k0); e1 = cmul(e1, k1); e2 = cmul(e2, k2); e3 = cmul(e3, k3);
        bfly4_inv(e0, e1, e2, e3);
        X[PX(base)] = e0; X[PX(base + 1)] = e1; X[PX(base + 2)] = e2; X[PX(base + 3)] = e3; }
    __syncthreads();
}
__device__ __forceinline__ void fft_fwd_lds(LAS cf* X, int tid) { fft_pass2<14, false>(X, tid); fft_pass2<10, false>(X, tid); fft_pass2<6, false>(X, tid); }
__device__ __forceinline__ void fft_inv_lds(LAS cf* X, int tid) { fft_pass2<6, true>(X, tid); fft_pass2<10, true>(X, tid); fft_pass2<14, true>(X, tid); }
__device__ __forceinline__ void conv8(const bf16_t* p, int c, int n, float w0, float w1, float w2, float b, float (&o)[8]) {
    const v4u v = *(const v4u*)(p + 8 * c);
    const float um = c > 0 ? bf2f(p[8 * c - 1]) : 0.f, up = 8 * c + 8 < n ? bf2f(p[8 * c + 8]) : 0.f;
    const float u0 = bflo(v.x), u1 = bfhi(v.x), u2 = bflo(v.y), u3 = bfhi(v.y), u4 = bflo(v.z), u5 = bfhi(v.z), u6 = bflo(v.w), u7 = bfhi(v.w);
    o[0] = w0 * um + w1 * u0 + w2 * u1 + b; o[1] = w0 * u0 + w1 * u1 + w2 * u2 + b; o[2] = w0 * u1 + w1 * u2 + w2 * u3 + b; o[3] = w0 * u2 + w1 * u3 + w2 * u4 + b;
    o[4] = w0 * u3 + w1 * u4 + w2 * u5 + b; o[5] = w0 * u4 + w1 * u5 + w2 * u6 + b; o[6] = w0 * u5 + w1 * u6 + w2 * u7 + b; o[7] = w0 * u6 + w1 * u7 + w2 * up + b;
}
__device__ __forceinline__ float hy_in(const bf16_t* p, int t, int n, float w0, float w1, float w2, float b) {
    const float um = t > 0 ? bf2f(p[t - 1]) : 0.f, u0 = bf2f(p[t]), up = t < n - 1 ? bf2f(p[t + 1]) : 0.f;
    return w0 * um + w1 * u0 + w2 * up + b;
}

#define XB_TMO      128
#define XB_XCNT(j)  (256  + 64 * (j))
#define XB_XSUB(j)  (1280 + 64 * (j))
#define XB_XGEN(j)  (2304 + 64 * (j))
#define XB_TOP      3328
#define XB_TOPGEN   3392
#define XCD_BAR_WORDS 3456
#define XB_SPIN_CAP (1u << 18)

__device__ __forceinline__ unsigned xb_ld(unsigned* p)              { return __hip_atomic_load(p, __ATOMIC_RELAXED, __HIP_MEMORY_SCOPE_AGENT); }
__device__ __forceinline__ unsigned xb_add(unsigned* p, unsigned v) { return __hip_atomic_fetch_add(p, v, __ATOMIC_RELAXED, __HIP_MEMORY_SCOPE_AGENT); }
__device__ __forceinline__ unsigned xb_xcc_id() { return (unsigned)__builtin_amdgcn_s_getreg((3 << 11) | 20) & 0xFu; }
#define XB_SPIN(cond, bar) do { unsigned _sp = 0; while (cond) { __builtin_amdgcn_s_sleep(1); \
    if ((++_sp & 255u) == 0u) { if (xb_ld(&(bar)[XB_TMO])) break; if (_sp > XB_SPIN_CAP) { atomicAdd(&(bar)[XB_TMO], 1u); break; } } } } while (0)

struct XcdBarrier {
    unsigned* bar; unsigned x;
    volatile LAS unsigned* st;
};

__device__ __forceinline__ XcdBarrier xcd_barrier_post(unsigned* bar, volatile LAS unsigned* st) {
    XcdBarrier b; b.bar = bar; b.x = xb_xcc_id(); b.st = st;
    if (threadIdx.x == 0) (void)xb_add(&bar[XB_XCNT(b.x)], 1u);
    return b;
}
__device__ __forceinline__ void xcd_barrier_complete(unsigned* bar, unsigned x, unsigned& nloc, unsigned& nx) {
    const unsigned G = gridDim.x * gridDim.y * gridDim.z;
    unsigned sum, cnt, mine, sp = 0u;
    for (;;) {
        sum = 0u; cnt = 0u; mine = 0u;
#pragma unroll
        for (unsigned j = 0; j < 16; ++j) { const unsigned c = xb_ld(&bar[XB_XCNT(j)]); sum += c; cnt += (c > 0u) ? 1u : 0u; mine = (j == x) ? c : mine; }
        if (sum == G) break;
        __builtin_amdgcn_s_sleep(1);
        if ((++sp & 255u) == 0u) { if (xb_ld(&bar[XB_TMO])) break; if (sp > XB_SPIN_CAP) { atomicAdd(&bar[XB_TMO], 1u); break; } }
    }
    nloc = mine > 0u ? mine : 1u; nx = cnt > 0u ? cnt : 1u;
}

__device__ __forceinline__ void xcd_barrier(const XcdBarrier& b, const int wave0) {
    asm volatile("s_waitcnt vmcnt(0)" ::: "memory");
    __syncthreads();
    if (wave0 == 0 && lane_id_v() == 0) {
        unsigned* bar = b.bar;
        __builtin_amdgcn_s_waitcnt(0);
        unsigned nloc = b.st[0], nx = b.st[1];
        if (nloc == 0u) { xcd_barrier_complete(bar, b.x, nloc, nx); b.st[0] = nloc; b.st[1] = nx; }
        const unsigned old = xb_add(&bar[XB_XSUB(b.x)], 1u);
        const unsigned gen = old / nloc;
        if (old + 1u == (gen + 1u) * nloc) {
            __builtin_amdgcn_fence(__ATOMIC_RELEASE, "agent");
            asm volatile("s_waitcnt vmcnt(0)" ::: "memory");
            const unsigned og = xb_add(&bar[XB_TOP], 1u);
            const unsigned tg = og / nx;
            if (og + 1u == (tg + 1u) * nx) xb_add(&bar[XB_TOPGEN], 1u);
            else XB_SPIN(xb_ld(&bar[XB_TOPGEN]) == tg, bar);
            __builtin_amdgcn_fence(__ATOMIC_ACQUIRE, "agent");
            xb_add(&bar[XB_XGEN(b.x)], 1u);
            asm volatile("s_waitcnt vmcnt(0)" ::: "memory");
        } else {
            XB_SPIN(xb_ld(&bar[XB_XGEN(b.x)]) == gen, bar);
            __builtin_amdgcn_fence(__ATOMIC_ACQUIRE, "agent");
            asm volatile("s_waitcnt vmcnt(0)" ::: "memory");
        }
    }
    __syncthreads();
}


struct Args { const float* in[33]; float* out; unsigned char* ws; };
__device__ __forceinline__ unsigned char* wsb(unsigned char* p) { asm volatile("" : "+s"(p)); return p; }
__device__ __forceinline__ int opq(int i) { asm volatile("" : "+s"(i)); return i; }

#define MOD ((float*)(wsb(a.ws) + WS_MOD))
#define LAM ((float*)(wsb(a.ws) + WS_LAM))
#define ROPE ((cf*)(wsb(a.ws) + WS_ROPE))
#define TW ((cf*)(wsb(a.ws) + WS_TW))
#define WIN ((bf16_t*)(wsb(a.ws) + WS_WIN))
#define WOUT ((bf16_t*)(wsb(a.ws) + WS_WOUT))
#define WUP ((bf16_t*)(wsb(a.ws) + WS_WUP))
#define WDN ((bf16_t*)(wsb(a.ws) + WS_WDN))
#define CTXX ((float*)(wsb(a.ws) + WS_CTXX))
#define FILT ((float*)(wsb(a.ws) + WS_FILT))
#define FILTC ((float*)(wsb(a.ws) + WS_FILTC))
#define H ((bf16_t*)(wsb(a.ws) + WS_H))
#define KFB ((cf*)(wsb(a.ws) + WS_KF))
#define RAW ((bf16_t*)(wsb(a.ws) + WS_RAW))
#define YRAW ((bf16_t*)(wsb(a.ws) + WS_YRAW))
#define YH ((float*)(wsb(a.ws) + WS_YH))
#define YHC ((float*)(wsb(a.ws) + WS_YHC))
#define QA ((bf16_t*)(wsb(a.ws) + WS_QA))
#define KA ((bf16_t*)(wsb(a.ws) + WS_KA))
#define VA ((bf16_t*)(wsb(a.ws) + WS_VA))
#define QD ((bf16_t*)(wsb(a.ws) + WS_QD))
#define KD ((bf16_t*)(wsb(a.ws) + WS_KD))
#define VD ((bf16_t*)(wsb(a.ws) + WS_VD))
#define HYR ((bf16_t*)(wsb(a.ws) + WS_HYR))
#define HYRC ((bf16_t*)(wsb(a.ws) + WS_HYRC))
#define GB ((bf16_t*)(wsb(a.ws) + WS_G))
#define OUT (a.out)
__device__ __forceinline__ void prep_work(const Args& a, LAS unsigned char* lds, const int lp, const bool needc, const int widx, const int nwg, const bool do_main, const bool do_dn, const int tid, const int lane, const int wave) {
    LAS float* scr = (LAS float*)(lds + wave * 16384);
    constexpr int I_IN = 16 * 88, I_OUT = 16 * 32, I_UP = 16 * 176, I_DN = 44 * 32;
    for (int it = (do_main ? 0 : I_IN + I_OUT + I_UP) + widx * 8 + wave; it < (do_dn ? I_IN + I_OUT + I_UP + I_DN : I_IN + I_OUT + I_UP); it += nwg * 8) {
        int r = it;
        if (r < I_IN) { transpose_item<2>(a.in[opq(8)] + (size_t)lp * 1024 * INW, 1024, INW, WIN, scr, r, lane); continue; } r -= I_IN;
        if (r < I_OUT) { transpose_item(a.in[opq(28)] + (size_t)lp * 1024 * 1024, 1024, 1024, WOUT, scr, r, lane); continue; } r -= I_OUT;
        if (r < I_UP) { transpose_item<1>(a.in[opq(29)] + (size_t)lp * 1024 * 2 * DFF, 1024, 2 * DFF, WUP, scr, r, lane); continue; } r -= I_UP;
        transpose_item(a.in[opq(32)] + (size_t)lp * DFF * 1024, DFF, 1024, WDN, scr, r, lane);
    }
    __syncthreads();
    if (do_main) {
    const float* fw1 = a.in[opq(19)] + lp * 33 * 64; const float* fb1 = a.in[opq(20)] + lp * 64; const float* fw2 = a.in[opq(21)] + lp * 64 * 64; const float* fb2 = a.in[opq(22)] + lp * 64;
    const float* fw3 = a.in[opq(23)] + (size_t)lp * 64 * 1024; const float* fb3 = a.in[opq(24)] + lp * 1024; const float* freq = a.in[opq(25)] + lp * 64;
    LAS float* Z = (LAS float*)lds; LAS float* H1 = Z + 33 * 33; LAS float* H2 = H1 + 33 * 64; LAS float* W1 = H2 + 33 * 64; LAS float* W2 = W1 + 33 * 64; LAS float* FB = W2 + 64 * 64;
    for (int i = tid; i < 33 * 64; i += NTHR) W1[i] = fw1[i];
    for (int i = tid; i < 64 * 64; i += NTHR) W2[i] = fw2[i];
    if (tid < 64) { FB[tid] = fb1[tid]; FB[64 + tid] = fb2[tid]; FB[128 + tid] = freq[tid]; }
    const int npos = needc ? 33 : 32;
    for (int item = widx; item < 256; item += nwg) {
        __syncthreads();
        for (int i = tid; i < npos * 33; i += NTHR) { const int p = i / 33, e = i - p * 33; const bool isc = p == 32; const int n = isc ? item : item * 32 + p; const float NP = isc ? 256.0f : 8192.0f; float val;
            if (e == 0) val = (float)n / (NP - 1.0f);
            else { const int k = (e - 1) & 15; const float band = 1e-4f + (float)k * ((15.0f - 1e-4f) / 15.0f); const float w = 6.283185307179586f * (float)n / NP; const float arg = band * w;
                val = (e <= 16) ? cosf(arg) : -sinf(arg); }
            Z[i] = val; }
        __syncthreads();
        for (int i = tid; i < npos * 64; i += NTHR) { const int p = i >> 6, j = i & 63; float s = FB[j];
#pragma unroll
            for (int e = 0; e < 33; ++e) s += Z[p * 33 + e] * W1[e * 64 + j];
            H1[i] = sinf(FB[128 + j] * s); }
        __syncthreads();
        for (int i = tid; i < npos * 64; i += NTHR) { const int p = i >> 6, j = i & 63; float s = FB[64 + j];
#pragma unroll 16
            for (int e = 0; e < 64; ++e) s += H1[p * 64 + e] * W2[e * 64 + j];
            H2[i] = sinf(FB[128 + j] * s); }
        __syncthreads();
#pragma unroll 1
        for (int half = 0; half < 2; ++half) { const int q = tid + 512 * half, c = q & 255;
            float w[64];
#pragma unroll
            for (int e = 0; e < 64; ++e) w[e] = fw3[(size_t)e * 1024 + q];
            const float b3 = fb3[q], adelta = 3.0701134573253945f + (float)c * ((15.350567286626973f - 3.0701134573253945f) / 255.0f);
#pragma unroll 1
            for (int p = 0; p < npos; ++p) { float s = b3;
#pragma unroll
                for (int e = 0; e < 64; ++e) s += H2[p * 64 + e] * w[e];
                const bool isc = p == 32; const int n = isc ? item : item * 32 + p; const float t = (float)n / (isc ? 255.0f : 8191.0f);
                float* dst = isc ? FILTC + (size_t)q * 256 : FILT + (size_t)q * 8192;
                dst[n] = s * expf(-t * adelta); }
        }
    }
    __syncthreads();
    }
}

__global__ void __launch_bounds__(NTHR, 2) fwd_mega(Args a) {
    extern __shared__ __attribute__((aligned(16))) unsigned char lds_raw[];
    cg::grid_group grid = cg::this_grid();
    LAS unsigned char* lds = (LAS unsigned char*)lds_raw;
    const int G = gridDim.x, bx = blockIdx.x;
    const int NGW = G * 8;
const int wave0 = __builtin_amdgcn_readfirstlane(threadIdx.x >> 6);
#define PHASE_IDS int tid = wave0 * 64 + lane_id_v(); asm volatile("" : "+v"(tid)); const int lane = tid & 63, wave = __builtin_amdgcn_readfirstlane(tid >> 6); const int gw = bx * 8 + wave; (void)lane; (void)gw;

    volatile LAS unsigned* MISC = (volatile LAS unsigned*)(lds + 147392);
    if (threadIdx.x < 16) MISC[threadIdx.x] = 0u;
    __syncthreads();
    const XcdBarrier xbar = xcd_barrier_post((unsigned*)a.ws, MISC + 8);
    if (threadIdx.x == 0) MISC[2] = xb_add((unsigned*)a.ws + 4096 + 64 * xbar.x, 1u);
    {
        PHASE_IDS
        LAS float* S = (LAS float*)lds; LAS float* RED = S + 5 * 1024;
        const float* c = a.in[opq(1)]; const float* cctx = a.in[opq(3)];
        for (int i = tid; i < 5 * 1024; i += NTHR) { const float v = i < 4096 ? c[i] : cctx[i - 4096]; S[i] = v / (1.f + expf(-v)); }
        __syncthreads();
        const float* wmod = a.in[opq(6)]; const float* bmod = a.in[opq(7)];
        for (int item = bx; item < 384; item += G) {
            const int l = item / 96, cgi = item % 96, ks = tid >> 6, jl = tid & 63, col = cgi * 64 + jl;
            const float* w = wmod + ((size_t)l * 1024 + ks * 128) * 6144 + col;
            float a0 = 0.f, a1 = 0.f, a2 = 0.f, a3 = 0.f, a4 = 0.f;
#pragma unroll 8
            for (int k = 0; k < 128; ++k) { const float wv = w[(size_t)k * 6144]; const int kk = ks * 128 + k;
                a0 += S[kk] * wv; a1 += S[1024 + kk] * wv; a2 += S[2048 + kk] * wv; a3 += S[3072 + kk] * wv; a4 += S[4096 + kk] * wv; }
            RED[(ks * 5 + 0) * 64 + jl] = a0; RED[(ks * 5 + 1) * 64 + jl] = a1; RED[(ks * 5 + 2) * 64 + jl] = a2; RED[(ks * 5 + 3) * 64 + jl] = a3; RED[(ks * 5 + 4) * 64 + jl] = a4;
            __syncthreads();
            if (tid < 320) { const int bi = tid >> 6, j = tid & 63; float s = bmod[l * 6144 + cgi * 64 + j];
#pragma unroll
                for (int k2 = 0; k2 < 8; ++k2) s += RED[(k2 * 5 + bi) * 64 + j];
                MOD[((size_t)l * 5 + bi) * 6144 + cgi * 64 + j] = s; }
            __syncthreads();
        }
        if (bx == 0 && wave < 4) { const int l = wave;
            const float s1 = wave_sum(a.in[opq(13)][l * 64 + lane] * a.in[opq(14)][l * 64 + lane]), s2 = wave_sum(a.in[opq(15)][l * 64 + lane] * a.in[opq(16)][l * 64 + lane]);
            if (lane == 0) LAM[l] = expf(s1) - expf(s2) + (0.8f - 0.6f * expf(-0.3f * (float)l)); }
        const int gt = bx * NTHR + tid;
        if (gt < 2048) { const int p = gt >> 4, f = gt & 15; const float inv = powf(10000.0f, -(float)f / 16.0f); float sn, cs; sincosf((float)p * inv, &sn, &cs); ROPE[gt] = mk2(cs, sn); }
        for (int m = gt; m < FFTN; m += G * NTHR) { float sn, cs; sincospif((float)m / 8192.0f, &sn, &cs); TW[m] = mk2(cs, -sn); }
    }
    if (PROBE_PLAIN_LAUNCH) xcd_barrier(xbar, wave0); else grid.sync();
    if (threadIdx.x == 0) {
        bool ok = (G % 8 == 0) && xbar.x < 8u;
        for (int j = 0; j < 8; ++j) ok = ok && (xb_ld((unsigned*)a.ws + 4096 + 64 * j) == (unsigned)(G / 8));
        const unsigned rk = MISC[2];
        MISC[0] = ok ? rk * 8u + xbar.x : (unsigned)bx;
        MISC[1] = ok ? xbar.x * (unsigned)(G / 8) + rk : (unsigned)((G % 8 == 0) ? (bx % 8) * (G / 8) + bx / 8 : bx);
    }
    __syncthreads();
    const int cbx = __builtin_amdgcn_readfirstlane((int)MISC[0]), vcu = __builtin_amdgcn_readfirstlane((int)MISC[1]);

    for (int l = 0; l < DEPTH; ++l) {
        const bool need_ctx = l < DEPTH - 1;
        const float* xl = l == 0 ? a.in[opq(0)] : OUT; const float* xc = l == 0 ? a.in[opq(2)] : CTXX;
        const float* modl = MOD + (size_t)l * 5 * 6144;
        for (int rep_ = 0; rep_ < REP_PREP; ++rep_) {
            PHASE_IDS
            __syncthreads();
            prep_work(a, lds, l, need_ctx, bx, G, l == 0, true, tid, lane, wave);
            norm_mod(xl, xc, a.in[opq(4)] + l * 1024, modl, 0, 1024, H, MT, gw, NGW, lane);
        }
        xcd_barrier(xbar, wave0);
        {
            pg8::Gemm g{H, WIN, MT, INW, 1024}; pg8::StaticOrder S; S.init(MT, INW, G, cbx);
            EpiInProj E{QA, KA, VA, QD, KD, VD, HYR, HYRC, a.in[opq(9)] + l * 64, a.in[opq(10)] + l * 64, a.in[opq(11)] + l * 64, a.in[opq(12)] + l * 64, ROPE};
            pg8::gemm_phase<EpiInProj, pg8::StaticOrder, PG8_ALIGN, PG8_SP2>(lds, g, S, E, wave0);
        }
        xcd_barrier(xbar, wave0);
        {
            PHASE_IDS
            LAS cf* X = (LAS cf*)lds; LAS float* RED = (LAS float*)(lds + 135168);
            const float* cw = a.in[opq(17)] + l * 3 * 768; const float* cb = a.in[opq(18)] + l * 768; const float* hb_ = a.in[opq(26)] + l * 512;
            for (int rep_ = 0; rep_ < REP_HY; ++rep_) for (int c = vcu; c < 256; c += G) {
                const float wv0 = cw[c], wv1 = cw[768 + c], wv2 = cw[1536 + c], bv = cb[c];
                const float wa0 = cw[256 + c], wa1 = cw[768 + 256 + c], wa2 = cw[1536 + 256 + c], ba = cb[256 + c];
                const float wb0 = cw[512 + c], wb1 = cw[768 + 512 + c], wb2 = cw[1536 + 512 + c], bb = cb[512 + c];
                const float bias1 = hb_[c], bias2 = hb_[256 + c];
                cf* KF = KFB + (size_t)c * 2 * FFTN;
                const int cw = 8 * (lane & 7) + (lane >> 3);
                for (int o = 0; o < 2; ++o) {
                    const float* hf = FILT + ((size_t)(0 * 2 + o) * 256 + c) * 8192; const float* hb = FILT + ((size_t)(1 * 2 + o) * 256 + c) * 8192;
                    float s = 0.f; for (int i = tid; i < 8192; i += NTHR) s += fabsf(hf[i]) + fabsf(hb[i]);
                    s = block_sum(s, RED, tid); const float inv = 1.0f / (s + EPSF);
                    for (int i = tid; i < 8192; i += NTHR) { X[PX(i)] = mk2(hf[i] * inv, 0.f); X[PX(8192 + i)] = (i == 0) ? mk2(0.f, 0.f) : mk2(hb[8192 - i] * inv, 0.f); }
                    __syncthreads();
                    fft_fwd_lds(X, tid);
                    fft_last_fwd(X, tid, KF + o * FFTN, o == 0 ? bias1 : bias2, 1.0f / FFTN);
                }
                __threadfence(); __syncthreads();
                for (int bp = 0; bp < 2; ++bp) {
                    const int b0 = 2 * bp, b1 = b0 + 1;
                    const bf16_t* pv0 = HYR + ((size_t)b0 * 768 + c) * 8192; const bf16_t* pv1 = HYR + ((size_t)b1 * 768 + c) * 8192;
#pragma unroll 1
                    for (int k = 0; k < 2; ++k) { const int ch = 64 * (wave + 8 * k) + cw; float u0[8], u1[8];
                        conv8(pv0, ch, 8192, wv0, wv1, wv2, bv, u0); conv8(pv1, ch, 8192, wv0, wv1, wv2, bv, u1);
#pragma unroll
                        for (int e = 0; e < 8; ++e) { X[PX(8 * ch + e)] = mk2(u0[e], u1[e]); X[PX(8192 + 8 * ch + e)] = mk2(0.f, 0.f); } }
                    __syncthreads();
                    fft_fwd_lds(X, tid); fft_mid_mul(X, tid, KF); fft_inv_lds(X, tid);
#pragma unroll 1
                    for (int k = 0; k < 2; ++k) { const int ch = 64 * (wave + 8 * k) + cw; float a0_[8], a1_[8];
                        conv8(pv0 + 256 * 8192, ch, 8192, wa0, wa1, wa2, ba, a0_); conv8(pv1 + 256 * 8192, ch, 8192, wa0, wa1, wa2, ba, a1_);
#pragma unroll
                        for (int e = 0; e < 8; ++e) { const cf cv = X[PX(8 * ch + e)]; X[PX(8 * ch + e)] = mk2(a0_[e] * cv.x, a1_[e] * cv.y); X[PX(8192 + 8 * ch + e)] = mk2(0.f, 0.f); } }
                    __syncthreads();
                    fft_fwd_lds(X, tid); fft_mid_mul(X, tid, KF + FFTN); fft_inv_lds(X, tid);
#pragma unroll 1
                    for (int k = 0; k < 2; ++k) { const int ch = 64 * (wave + 8 * k) + cw; float x0_[8], x1_[8];
                        conv8(pv0 + 512 * 8192, ch, 8192, wb0, wb1, wb2, bb, x0_); conv8(pv1 + 512 * 8192, ch, 8192, wb0, wb1, wb2, bb, x1_);
                        f32x4 o0a, o0b, o1a, o1b;
#pragma unroll
                        for (int e = 0; e < 4; ++e) { const cf ca = X[PX(8 * ch + e)], cb2 = X[PX(8 * ch + 4 + e)]; o0a[e] = x0_[e] * ca.x; o1a[e] = x1_[e] * ca.y; o0b[e] = x0_[4 + e] * cb2.x; o1b[e] = x1_[4 + e] * cb2.y; }
                        float* y0p = YH + ((size_t)b0 * 256 + c) * 8192 + 8 * ch; float* y1p = YH + ((size_t)b1 * 256 + c) * 8192 + 8 * ch;
                        *(f32x4*)y0p = o0a; *(f32x4*)(y0p + 4) = o0b; *(f32x4*)y1p = o1a; *(f32x4*)(y1p + 4) = o1b; }
                    __syncthreads();
                }
                if (need_ctx) {
                    int tidc = tid; asm volatile("" : "+v"(tidc));
                    LAS float* KC = (LAS float*)lds; LAS float* U = KC + 1024; LAS float* XA = U + 1024; LAS float* XB = XA + 1024; LAS float* Z1 = XB + 1024;
                    for (int o = 0; o < 2; ++o) {
                        const float* hf = FILTC + ((size_t)(0 * 2 + o) * 256 + c) * 256; const float* hb = FILTC + ((size_t)(1 * 2 + o) * 256 + c) * 256;
                        const float f_ = tid < 256 ? hf[tid] : 0.f, b_ = tid < 256 ? hb[tid] : 0.f;
                        float s = fabsf(f_) + fabsf(b_);
                        s = block_sum(s, RED, tid); const float inv = 1.0f / (s + EPSF);
                        if (tid < 256) { KC[o * 512 + 255 + tid] = f_ * inv; if (tid > 0) KC[o * 512 + 255 - tid] = b_ * inv; }
                    }
#pragma unroll 1
                    for (int k = 0; k < 2; ++k) { const int i = tidc + 512 * k, b = i >> 8, t = i & 255; const bf16_t* p = HYRC + ((size_t)b * 768 + c) * 256;
                        U[i] = hy_in(p, t, 256, wv0, wv1, wv2, bv); XA[i] = hy_in(p + 256 * 256, t, 256, wa0, wa1, wa2, ba); XB[i] = hy_in(p + 512 * 256, t, 256, wb0, wb1, wb2, bb); }
                    __syncthreads();
#pragma unroll 1
                    for (int k = 0; k < 2; ++k) { const int i = tidc + 512 * k, b = i >> 8, t = i & 255; float acc = 0.f; const LAS float* kp = KC + 255 + t; const LAS float* up = U + b * 256;
#pragma unroll 8
                        for (int s = 0; s < 256; ++s) acc += kp[-s] * up[s];
                        Z1[i] = XA[i] * (acc + bias1 * U[i]); }
                    __syncthreads();
#pragma unroll 1
                    for (int k = 0; k < 2; ++k) { const int i = tidc + 512 * k, b = i >> 8, t = i & 255; float acc = 0.f; const LAS float* kp = KC + 512 + 255 + t; const LAS float* up = Z1 + b * 256;
#pragma unroll 8
                        for (int s = 0; s < 256; ++s) acc += kp[-s] * up[s];
                        YHC[((size_t)b * 256 + c) * 256 + t] = XB[i] * (acc + bias2 * Z1[i]); }
                    __syncthreads();
                }
            }
            for (int rep_ = 0; rep_ < REP_ATT; ++rep_) {
                const int nA = 16 * 32 + (need_ctx ? 16 : 0), nC = 32 * 32 + (need_ctx ? 32 : 0);
                for (int u = vcu; u < nA; u += G) {
                    const bool isc = u >= 16 * 32; const int hu = isc ? u - 16 * 32 : (u >> 5), qb = u & 31, b = hu >> 2, k = hu & 3, row0 = isc ? ML + b * 256 : b * 8192 + qb * 256;
                    attn_body::attn_unit<8, false, 256, 64, 64, 1280>((const attn_body::bf16*)(QA + k * 64 + (size_t)row0 * 256), (const attn_body::bf16*)(KA + (size_t)(b * 2 + (k >> 1)) * NKEY * 64), (const attn_body::bf16*)(VA + (size_t)(b * 2 + (k >> 1)) * NKEY * 64),
                        (attn_body::bf16*)(YRAW + k * 64 + (size_t)row0 * 1280), isc ? 4 : 132, (char*)lds_raw, wave0);
                }
                for (int u = vcu; u < nC; u += G) {
                    const bool isc = u >= 32 * 32; const int hu = isc ? u - 32 * 32 : (u >> 5), qb = u & 31, b = hu >> 3, h = (hu & 7) >> 1, j = hu & 1, row0 = isc ? ML + b * 256 : b * 8192 + qb * 256;
                    attn_body::attn_unit<8, true, 512, 64, 128, 1280>((const attn_body::bf16*)(QD + (h * 2 + j) * 64 + (size_t)row0 * 512), (const attn_body::bf16*)(KD + (size_t)(b * 8 + h * 2 + j) * NKEY * 64), (const attn_body::bf16*)(VD + (size_t)(b * 4 + h) * NKEY * 128),
                        (attn_body::bf16*)(YRAW + 256 + j * 512 + h * 128 + (size_t)row0 * 1280), isc ? 4 : 132, (char*)lds_raw, wave0);
                }
            }
        }
        xcd_barrier(xbar, wave0);
        for (int rep_ = 0; rep_ < REP_MERGE; ++rep_) {
            PHASE_IDS
            LAS float* S = (LAS float*)lds;
            const float* go = a.in[opq(27)] + l * 1024;
            const float lam = LAM[l], lam_init = 0.8f - 0.6f * expf(-0.3f * (float)l);
            const int ntile = need_ctx ? 528 : 512;
            for (int tl = bx; tl < ntile; tl += G) {
                const int r0 = tl * 64; const float* yb; int cstride;
                if (r0 < ML) { yb = YH + (size_t)(r0 >> 13) * 256 * 8192 + (r0 & 8191); cstride = 8192; } else { const int rr = r0 - ML; yb = YHC + (size_t)(rr >> 8) * 256 * 256 + (rr & 255); cstride = 256; }
                for (int i = 0; i < 32; ++i) { const int c = i * 8 + wave; S[lane * 257 + c] = yb[(size_t)c * cstride + lane]; }
                __syncthreads();
                for (int k = 0; k < 8; ++k) {
                    const int row = wave * 8 + k, r = r0 + row; const bf16_t* yr = YRAW + (size_t)r * 1280; bf16_t* hr = H + (size_t)r * 1024;
                    { const v2u w = *(const v2u*)(yr + 4 * lane); const float y0 = bflo(w.x), y1 = bfhi(w.x), y2 = bflo(w.y), y3 = bfhi(w.y);
                      const float ss = wave_sum(y0 * y0 + y1 * y1 + y2 * y2 + y3 * y3); const float rinv = 1.0f / sqrtf(ss * (1.0f / 256.0f) + EPSF);
                      const f32x4 g4 = *(const f32x4*)(go + 4 * lane); v2u o; o.x = pk2(y0 * rinv * g4.x, y1 * rinv * g4.y); o.y = pk2(y2 * rinv * g4.z, y3 * rinv * g4.w); *(v2u*)(hr + 4 * lane) = o; }
                    { const float y0 = S[row * 257 + 4 * lane], y1 = S[row * 257 + 4 * lane + 1], y2 = S[row * 257 + 4 * lane + 2], y3 = S[row * 257 + 4 * lane + 3];
                      const float ss = wave_sum(y0 * y0 + y1 * y1 + y2 * y2 + y3 * y3); const float rinv = 1.0f / sqrtf(ss * (1.0f / 256.0f) + EPSF);
                      const f32x4 g4 = *(const f32x4*)(go + 256 + 4 * lane); v2u o; o.x = pk2(y0 * rinv * g4.x, y1 * rinv * g4.y); o.y = pk2(y2 * rinv * g4.z, y3 * rinv * g4.w); *(v2u*)(hr + 256 + 4 * lane) = o; }
                    { const v4u w0 = *(const v4u*)(yr + 256 + 8 * lane), w1 = *(const v4u*)(yr + 768 + 8 * lane);
                      float d[8];
                      d[0] = bflo(w0.x) - lam * bflo(w1.x); d[1] = bfhi(w0.x) - lam * bfhi(w1.x); d[2] = bflo(w0.y) - lam * bflo(w1.y); d[3] = bfhi(w0.y) - lam * bfhi(w1.y);
                      d[4] = bflo(w0.z) - lam * bflo(w1.z); d[5] = bfhi(w0.z) - lam * bfhi(w1.z); d[6] = bflo(w0.w) - lam * bflo(w1.w); d[7] = bfhi(w0.w) - lam * bfhi(w1.w);
                      float ss = 0.f;
#pragma unroll
                      for (int q = 0; q < 8; ++q) ss += d[q] * d[q];
                      ss += shx(ss, 1, lane); ss += shx(ss, 2, lane); ss += shx(ss, 4, lane); ss += shx(ss, 8, lane);
                      const float rinv = (1.0f - lam_init) / sqrtf(ss * (1.0f / 128.0f) + EPSF);
                      const f32x4 ga = *(const f32x4*)(go + 512 + 8 * lane), gb = *(const f32x4*)(go + 512 + 8 * lane + 4);
                      v4u o; o.x = pk2(d[0] * rinv * ga.x, d[1] * rinv * ga.y); o.y = pk2(d[2] * rinv * ga.z, d[3] * rinv * ga.w); o.z = pk2(d[4] * rinv * gb.x, d[5] * rinv * gb.y); o.w = pk2(d[6] * rinv * gb.z, d[7] * rinv * gb.w);
                      *(v4u*)(hr + 512 + 8 * lane) = o; }
                }
                __syncthreads();
            }
        }
        xcd_barrier(xbar, wave0);
        for (int es_ = 0; es_ < EXTRA_SYNC; ++es_) xcd_barrier(xbar, wave0);
        const int M5 = need_ctx ? MT : ML;
        {
            pg8::Gemm g{H, WOUT, M5, 1024, 1024}; pg8::StaticOrder S; S.init(M5, 1024, G, cbx);
            EpiGateRes E{xl, OUT, xc, CTXX, modl + 2048, 0};
            pg8::gemm_phase<EpiGateRes, pg8::StaticOrder, PG8_ALIGN, PG8_SP2>(lds, g, S, E, wave0);
            for (int rep_ = 1; rep_ < REP_GEMM2; ++rep_) { EpiGateRes E2{OUT, OUT, CTXX, CTXX, (const float*)(wsb(a.ws) + 65536), 0}; pg8::gemm_phase<EpiGateRes, pg8::StaticOrder, PG8_ALIGN, PG8_SP2>(lds, g, S, E2, wave0); }
        }
        xcd_barrier(xbar, wave0);
        for (int rep_ = 0; rep_ < REP_N2; ++rep_) { PHASE_IDS norm_mod(OUT, CTXX, a.in[opq(5)] + l * 1024, modl, 3072, 4096, H, M5, gw, NGW, lane); }
        xcd_barrier(xbar, wave0);
        {
            const int ntm = (M5 + 247) / 248;
            pg8::Gemm g{H - 1024, WUP, ntm * 256, 2 * DFF, 1024}; pg8::StaticOrder S; S.init(ntm * 256, 2 * DFF, G, cbx);
            EpiGlu E{GB, a.in[opq(30)] + (size_t)l * 3 * DFF, a.in[opq(31)] + l * DFF, M5};
            pg8::gemm_phase<EpiGlu, pg8::StaticOrder, PG8_ALIGN, PG8_SP2, true>(lds, g, S, E, wave0);
        }
        xcd_barrier(xbar, wave0);
        {
            pg8::Gemm g{GB, WDN, M5, 1024, DFF}; pg8::StaticOrder S; S.init(M5, 1024, G, cbx);
            EpiGateRes E{OUT, OUT, CTXX, CTXX, modl + 5120, 0};
            pg8::gemm_phase<EpiGateRes, pg8::StaticOrder, PG8_ALIGN, PG8_SP2>(lds, g, S, E, wave0);
            if (l + 1 < DEPTH) { const int units = (M5 >> 8) * 4, first = units % G;
                if (cbx >= first) { PHASE_IDS __syncthreads(); prep_work(a, lds, l + 1, l + 1 < DEPTH - 1, cbx - first, G - first, true, false, tid, lane, wave); } }
        }
        xcd_barrier(xbar, wave0);
    }
}

extern "C" void kernel_launch(void* const* d_in, const int* in_sizes, int n_in, void* d_out, int out_size, void* d_ws, size_t ws_size, hipStream_t stream) {
    static int grid = 0;
    if (grid == 0) {
        if (n_in != 33 || out_size != ML * DMOD || ws_size < WS_END) { fprintf(stderr, "kernel_launch: unexpected shapes: n_in %d out %d ws %zu (need %zu)\n", n_in, out_size, ws_size, (size_t)WS_END); grid = -1; return; }
        int dev = 0, cus = 0, per_cu = 0;
        if (hipGetDevice(&dev) != hipSuccess || hipDeviceGetAttribute(&cus, hipDeviceAttributeMultiprocessorCount, dev) != hipSuccess) { grid = -1; return; }
        if (hipFuncSetAttribute((const void*)fwd_mega, hipFuncAttributeMaxDynamicSharedMemorySize, LDS_BYTES) != hipSuccess) { fprintf(stderr, "kernel_launch: hipFuncSetAttribute failed\n"); grid = -1; return; }
        if (hipOccupancyMaxActiveBlocksPerMultiprocessor(&per_cu, (const void*)fwd_mega, NTHR, LDS_BYTES) != hipSuccess || per_cu < 1) { fprintf(stderr, "kernel_launch: occupancy query says %d\n", per_cu); }
        (void)hipGetLastError();
        grid = cus;
    }
    if (grid < 0) return;
    Args a{};
    for (int i = 0; i < 33; ++i) a.in[i] = (const float*)d_in[i];
    a.out = (float*)d_out; a.ws = (unsigned char*)d_ws;
    if (hipMemsetAsync(d_ws, 0, 32768, stream) != hipSuccess) { fprintf(stderr, "kernel_launch: memset failed\n"); return; }
    void* args[] = {&a};
#if PROBE_PLAIN_LAUNCH
    hipLaunchKernelGGL(fwd_mega, dim3(grid), dim3(NTHR), LDS_BYTES, stream, a); const hipError_t e = hipPeekAtLastError(); (void)args;
#else
    const hipError_t e = hipLaunchCooperativeKernel((const void*)fwd_mega, dim3(grid), dim3(NTHR), args, LDS_BYTES, stream);
#endif
    if (e != hipSuccess) fprintf(stderr, "kernel_launch: cooperative launch failed: %s (grid %d)\n", hipGetErrorString(e), grid);
}
```

```cpp
#include <hip/hip_runtime.h>
#include <cstdio>
#include <cstdint>
__device__ __forceinline__ int lane_id_v() { int l; asm volatile("v_mbcnt_lo_u32_b32 %0, -1, 0\n\tv_mbcnt_hi_u32_b32 %0, -1, %0" : "=v"(l)); return l; }
namespace pg8 {
#define PG8_LAS __attribute__((address_space(3)))
typedef unsigned short bf16_t;
typedef short bf16x8 __attribute__((ext_vector_type(8)));
typedef float f32x4 __attribute__((ext_vector_type(4)));
typedef unsigned u32x4 __attribute__((ext_vector_type(4)));
constexpr int BM = 256, BK = 64, HALF = 128, HTB = HALF * BK * 2  , STAGE_BYTES = 8 * HTB, NXCD = 8, WGM = 8;

__host__ __device__ __forceinline__ int lds_byte(int r, int c) { const int st = (r >> 4) * 2 + (c >> 5), rr = r & 15, cc = c & 31, ob = rr * 64 + cc * 2; return st * 1024 + (ob ^ (((ob >> 9) & 1) << 5)); }
__host__ __device__ __forceinline__ void stage_rc(int b, int& R, int& C) { const int st = b / 1024, sb = b % 1024, swz = sb ^ (((sb >> 9) & 1) << 5); R = (st >> 1) * 16 + swz / 64; C = (st & 1) * 32 + (swz % 64) / 2; }
__host__ __device__ __forceinline__ int perm32(int rho) { const int n = rho >> 4, i = rho & 15; return 8 * (i >> 2) + 4 * n + (i & 3); }

struct Unit { int pm, pn; };
struct Gemm { const bf16_t* A; const bf16_t* Bt; int M, N, K; };

struct StaticOrder {
    int nM, nN, nwg, G, c;
    __host__ __device__ void init(int M, int N, int G_, int c_) { nM = M / BM; nN = N / BM; nwg = nM * nN; G = G_; c = c_; }
    __host__ __device__ bool next(int i, Unit& u) const {
        const long L = (long)i * G + c; if (L >= nwg) return false;
        int wgid = (int)L; { const int q = nwg / NXCD, r = nwg % NXCD, xcd = wgid % NXCD, off = wgid / NXCD; wgid = (xcd < r ? xcd * (q + 1) : r * (q + 1) + (xcd - r) * q) + off; }
        const int nig = WGM * nN, gid = wgid / nig, fm = gid * WGM, gsz = (nM - fm) < WGM ? (nM - fm) : WGM;
        u.pm = fm + ((wgid % nig) % gsz); u.pn = (wgid % nig) / gsz; return true;
    }
    __device__ __forceinline__ void a_ready(const Unit&) const {}
    __device__ __forceinline__ void done(const Unit&) const {}
};

__device__ __forceinline__ unsigned cvt_pk_bf16(float lo, float hi) { unsigned r; asm volatile("v_cvt_pk_bf16_f32 %0, %1, %2" : "=v"(r) : "v"(lo), "v"(hi)); return r; }
typedef float f32x2 __attribute__((ext_vector_type(2)));
__device__ __forceinline__ f32x2 gelu_pk(f32x2 v) {
    const f32x2 av = __builtin_elementwise_abs(v), d = av * 0.2316418882f + 1.0f;
    f32x2 t; t.x = __builtin_amdgcn_rcpf(d.x); t.y = __builtin_amdgcn_rcpf(d.y);
    f32x2 q = t * 0.5307027145f + (-0.7265760135f); q = q * t + 0.7107068705f; q = q * t + (-0.142248368f); q = q * t + 0.127414796f; q = q * t;
    const f32x2 s = (v * v) * (-0.72134752044f);
    f32x2 e; e.x = __builtin_amdgcn_exp2f(s.x); e.y = __builtin_amdgcn_exp2f(s.y);
    const f32x2 m = v * (q * e), r = v - m;
    f32x2 o; o.x = v.x < 0.f ? m.x : r.x; o.y = v.y < 0.f ? m.y : r.y; return o;
}

template <int ACT  > struct EpiBf16 {
    static constexpr bool PERM = true, AFTER_DRAIN = false; static_assert(ACT == 0 || ACT == 1, "EpiBf16: ACT is 0 (none) or 1 (gelu_pk)");
    bf16_t* O; int ldc; const float* bias; int split_cols; size_t split_stride; float scale0;
    __device__ __forceinline__ void operator()(const f32x4 (&acc)[2][2][4][2], const Unit& u, int wr, int wc, int fr, int fq) const {
        const int row0 = u.pm * BM + wr * 64 + fr; int colt = u.pn * BM; bf16_t* base = O;
        float sc = 1.f; if (split_cols) { const int t = colt / split_cols; base += (size_t)t * split_stride; colt -= t * split_cols; if (t == 0) sc = scale0; }
        const int col0 = colt + wc * 32 + 8 * fq, bcol0 = u.pn * BM + wc * 32 + 8 * fq;
        f32x4 bv[2][2];
#pragma unroll
        for (int bj = 0; bj < 2; ++bj)
#pragma unroll
            for (int n = 0; n < 2; ++n) bv[bj][n] = bias ? *(const f32x4*)(bias + bcol0 + bj * HALF + 4 * n) : (f32x4){0.f, 0.f, 0.f, 0.f};
#pragma unroll
        for (int ai = 0; ai < 2; ++ai)
#pragma unroll
            for (int m = 0; m < 4; ++m) { bf16_t* rowp = base + (size_t)(row0 + ai * HALF + m * 16) * ldc + col0;
#pragma unroll
                for (int bj = 0; bj < 2; ++bj) { f32x4 v0 = acc[ai][bj][m][0] + bv[bj][0], v1 = acc[ai][bj][m][1] + bv[bj][1];
                    if (ACT == 1) { f32x2 a = gelu_pk((f32x2){v0[0], v0[1]}), b = gelu_pk((f32x2){v0[2], v0[3]}), c = gelu_pk((f32x2){v1[0], v1[1]}), d = gelu_pk((f32x2){v1[2], v1[3]});
                        v0 = (f32x4){a.x, a.y, b.x, b.y}; v1 = (f32x4){c.x, c.y, d.x, d.y}; }
                    v0 = v0 * sc; v1 = v1 * sc; u32x4 w; w.x = cvt_pk_bf16(v0[0], v0[1]); w.y = cvt_pk_bf16(v0[2], v0[3]); w.z = cvt_pk_bf16(v1[0], v1[1]); w.w = cvt_pk_bf16(v1[2], v1[3]);
                    *(u32x4*)(rowp + bj * HALF) = w; } }
    }
};
template <class Epi, class Sched, bool ALIGN_EPI = false, bool SP2 = false, bool HALO = false>
__device__ __forceinline__ void gemm_phase(PG8_LAS unsigned char* lds, const Gemm g, const Sched& S, const Epi& E, const int wave0) {
    int tid_o = wave0 * 64 + lane_id_v(); asm volatile("" : "+v"(tid_o));
    const int tid = tid_o, wid = __builtin_amdgcn_readfirstlane(tid >> 6), lane = tid & 63, wr = wid >> 2, wc = wid & 3, fr = lane & 15, fq = lane >> 4;
    const int K = g.K, nt = K / BK;
    unsigned voffA[2], voffB[2];
#pragma unroll
    for (int i = 0; i < 2; ++i) { int R, C; stage_rc(tid * 16 + i * 8192, R, C); const int Rb = Epi::PERM ? ((R & ~31) + perm32(R & 31)) : R;
        voffA[i] = HALO ? (unsigned)(((R & 63) + 62 * (R >> 6)) * K + C) * 2u : (unsigned)(R * K + C) * 2u; voffB[i] = (unsigned)(Rb * K + C) * 2u; }
    const size_t kstep = (size_t)(BK * 2);
    const size_t hstep = (size_t)HALF * K * 2;
    const size_t tstep = 2 * hstep;
    const size_t hstepA = HALO ? (size_t)124 * K * 2 : hstep, tstepA = 2 * hstepA;
    const unsigned ldsw = (unsigned)wid * 1024u;
    const int aoff = lds_byte(wr * 64 + fr, fq * 8), boff = lds_byte(wc * 32 + fr, fq * 8);
#define PG8_SA(b, h) (((b) * 2 + (h)) * HTB)
#define PG8_SB(b, h) ((4 + (b) * 2 + (h)) * HTB)
#define PG8_STAGE(bufoff, gbase, voff) do { _Pragma("unroll") for (int _i = 0; _i < 2; ++_i) \
        __builtin_amdgcn_global_load_lds((const unsigned*)((const char*)(gbase) + (voff)[_i]), (PG8_LAS unsigned*)(lds + (bufoff) + ldsw + _i * 8192), 16, 0, 0); } while (0)
#define PG8_LDA(dst, b, h) do { _Pragma("unroll") for (int m = 0; m < 4; ++m) _Pragma("unroll") for (int k = 0; k < 2; ++k) dst[m][k] = *(const PG8_LAS bf16x8*)(lds + PG8_SA(b, h) + aoff + m * 2048 + k * 1024); } while (0)
#define PG8_LDB(dst, b, h) do { _Pragma("unroll") for (int n = 0; n < 2; ++n) _Pragma("unroll") for (int k = 0; k < 2; ++k) dst[n][k] = *(const PG8_LAS bf16x8*)(lds + PG8_SB(b, h) + boff + n * 2048 + k * 1024); } while (0)
#define PG8_MMA(ai, bj, At, Bt) do { __builtin_amdgcn_s_setprio(1); _Pragma("unroll") for (int m = 0; m < 4; ++m) _Pragma("unroll") for (int n = 0; n < 2; ++n) _Pragma("unroll") for (int k = 0; k < 2; ++k) \
        acc[ai][bj][m][n] = __builtin_amdgcn_mfma_f32_16x16x32_bf16(Bt[n][k], At[m][k], acc[ai][bj][m][n], 0, 0, 0); __builtin_amdgcn_s_setprio(0); } while (0)
#define PG8_WAIT_V(n) asm volatile("s_waitcnt vmcnt(" #n ")" ::: "memory")
#define PG8_WAIT_L(n) asm volatile("s_waitcnt lgkmcnt(" #n ")" ::: "memory")
#define PG8_BAR __builtin_amdgcn_s_barrier()
#define PG8_SCHED __builtin_amdgcn_sched_barrier(0)
    Unit cur, nxt; int ui = 0;
    if (!S.next(0, cur)) return;
    f32x4 acc[2][2][4][2];
#pragma unroll
    for (int a = 0; a < 2; ++a)
#pragma unroll
        for (int b = 0; b < 2; ++b)
#pragma unroll
            for (int m = 0; m < 4; ++m)
#pragma unroll
                for (int n = 0; n < 2; ++n) acc[a][b][m][n] = (f32x4){0.f, 0.f, 0.f, 0.f};
    bf16x8 At[4][2], B0[2][2], B1[2][2];
    const char* cA = (const char*)g.A + (size_t)cur.pm * tstepA; const char* cB = (const char*)g.Bt + (size_t)cur.pn * tstep;
    S.a_ready(cur);
    if constexpr (SP2) {
        PG8_STAGE(PG8_SB(0, 0), cB, voffB); PG8_STAGE(PG8_SB(0, 1), cB + hstep, voffB); PG8_STAGE(PG8_SA(0, 0), cA, voffA); PG8_STAGE(PG8_SA(0, 1), cA + hstepA, voffA);
        if (wr == 1) PG8_BAR;
        PG8_WAIT_V(2); PG8_BAR;
        PG8_STAGE(PG8_SB(1, 0), cB + kstep, voffB); PG8_STAGE(PG8_SA(1, 0), cA + kstep, voffA); PG8_STAGE(PG8_SB(1, 1), cB + hstep + kstep, voffB);
        PG8_WAIT_V(6); PG8_BAR;
    } else {
        PG8_STAGE(PG8_SB(0, 0), cB, voffB); PG8_STAGE(PG8_SA(0, 0), cA, voffA); PG8_STAGE(PG8_SB(0, 1), cB + hstep, voffB); PG8_STAGE(PG8_SA(0, 1), cA + hstepA, voffA);
        if (wr == 1) PG8_BAR;
        PG8_WAIT_V(4); PG8_BAR;
        PG8_STAGE(PG8_SB(1, 0), cB + kstep, voffB); PG8_STAGE(PG8_SA(1, 0), cA + kstep, voffA); PG8_STAGE(PG8_SB(1, 1), cB + hstep + kstep, voffB);
        PG8_WAIT_V(6); PG8_BAR;
    }
    for (;;) {
        const bool has_next = S.next(ui + 1, nxt);
        const char* nA = has_next ? (const char*)g.A + (size_t)nxt.pm * tstepA : cA; const char* nB = has_next ? (const char*)g.Bt + (size_t)nxt.pn * tstep : cB;
        for (int t = 0; t < nt; t += 2) {
            const bool last = (t == nt - 2);
            const char* a1 = cA + (size_t)(t + 1) * kstep;
            const char* a2 = last ? nA : cA + (size_t)(t + 2) * kstep; const char* b2 = last ? nB : cB + (size_t)(t + 2) * kstep;
            const char* a3 = a2 + kstep; const char* b3 = b2 + kstep;
            if (last && has_next) S.a_ready(nxt);
            if constexpr (SP2) {
            PG8_LDB(B0, 0, 0); PG8_LDB(B1, 0, 1); PG8_SCHED; PG8_LDA(At, 0, 0); PG8_STAGE(PG8_SA(1, 1), a1 + hstepA, voffA);
            PG8_WAIT_V(8); PG8_WAIT_L(0); PG8_BAR; PG8_MMA(0, 0, At, B0); PG8_MMA(0, 1, At, B1); PG8_BAR; PG8_SCHED;
            PG8_LDA(At, 0, 1); PG8_STAGE(PG8_SB(0, 0), b2, voffB); PG8_STAGE(PG8_SB(0, 1), b2 + hstep, voffB); PG8_STAGE(PG8_SA(0, 0), a2, voffA);
            PG8_WAIT_V(8); PG8_WAIT_L(0); PG8_BAR; PG8_MMA(1, 0, At, B0); PG8_MMA(1, 1, At, B1); PG8_BAR; PG8_SCHED;
            PG8_LDB(B0, 1, 0); PG8_LDB(B1, 1, 1); PG8_SCHED; PG8_LDA(At, 1, 0); PG8_STAGE(PG8_SA(0, 1), a2 + hstepA, voffA);
            PG8_WAIT_V(8); PG8_WAIT_L(0); PG8_BAR; PG8_MMA(0, 0, At, B0); PG8_MMA(0, 1, At, B1); PG8_BAR; PG8_SCHED;
            PG8_LDA(At, 1, 1); PG8_STAGE(PG8_SB(1, 0), b3, voffB); PG8_STAGE(PG8_SB(1, 1), b3 + hstep, voffB); PG8_STAGE(PG8_SA(1, 0), a3, voffA);
            PG8_WAIT_V(8); PG8_WAIT_L(0); PG8_BAR; PG8_MMA(1, 0, At, B0); PG8_MMA(1, 1, At, B1); PG8_BAR; PG8_SCHED;
            } else {
            PG8_LDB(B0, 0, 0); PG8_SCHED; PG8_LDA(At, 0, 0); PG8_STAGE(PG8_SA(1, 1), a1 + hstepA, voffA);
            PG8_WAIT_L(8); PG8_BAR; PG8_WAIT_L(0); PG8_MMA(0, 0, At, B0); PG8_BAR; PG8_SCHED;
            PG8_LDB(B1, 0, 1); PG8_STAGE(PG8_SB(0, 0), b2, voffB);
            PG8_BAR; PG8_WAIT_L(0); PG8_MMA(0, 1, At, B1); PG8_BAR;
            PG8_LDA(At, 0, 1); PG8_STAGE(PG8_SA(0, 0), a2, voffA);
            PG8_BAR; PG8_WAIT_L(0); PG8_MMA(1, 0, At, B0); PG8_BAR; PG8_SCHED;
            PG8_STAGE(PG8_SB(0, 1), b2 + hstep, voffB);
            PG8_WAIT_V(6); PG8_BAR; PG8_MMA(1, 1, At, B1); PG8_BAR;
            PG8_LDB(B0, 1, 0); PG8_SCHED; PG8_LDA(At, 1, 0); PG8_STAGE(PG8_SA(0, 1), a2 + hstepA, voffA);
            PG8_WAIT_L(8); PG8_BAR; PG8_WAIT_L(0); PG8_MMA(0, 0, At, B0); PG8_BAR; PG8_SCHED;
            PG8_LDB(B1, 1, 1); PG8_STAGE(PG8_SB(1, 0), b3, voffB);
            PG8_BAR; PG8_WAIT_L(0); PG8_MMA(0, 1, At, B1); PG8_BAR;
            PG8_LDA(At, 1, 1); PG8_STAGE(PG8_SA(1, 0), a3, voffA);
            PG8_BAR; PG8_WAIT_L(0); PG8_MMA(1, 0, At, B0); PG8_BAR; PG8_SCHED;
            PG8_STAGE(PG8_SB(1, 1), b3 + hstep, voffB);
            PG8_WAIT_V(6); PG8_BAR; PG8_MMA(1, 1, At, B1); PG8_BAR;
            }
        }
        if constexpr (ALIGN_EPI) { if (wr == 0) PG8_BAR; }
        if constexpr (!Epi::AFTER_DRAIN) { E(acc, cur, wr, wc, fr, fq); S.done(cur); }
        if (!has_next) break;
#pragma unroll
        for (int a = 0; a < 2; ++a)
#pragma unroll
            for (int b = 0; b < 2; ++b)
#pragma unroll
                for (int m = 0; m < 4; ++m)
#pragma unroll
                    for (int n = 0; n < 2; ++n) acc[a][b][m][n] = (f32x4){0.f, 0.f, 0.f, 0.f};
        cur = nxt; cA = nA; cB = nB; ++ui;
        if constexpr (ALIGN_EPI) { if (wr == 1) PG8_BAR; }
    }
    PG8_WAIT_V(0);
    if constexpr (!ALIGN_EPI) { if (wr == 0) PG8_BAR; }
    PG8_BAR;
    if constexpr (Epi::AFTER_DRAIN) { E.fused(acc, cur, wr, wc, fr, fq, lds, wid, lane); S.done(cur); }
#undef PG8_SA
#undef PG8_SB
#undef PG8_STAGE
#undef PG8_LDA
#undef PG8_LDB
#undef PG8_MMA
#undef PG8_WAIT_V
#undef PG8_WAIT_L
#undef PG8_BAR
#undef PG8_SCHED
}
}

#ifndef PG8_SP2
#define PG8_SP2 true
#endif
#ifndef PG8_ALIGN
#define PG8_ALIGN true
#endif
#include <hip/hip_bf16.h>
#include <cmath>
namespace attn_body {
using bf16=__hip_bfloat16;
using bf16x8=__attribute__((ext_vector_type(8)))short;
using s16x4=__attribute__((ext_vector_type(4)))short;
using f32x16=__attribute__((ext_vector_type(16)))float;
using u32x4=__attribute__((ext_vector_type(4)))unsigned;
constexpr int D=64;
constexpr int NW=8,QBLK=32,QB=QBLK*NW,KVBLK=64;
constexpr int ATTN_UNIT_ROWS=QB;
__device__ __forceinline__ int crow(int r,int hi){return (r&3)+8*(r>>2)+4*hi;}
#define SBAR() __builtin_amdgcn_sched_barrier(0)
__device__ __forceinline__ void cmask(f32x16&p0,f32x16&p1,int jb,int qrel,int hi){
  const float NEG=-INFINITY; int kb=64*jb+4*hi;
  #pragma unroll
  for(int r=0;r<16;++r){int kv=kb+(r&3)+8*(r>>2); if(kv>qrel)p0[r]=NEG; if(kv+32>qrel)p1[r]=NEG;}
}

constexpr int NSLOT=3, SLOTB=8192;
constexpr int LDS_K=0, LDS_V=NSLOT*SLOTB, LDS_WS=2*NSLOT*SLOTB, LDS_OST=LDS_WS+NW*64*4, LDS_BYTES=LDS_OST+NW*4096;
constexpr float C2=0.125f*1.4426950408889634f;
__device__ __forceinline__ void glds16(const void*gsrc,unsigned lds_dst){unsigned keep;
  asm volatile("s_mov_b32 %0, m0\n\ts_mov_b32 m0, %2\n\ts_nop 0\n\tglobal_load_lds_dwordx4 %1, off\n\ts_mov_b32 m0, %0":"=&s"(keep):"v"(gsrc),"s"(lds_dst):"memory");}
__device__ __forceinline__ float max3f(float a,float b,float c){float r;asm("v_max3_f32 %0, %1, %2, %3":"=v"(r):"v"(a),"v"(b),"v"(c));return r;}
__device__ __forceinline__ float max2f(float a,float b){float r;asm("v_max_f32_e32 %0, %1, %2":"=v"(r):"v"(a),"v"(b));return r;}
__device__ __forceinline__ float fadd_s(float a,float b){float r;asm("v_add_f32_e32 %0, %1, %2":"=v"(r):"v"(a),"v"(b));return r;}
__device__ __forceinline__ float fsub_s(float a,float b){float r;asm("v_sub_f32_e32 %0, %1, %2":"=v"(r):"v"(a),"v"(b));return r;}
typedef float f32x2_t __attribute__((ext_vector_type(2))); typedef __bf16 bf16x2_t __attribute__((ext_vector_type(2)));
__device__ __forceinline__ unsigned cvtpk_s(float lo,float hi){f32x2_t v={lo,hi};bf16x2_t b=__builtin_convertvector(v,bf16x2_t);return __builtin_bit_cast(unsigned,b);}
#define WAIT_BAR(N) asm volatile("s_waitcnt vmcnt(" #N ") lgkmcnt(0)\n\ts_barrier":::"memory")

__device__ __forceinline__ void qkt(f32x16&p0,f32x16&p1,const char*Kslot,const bf16x8*qr,const f32x16&negm,int r32,int hi){
  const char*kb=Kslot+hi*1024+r32*16;
  #pragma unroll
  for(int d0=0;d0<4;++d0){
    const bf16x8 b0=*reinterpret_cast<const bf16x8*>(kb+d0*2048);
    const bf16x8 b1=*reinterpret_cast<const bf16x8*>(kb+d0*2048+512);
    if(d0==0){p0=__builtin_amdgcn_mfma_f32_32x32x16_bf16(b0,qr[0],negm,0,0,0);p1=__builtin_amdgcn_mfma_f32_32x32x16_bf16(b1,qr[0],negm,0,0,0);}
    else{p0=__builtin_amdgcn_mfma_f32_32x32x16_bf16(b0,qr[d0],p0,0,0,0);p1=__builtin_amdgcn_mfma_f32_32x32x16_bf16(b1,qr[d0],p1,0,0,0);}}
}
typedef __attribute__((address_space(3))) const char* lds_cptr;
typedef short v4i16_t __attribute__((ext_vector_type(4)));
__device__ __forceinline__ void kload8(bf16x8*kf,lds_cptr kp){
  kf[0]=*(const __attribute__((address_space(3))) bf16x8*)(kp);      kf[1]=*(const __attribute__((address_space(3))) bf16x8*)(kp+512);
  kf[2]=*(const __attribute__((address_space(3))) bf16x8*)(kp+2048); kf[3]=*(const __attribute__((address_space(3))) bf16x8*)(kp+2560);
  kf[4]=*(const __attribute__((address_space(3))) bf16x8*)(kp+4096); kf[5]=*(const __attribute__((address_space(3))) bf16x8*)(kp+4608);
  kf[6]=*(const __attribute__((address_space(3))) bf16x8*)(kp+6144); kf[7]=*(const __attribute__((address_space(3))) bf16x8*)(kp+6656);
}
__device__ __forceinline__ void kload2(bf16x8*kf,lds_cptr kp,int j){ kf[2*j]=*(const __attribute__((address_space(3))) bf16x8*)(kp+j*2048); kf[2*j+1]=*(const __attribute__((address_space(3))) bf16x8*)(kp+j*2048+512); }
__device__ __forceinline__ s16x4 vtr(lds_cptr p){ return __builtin_bit_cast(s16x4,__builtin_amdgcn_ds_read_tr16_b64_v4i16((__attribute__((address_space(3))) v4i16_t*)p)); }
__device__ __forceinline__ float rowmax(const f32x16&p0,const f32x16&p1){
  float a=max3f(p0[0],p0[1],p1[0]),b=max3f(p0[2],p0[3],p1[1]);a=max3f(a,p1[2],p1[3]);
  #pragma unroll
  for(int r=4;r<16;r+=4){a=max3f(a,p0[r],p0[r+1]);b=max3f(b,p0[r+2],p0[r+3]);a=max3f(a,p1[r],p1[r+1]);b=max3f(b,p1[r+2],p1[r+3]);}
  const float m=max2f(a,b);
  auto rr=__builtin_amdgcn_permlane32_swap(__float_as_uint(m),__float_as_uint(m),false,false);
  return max2f(__uint_as_float(rr[0]),__uint_as_float(rr[1]));
}
__device__ __forceinline__ void pv(f32x16*o,int vb,bf16x8 pa0,bf16x8 pa1,bf16x8 pa2,bf16x8 pa3){
  #pragma unroll
  for(int d0=0;d0<2;++d0){s16x4 lo[4],hi[4];
    #pragma unroll
    for(int ks=0;ks<4;++ks){
      asm volatile("ds_read_b64_tr_b16 %0,%1 offset:%c2":"=&v"(lo[ks]):"v"(vb),"i"(d0*4096+ks*1024):"memory");
      asm volatile("ds_read_b64_tr_b16 %0,%1 offset:%c2":"=&v"(hi[ks]):"v"(vb),"i"(d0*4096+ks*1024+512):"memory");}
    asm volatile("s_waitcnt lgkmcnt(0)":::"memory");SBAR();
    #define PK(k) (bf16x8){lo[k][0],lo[k][1],lo[k][2],lo[k][3],hi[k][0],hi[k][1],hi[k][2],hi[k][3]}
    o[d0]=__builtin_amdgcn_mfma_f32_32x32x16_bf16(pa0,PK(0),o[d0],0,0,0);
    o[d0]=__builtin_amdgcn_mfma_f32_32x32x16_bf16(pa1,PK(1),o[d0],0,0,0);
    o[d0]=__builtin_amdgcn_mfma_f32_32x32x16_bf16(pa2,PK(2),o[d0],0,0,0);
    o[d0]=__builtin_amdgcn_mfma_f32_32x32x16_bf16(pa3,PK(3),o[d0],0,0,0);
    #undef PK
  }
}

#ifndef ATTN_STORE16
#define ATTN_STORE16(p,v) (*(u32x4*)(p)=(v))
#endif
template<int THRL,bool DV128,int PQ,int PK,int PV,int PO> __device__ __forceinline__ void attn_unit(const bf16*Qb,const bf16*__restrict__ Kb,const bf16*__restrict__ Vb,bf16*Ob,const int NT,char*shm,const int wave0){
  int tid_o=wave0*64+lane_id_v(); asm volatile("":"+v"(tid_o)); const int tid=tid_o,lane=tid&63,r32=lane&31,hi=lane>>5; const int wid=__builtin_amdgcn_readfirstlane(tid>>6);
  const bf16*Qw=Qb+(long)(wid*QBLK)*PQ;
  const bf16*Kh=Kb,*Vh=Vb;
  const unsigned lds0=(unsigned)(uintptr_t)shm;
  constexpr int VS=DV128?2:1, L_WS=LDS_V+NSLOT*SLOTB*VS, L_OST=L_WS+NW*64*4;
  float*wsf=(float*)(shm+L_WS)+wid*64;
  const bf16*ksrc=Kh+(long)lane*PK+wid*8;
  const bf16*vsrc=Vh+(long)(16*(wid&3)+(lane>>2))*PV+(wid>>2)*32+(lane&3)*8;
  const unsigned kdst=lds0+LDS_K+wid*1024, vdst=lds0+LDS_V+wid*1024;
  #define DMA_K(t,slot) glds16(ksrc+(long)(t)*KVBLK*PK,(unsigned)__builtin_amdgcn_readfirstlane(kdst+(slot)))
  #define DMA_V(t,slot) do{ glds16(vsrc+(long)(t)*KVBLK*PV,(unsigned)__builtin_amdgcn_readfirstlane(vdst+VS*(slot))); if constexpr(DV128){ glds16(vsrc+64+(long)(t)*KVBLK*PV,(unsigned)__builtin_amdgcn_readfirstlane(vdst+VS*(slot)+8192)); } }while(0)
  const char*Kbase=shm+LDS_K; bf16x8 kf[8];
  const lds_cptr shm3=(lds_cptr)shm; const lds_cptr kp0=shm3+LDS_K+hi*1024+r32*16; const lds_cptr vp0=shm3+LDS_V+((lane>>4)&1)*32+(lane&3)*8+(4*hi+((lane&15)>>2))*64;
  DMA_K(0,0);DMA_V(0,0);DMA_K(1,SLOTB);
  bf16x8 qr[4];
  #pragma unroll
  for(int d0=0;d0<4;++d0)qr[d0]=*reinterpret_cast<const bf16x8*>(&Qw[(long)r32*PQ+d0*16+hi*8]);
  float mhat=0.f,l_reg=0.f;f32x16 o[4];o[0]=f32x16{};o[1]=f32x16{};o[2]=f32x16{};o[3]=f32x16{};f32x16 negm=f32x16{};asm volatile("":"+v"(negm));
  #define CMASK(P0,P1,t) do{}while(0)
  bool resc=false;
  #define START(P0,P1) do{ const float rm=rowmax(P0,P1); resc=false; \
    { const float dl=rm; mhat=fadd_s(mhat,dl); \
      _Pragma("unroll") for(int r=0;r<16;++r){P0[r]=fsub_s(P0[r],dl);P1[r]=fsub_s(P1[r],dl);} \
      _Pragma("unroll") for(int r=0;r<16;++r)negm[r]=-mhat; asm volatile("":"+v"(negm)); } \
    _Pragma("unroll") for(int r=0;r<16;++r)P0[r]=__builtin_amdgcn_exp2f(P0[r]); }while(0)
  #define RESC() do{ if(resc){ asm volatile("s_waitcnt lgkmcnt(0)":::"memory"); \
      _Pragma("unroll") for(int d_=0;d_<2*VS;++d_) _Pragma("unroll") for(int r=0;r<16;++r)o[d_][r]*=wsf[crow(r,hi)]; } }while(0)
  f32x16 pA0,pA1,pB0,pB1;
  int sl_prev=0,sl_cur=0,sl_next=SLOTB;
  #define ROT() do{sl_prev=sl_cur;sl_cur=sl_next;sl_next=(sl_next==(NSLOT-1)*SLOTB)?0:sl_next+SLOTB;}while(0)
  DMA_K(2,2*SLOTB);
  WAIT_BAR(3);
  qkt(pA0,pA1,Kbase,qr,negm,r32,hi);asm volatile("s_nop 15\n\ts_nop 7":"+v"(pA0),"+v"(pA1));CMASK(pA0,pA1,0);
  START(pA0,pA1);
  _Pragma("unroll") for(int r=0;r<16;++r)pA1[r]=__builtin_amdgcn_exp2f(pA1[r]);
  WAIT_BAR(0);
  DMA_K(3,0);DMA_V(1,SLOTB);
  ROT();
  kload8(kf,kp0+sl_cur);
  #define WB2() do{ if constexpr(DV128){WAIT_BAR(3);}else{WAIT_BAR(2);} }while(0)
  #define WB1() do{ if constexpr(DV128){WAIT_BAR(2);}else{WAIT_BAR(1);} }while(0)
  WB2();
  s16x4 vlo[8],vhi[8]; u32x4 pw0,pw1,pw2,pw3;
  #define PKW(P,B) cvtpk_s(P[B],P[B+1])
  #define PAF(k) __builtin_bit_cast(bf16x8,pw##k)
  #define VFR(i) (bf16x8){vlo[i][0],vlo[i][1],vlo[i][2],vlo[i][3],vhi[i][0],vhi[i][1],vhi[i][2],vhi[i][3]}
  #define PIN(x) asm volatile("":"+v"(x))
  #define MX3(a,b,c) __builtin_fmaxf(__builtin_fmaxf((a),(b)),(c))
  #define GAPA(MF,A0,A1,A2,A3,W0,W1,PW) do{ MF; sacc+=A0; sacc+=A1; sacc+=A2; sacc+=A3; PIN(sacc); W0; W1; PIN(PW); SBAR(); }while(0)
  #define EX(v) __builtin_amdgcn_exp2f(v)
  #define GAPC(MF,X,B) do{ MF; X[B]=EX(X[B]); X[B+1]=EX(X[B+1]); PIN(X); SBAR(); }while(0)
  #define GAPB(MF,X,B) do{ MF; X[B]=EX(X[B]); X[B+1]=EX(X[B+1]); X[B+2]=EX(X[B+2]); X[B+3]=EX(X[B+3]); PIN(X); SBAR(); }while(0)
  #define VRD(i) do{ vlo[i]=vtr(vp_+(((i)>>2)*4096+((i)&3)*1024)); vhi[i]=vtr(vp_+(((i)>>2)*4096+((i)&3)*1024+512)); }while(0)
  #define KRD(G,j) do{ if(G){ kload2(kf,kp0+sl_next,j); SBAR(); } }while(0)
  #define STEP(C0,C1,P0,P1,t,GK,GV,GL) do{ SBAR(); \
    const lds_cptr vp_=vp0+VS*sl_prev; \
    VRD(0); SBAR(); float sacc=(P0[0]+P0[1]); \
    GAPA(C0=__builtin_amdgcn_mfma_f32_32x32x16_bf16(kf[0],qr[0],negm,0,0,0), P0[2],P0[3],P0[4],P0[5],     pw0[0]=PKW(P0,0), pw0[1]=PKW(P0,2), pw0); \
    VRD(4); SBAR(); GAPA(C1=__builtin_amdgcn_mfma_f32_32x32x16_bf16(kf[1],qr[0],negm,0,0,0), P0[6],P0[7],P0[8],P0[9],     pw0[2]=PKW(P0,4), pw0[3]=PKW(P0,6), pw0); \
    VRD(1); SBAR(); GAPA(C0=__builtin_amdgcn_mfma_f32_32x32x16_bf16(kf[2],qr[1],C0,0,0,0),   P0[10],P0[11],P0[12],P0[13], pw1[0]=PKW(P0,8), pw1[1]=PKW(P0,10), pw1); \
    VRD(5); SBAR(); GAPA(C1=__builtin_amdgcn_mfma_f32_32x32x16_bf16(kf[3],qr[1],C1,0,0,0),   P0[14],P0[15],P1[0],P1[1],   pw1[2]=PKW(P0,12),pw1[3]=PKW(P0,14), pw1); \
    VRD(2); SBAR(); GAPA(C0=__builtin_amdgcn_mfma_f32_32x32x16_bf16(kf[4],qr[2],C0,0,0,0),   P1[2],P1[3],P1[4],P1[5],     pw2[0]=PKW(P1,0), pw2[1]=PKW(P1,2), pw2); \
    VRD(6); SBAR(); GAPA(C1=__builtin_amdgcn_mfma_f32_32x32x16_bf16(kf[5],qr[2],C1,0,0,0),   P1[6],P1[7],P1[8],P1[9],     pw2[2]=PKW(P1,4), pw2[3]=PKW(P1,6), pw2); \
    VRD(3); SBAR(); GAPA(C0=__builtin_amdgcn_mfma_f32_32x32x16_bf16(kf[6],qr[3],C0,0,0,0),   P1[10],P1[11],P1[12],P1[13], pw3[0]=PKW(P1,8), pw3[1]=PKW(P1,10), pw3); \
    VRD(7); SBAR(); GAPA(C1=__builtin_amdgcn_mfma_f32_32x32x16_bf16(kf[7],qr[3],C1,0,0,0),   P1[14],P1[15],0.f,0.f,       pw3[2]=PKW(P1,12),pw3[3]=PKW(P1,14), pw3); \
    l_reg+=sacc; \
    if(GK){DMA_K((t)+3,sl_cur);} if(GV){DMA_V((t)+1,sl_next);} \
    CMASK(C0,C1,t); \
    { float a=MX3(C0[0],C0[1],C1[0]),b=MX3(C0[2],C0[3],C1[1]); a=MX3(a,C1[2],C1[3]); \
      _Pragma("unroll") for(int r=4;r<16;r+=4){a=MX3(a,C0[r],C0[r+1]);b=MX3(b,C0[r+2],C0[r+3]);a=MX3(a,C1[r],C1[r+1]);b=MX3(b,C1[r+2],C1[r+3]);} \
      float rm=__builtin_fmaxf(a,b); { auto rr=__builtin_amdgcn_permlane32_swap(__float_as_uint(rm),__float_as_uint(rm),false,false); rm=__builtin_fmaxf(__uint_as_float(rr[0]),__uint_as_float(rr[1])); } \
      resc=false; \
      if(__builtin_expect(__any(rm>(float)THRL),0)){ const float dl=__builtin_fmaxf(rm,0.f); mhat+=dl; \
        _Pragma("unroll") for(int r=0;r<16;++r){C0[r]-=dl;C1[r]-=dl;} \
        _Pragma("unroll") for(int r=0;r<16;++r)negm[r]=-mhat; asm volatile("":"+v"(negm)); \
        const float f=__builtin_amdgcn_exp2f(-dl); l_reg*=f; if(hi==0)wsf[r32]=f; resc=true; } } \
    SBAR(); \
    GAPB(o[0]=__builtin_amdgcn_mfma_f32_32x32x16_bf16(PAF(0),VFR(0),o[0],0,0,0), C0,0); \
    GAPB(o[1]=__builtin_amdgcn_mfma_f32_32x32x16_bf16(PAF(0),VFR(4),o[1],0,0,0), C0,4); \
    KRD(GL,0); GAPB(o[0]=__builtin_amdgcn_mfma_f32_32x32x16_bf16(PAF(1),VFR(1),o[0],0,0,0), C0,8); \
    KRD(GL,1); GAPB(o[1]=__builtin_amdgcn_mfma_f32_32x32x16_bf16(PAF(1),VFR(5),o[1],0,0,0), C0,12); \
    KRD(GL,2); GAPB(o[0]=__builtin_amdgcn_mfma_f32_32x32x16_bf16(PAF(2),VFR(2),o[0],0,0,0), C1,0); \
    KRD(GL,3); GAPB(o[1]=__builtin_amdgcn_mfma_f32_32x32x16_bf16(PAF(2),VFR(6),o[1],0,0,0), C1,4); \
    GAPB(o[0]=__builtin_amdgcn_mfma_f32_32x32x16_bf16(PAF(3),VFR(3),o[0],0,0,0), C1,8); \
    GAPB(o[1]=__builtin_amdgcn_mfma_f32_32x32x16_bf16(PAF(3),VFR(7),o[1],0,0,0), C1,12); \
    }while(0)
  #define VRD2(i) do{ vlo[i]=vtr(vp_+(8192+((i)>>2)*4096+((i)&3)*1024)); vhi[i]=vtr(vp_+(8192+((i)>>2)*4096+((i)&3)*1024+512)); }while(0)
  #define STEP128(C0,C1,P0,P1,t,GK,GV,GL) do{ SBAR(); \
    const lds_cptr vp_=vp0+VS*sl_prev; \
    float sacc=(P0[0]+P0[1]); \
    GAPA(C0=__builtin_amdgcn_mfma_f32_32x32x16_bf16(kf[0],qr[0],negm,0,0,0), P0[2],P0[3],P0[4],P0[5],     pw0[0]=PKW(P0,0), pw0[1]=PKW(P0,2), pw0); \
    GAPA(C1=__builtin_amdgcn_mfma_f32_32x32x16_bf16(kf[1],qr[0],negm,0,0,0), P0[6],P0[7],P0[8],P0[9],     pw0[2]=PKW(P0,4), pw0[3]=PKW(P0,6), pw0); \
    GAPA(C0=__builtin_amdgcn_mfma_f32_32x32x16_bf16(kf[2],qr[1],C0,0,0,0),   P0[10],P0[11],P0[12],P0[13], pw1[0]=PKW(P0,8), pw1[1]=PKW(P0,10), pw1); \
    GAPA(C1=__builtin_amdgcn_mfma_f32_32x32x16_bf16(kf[3],qr[1],C1,0,0,0),   P0[14],P0[15],P1[0],P1[1],   pw1[2]=PKW(P0,12),pw1[3]=PKW(P0,14), pw1); \
    GAPA(C0=__builtin_amdgcn_mfma_f32_32x32x16_bf16(kf[4],qr[2],C0,0,0,0),   P1[2],P1[3],P1[4],P1[5],     pw2[0]=PKW(P1,0), pw2[1]=PKW(P1,2), pw2); \
    GAPA(C1=__builtin_amdgcn_mfma_f32_32x32x16_bf16(kf[5],qr[2],C1,0,0,0),   P1[6],P1[7],P1[8],P1[9],     pw2[2]=PKW(P1,4), pw2[3]=PKW(P1,6), pw2); \
    GAPA(C0=__builtin_amdgcn_mfma_f32_32x32x16_bf16(kf[6],qr[3],C0,0,0,0),   P1[10],P1[11],P1[12],P1[13], pw3[0]=PKW(P1,8), pw3[1]=PKW(P1,10), pw3); \
    GAPA(C1=__builtin_amdgcn_mfma_f32_32x32x16_bf16(kf[7],qr[3],C1,0,0,0),   P1[14],P1[15],0.f,0.f,       pw3[2]=PKW(P1,12),pw3[3]=PKW(P1,14), pw3); \
    l_reg+=sacc; \
    if(GK){DMA_K((t)+3,sl_cur);} if(GV){DMA_V((t)+1,sl_next);} \
    CMASK(C0,C1,t); \
    { float a=MX3(C0[0],C0[1],C1[0]),b=MX3(C0[2],C0[3],C1[1]); a=MX3(a,C1[2],C1[3]); \
      _Pragma("unroll") for(int r=4;r<16;r+=4){a=MX3(a,C0[r],C0[r+1]);b=MX3(b,C0[r+2],C0[r+3]);a=MX3(a,C1[r],C1[r+1]);b=MX3(b,C1[r+2],C1[r+3]);} \
      float rm=__builtin_fmaxf(a,b); { auto rr=__builtin_amdgcn_permlane32_swap(__float_as_uint(rm),__float_as_uint(rm),false,false); rm=__builtin_fmaxf(__uint_as_float(rr[0]),__uint_as_float(rr[1])); } \
      resc=false; \
      if(__builtin_expect(__any(rm>(float)THRL),0)){ const float dl=__builtin_fmaxf(rm,0.f); mhat+=dl; \
        _Pragma("unroll") for(int r=0;r<16;++r){C0[r]-=dl;C1[r]-=dl;} \
        _Pragma("unroll") for(int r=0;r<16;++r)negm[r]=-mhat; asm volatile("":"+v"(negm)); \
        const float f=__builtin_amdgcn_exp2f(-dl); l_reg*=f; if(hi==0)wsf[r32]=f; resc=true; } } \
    SBAR(); \
    VRD(0); VRD(4); VRD(1); VRD(5); SBAR(); \
    GAPC(o[0]=__builtin_amdgcn_mfma_f32_32x32x16_bf16(PAF(0),VFR(0),o[0],0,0,0), C0,0); VRD(2); SBAR(); \
    GAPC(o[1]=__builtin_amdgcn_mfma_f32_32x32x16_bf16(PAF(0),VFR(4),o[1],0,0,0), C0,2); VRD(6); SBAR(); \
    KRD(GL,0); GAPC(o[0]=__builtin_amdgcn_mfma_f32_32x32x16_bf16(PAF(1),VFR(1),o[0],0,0,0), C0,4); VRD(3); SBAR(); \
    KRD(GL,1); GAPC(o[1]=__builtin_amdgcn_mfma_f32_32x32x16_bf16(PAF(1),VFR(5),o[1],0,0,0), C0,6); VRD(7); SBAR(); \
    KRD(GL,2); GAPC(o[0]=__builtin_amdgcn_mfma_f32_32x32x16_bf16(PAF(2),VFR(2),o[0],0,0,0), C0,8); VRD2(0); SBAR(); \
    KRD(GL,3); GAPC(o[1]=__builtin_amdgcn_mfma_f32_32x32x16_bf16(PAF(2),VFR(6),o[1],0,0,0), C0,10); VRD2(4); SBAR(); \
    GAPC(o[0]=__builtin_amdgcn_mfma_f32_32x32x16_bf16(PAF(3),VFR(3),o[0],0,0,0), C0,12); VRD2(1); SBAR(); \
    GAPC(o[1]=__builtin_amdgcn_mfma_f32_32x32x16_bf16(PAF(3),VFR(7),o[1],0,0,0), C0,14); VRD2(5); SBAR(); \
    GAPC(o[2]=__builtin_amdgcn_mfma_f32_32x32x16_bf16(PAF(0),VFR(0),o[2],0,0,0), C1,0); VRD2(2); SBAR(); \
    GAPC(o[3]=__builtin_amdgcn_mfma_f32_32x32x16_bf16(PAF(0),VFR(4),o[3],0,0,0), C1,2); VRD2(6); SBAR(); \
    GAPC(o[2]=__builtin_amdgcn_mfma_f32_32x32x16_bf16(PAF(1),VFR(1),o[2],0,0,0), C1,4); VRD2(3); SBAR(); \
    GAPC(o[3]=__builtin_amdgcn_mfma_f32_32x32x16_bf16(PAF(1),VFR(5),o[3],0,0,0), C1,6); VRD2(7); SBAR(); \
    GAPC(o[2]=__builtin_amdgcn_mfma_f32_32x32x16_bf16(PAF(2),VFR(2),o[2],0,0,0), C1,8); \
    GAPC(o[3]=__builtin_amdgcn_mfma_f32_32x32x16_bf16(PAF(2),VFR(6),o[3],0,0,0), C1,10); \
    GAPC(o[2]=__builtin_amdgcn_mfma_f32_32x32x16_bf16(PAF(3),VFR(3),o[2],0,0,0), C1,12); \
    GAPC(o[3]=__builtin_amdgcn_mfma_f32_32x32x16_bf16(PAF(3),VFR(7),o[3],0,0,0), C1,14); \
    }while(0)
  #define STEPX(...) do{ if constexpr(DV128){ STEP128(__VA_ARGS__); } else { STEP(__VA_ARGS__); } }while(0)
  int t=1;
  #undef CMASK
  #define CMASK(P0,P1,t) do{}while(0)
  for(;t+5<NT;t+=2){
    STEPX(pB0,pB1,pA0,pA1,t,true,true,true);     WB2(); RESC(); ROT();
    STEPX(pA0,pA1,pB0,pB1,t+1,true,true,true);   WB2(); RESC(); ROT();
  }
  #undef CMASK
  #define CMASK(P0,P1,t) do{}while(0)
  #define ENDW(tt) do{ if((tt)+3<NT){WB2();} else if((tt)+2<NT){WB1();} else {WAIT_BAR(0);} }while(0)
  for(;t+1<NT;t+=2){
    STEPX(pB0,pB1,pA0,pA1,t,(t+3<NT),(t+1<NT),(t+1<NT));       ENDW(t);   RESC(); ROT();
    STEPX(pA0,pA1,pB0,pB1,t+1,(t+4<NT),(t+2<NT),(t+2<NT));     ENDW(t+1); RESC(); ROT();
  }
  STEPX(pB0,pB1,pA0,pA1,NT-1,false,false,false); RESC();
  { float sacc=pB0[0]+pB0[1]; _Pragma("unroll") for(int r=2;r<16;++r)sacc+=pB0[r]; _Pragma("unroll") for(int r=0;r<16;++r)sacc+=pB1[r]; l_reg+=sacc;
    pw0=(u32x4){PKW(pB0,0),PKW(pB0,2),PKW(pB0,4),PKW(pB0,6)};pw1=(u32x4){PKW(pB0,8),PKW(pB0,10),PKW(pB0,12),PKW(pB0,14)};pw2=(u32x4){PKW(pB1,0),PKW(pB1,2),PKW(pB1,4),PKW(pB1,6)};pw3=(u32x4){PKW(pB1,8),PKW(pB1,10),PKW(pB1,12),PKW(pB1,14)};
    int lane_d=lane; asm volatile("":"+v"(lane_d)); const int vb0=(int)(lds0+LDS_V)+((lane_d>>4)&1)*32+(lane_d&3)*8+(4*(lane_d>>5)+((lane_d&15)>>2))*64;
    SBAR(); pv(o,vb0+VS*sl_cur,PAF(0),PAF(1),PAF(2),PAF(3)); if constexpr(DV128){ pv(o+2,vb0+VS*sl_cur+8192,PAF(0),PAF(1),PAF(2),PAF(3)); } }
  #undef PKW
  #undef PAF
  #undef VFR
  #undef PIN
  #undef MX3
  #undef GAPA
  #undef GAPB
  #undef GAPC
  #undef EX
  #undef VRD
  #undef KRD
  #undef STEP
  #undef STEP128
  #undef STEPX
  #undef VRD2
  #undef WB2
  #undef WB1
  #undef ENDW
  {auto rr=__builtin_amdgcn_permlane32_swap(__float_as_uint(l_reg),__float_as_uint(l_reg),false,false);l_reg=__uint_as_float(rr[0])+__uint_as_float(rr[1]);}
  if(hi==0)wsf[32+r32]=l_reg;asm volatile("s_waitcnt lgkmcnt(0)":::"memory");
  float rli[16];
  #pragma unroll
  for(int r=0;r<16;++r)rli[r]=__builtin_amdgcn_rcpf(wsf[32+crow(r,hi)]);
  bf16*Ow=Ob+(long)(wid*QBLK)*PO;
  { bf16*stg=(bf16*)(shm+L_OST)+wid*2048;
    #pragma unroll
    for(int hf=0;hf<VS;++hf){
      #pragma unroll
      for(int r=0;r<16;++r){const int orow=crow(r,hi);
        #pragma unroll
        for(int d0=0;d0<2;++d0)stg[orow*64+d0*32+r32]=__float2bfloat16(o[2*hf+d0][r]*rli[r]);}
      asm volatile("s_waitcnt lgkmcnt(0)":::"memory");
      #pragma unroll
      for(int i=0;i<4;++i){const int row=i*8+(lane>>3),ch=lane&7; const u32x4 v=*(const u32x4*)(stg+row*64+ch*8); ATTN_STORE16(Ow+(long)row*PO+hf*64+ch*8,v);}
      asm volatile("s_waitcnt lgkmcnt(0)":::"memory"); } }
  asm volatile("s_waitcnt lgkmcnt(0)\n\ts_barrier":::"memory");
  #undef DMA_K
  #undef DMA_V
  #undef CMASK
  #undef START
  #undef RESC
  #undef ROT
}
constexpr int ATTN_LDS_BYTES=LDS_BYTES;
#undef SBAR
#undef WAIT_BAR
}
#include <hip/hip_cooperative_groups.h>
namespace cg = cooperative_groups;
#define LAS __attribute__((address_space(3)))
typedef unsigned short bf16_t;
typedef unsigned v4u __attribute__((ext_vector_type(4)));
typedef unsigned v2u __attribute__((ext_vector_type(2)));
typedef float f32x4 __attribute__((ext_vector_type(4)));
typedef float cf __attribute__((ext_vector_type(2)));

constexpr int NTHR = 512;
constexpr int DMOD = 1024, NBATCH = 4, SEQ = 8192, CTXL = 256, DEPTH = 4;
constexpr int ML = NBATCH * SEQ, MC = NBATCH * CTXL, MT = ML + MC;
constexpr int INW = 2816, DFF = 2816, NKEY = SEQ + CTXL;
constexpr float EPSF = 1e-6f;
constexpr int FFTN = 16384;

constexpr size_t MiB = 1u << 20;
constexpr size_t WS_MOD = 1 * MiB;
constexpr size_t WS_LAM = 1 * MiB + 512 * 1024;
constexpr size_t WS_ROPE = WS_LAM + 256;
constexpr size_t WS_TW = 1 * MiB + 768 * 1024;
constexpr size_t WS_WIN = 2 * MiB, WS_WOUT = WS_WIN + (size_t)INW * 1024 * 2, WS_WUP = WS_WOUT + 2 * MiB, WS_WDN = WS_WUP + (size_t)2 * DFF * 1024 * 2;
constexpr size_t WS_CTXX = 26 * MiB;
constexpr size_t WS_FILT = 30 * MiB, WS_FILTC = 62 * MiB;
constexpr size_t WS_H = 64 * MiB;
constexpr size_t WS_KF = 64 * MiB;
constexpr size_t WS_RAW = 130 * MiB;
constexpr size_t WS_YRAW = 130 * MiB;
constexpr size_t WS_YH = 213 * MiB, WS_YHC = 245 * MiB;
constexpr size_t WS_QA = 312 * MiB, WS_KA = 329 * MiB, WS_VA = 338 * MiB, WS_QD = 347 * MiB, WS_KD = 380 * MiB, WS_VD = 413 * MiB;
constexpr size_t WS_HYR = 446 * MiB, WS_HYRC = 494 * MiB;
constexpr size_t WS_G = 130 * MiB;
constexpr size_t WS_END = 496 * MiB;
static_assert(WS_WDN + (size_t)DFF * 1024 * 2 <= WS_CTXX, "weights");
static_assert(WS_H + (size_t)MT * 1024 * 2 <= WS_RAW && WS_RAW + (size_t)MT * INW * 2 <= WS_QA, "map1");
static_assert(WS_YRAW + (size_t)MT * 1280 * 2 <= WS_YH && WS_G + (size_t)MT * DFF * 2 <= WS_QA, "map2");
constexpr int LDS_BYTES = 147456;
#ifndef PHM
#define PHM 0xffff
#endif
#define PH(b) ((PHM >> (b)) & 1)
#ifndef REP_ATT
#define REP_ATT 1
#endif
#ifndef REP_HY
#define REP_HY 1
#endif
#ifndef REP_GEMM
#define REP_GEMM 1
#endif
#ifndef REP_PREP
#define REP_PREP 1
#endif
#ifndef REP_PP
#define REP_PP 1
#endif
#ifndef REP_MERGE
#define REP_MERGE 1
#endif
#ifndef REP_N2
#define REP_N2 1
#endif
#ifndef REP_GLU
#define REP_GLU 1
#endif
#ifndef REP_GEMM2
#define REP_GEMM2 1
#endif
#ifndef REP_PRO
#define REP_PRO 1
#endif
#ifndef PROBE_PLAIN_LAUNCH
#define PROBE_PLAIN_LAUNCH 0
#endif
#ifndef EXTRA_SYNC
#define EXTRA_SYNC 0
#endif

typedef float f32x2_cv __attribute__((ext_vector_type(2))); typedef __bf16 bf16x2_cv __attribute__((ext_vector_type(2)));
__device__ __forceinline__ unsigned pk2(float lo, float hi) { const f32x2_cv v = {lo, hi}; const bf16x2_cv b = __builtin_convertvector(v, bf16x2_cv); return __builtin_bit_cast(unsigned, b); }
__device__ __forceinline__ unsigned f2bf(float f) { return pk2(f, f) & 0xffffu; }

__device__ __forceinline__ float bf2f(bf16_t u) { return __uint_as_float((unsigned)u << 16); }
__device__ __forceinline__ float bflo(unsigned w) { return __uint_as_float(w << 16); }
__device__ __forceinline__ float bfhi(unsigned w) { return __uint_as_float(w & 0xffff0000u); }
__device__ __forceinline__ float shx(float v, int m, int lane) { return __builtin_bit_cast(float, __builtin_amdgcn_ds_bpermute((lane ^ m) << 2, __builtin_bit_cast(int, v))); }
__device__ __forceinline__ float wave_sum(float v) {
    const int lane = lane_id_v();
#pragma unroll
    for (int o = 1; o < 64; o <<= 1) v += shx(v, o, lane);
    return v;
}
__device__ __forceinline__ float block_sum(float v, LAS float* RED, int tid) {
    v = wave_sum(v); __syncthreads(); if ((tid & 63) == 0) RED[tid >> 6] = v; __syncthreads();
    float s = 0.f;
#pragma unroll
    for (int w = 0; w < 8; ++w) s += RED[w];
    return s;
}

struct EpiGateRes {
    static constexpr bool PERM = false, AFTER_DRAIN = false;
    const float* base_lat; float* out_lat; const float* base_ctx; float* out_ctx; const float* gate; int row_off;
    __device__ __forceinline__ void operator()(const pg8::f32x4 (&acc)[2][2][4][2], const pg8::Unit& u, int wr, int wc, int fr, int fq) const {
        const int col0 = u.pn * 256 + wc * 32 + 4 * fq;
#pragma unroll
        for (int ai = 0; ai < 2; ++ai)
#pragma unroll
            for (int m = 0; m < 4; ++m) {
                const int r = row_off + u.pm * 256 + ai * 128 + wr * 64 + m * 16 + fr;
                const bool lat = r < ML; const int bi = lat ? (r >> 13) : 4;
                const size_t off = lat ? (size_t)r * 1024 : (size_t)(r - ML) * 1024;
                const float* bp = (lat ? base_lat : base_ctx) + off + col0; float* op = (lat ? out_lat : out_ctx) + off + col0;
                const float* gp = gate + bi * 6144 + col0;
#pragma unroll
                for (int bj = 0; bj < 2; ++bj)
#pragma unroll
                    for (int n = 0; n < 2; ++n) {
                        const pg8::f32x4 g4 = *(const pg8::f32x4*)(gp + bj * 128 + n * 16), b4 = *(const pg8::f32x4*)(bp + bj * 128 + n * 16);
                        *(pg8::f32x4*)(op + bj * 128 + n * 16) = b4 + g4 * acc[ai][bj][m][n];
                    }
            }
    }
};

__device__ __forceinline__ float dpp_ror1(float v) { return __builtin_bit_cast(float, __builtin_amdgcn_update_dpp(0, __builtin_bit_cast(int, v), 0x121, 0xF, 0xF, false)); }
__device__ __forceinline__ float dpp_rol1(float v) { return __builtin_bit_cast(float, __builtin_amdgcn_update_dpp(0, __builtin_bit_cast(int, v), 0x12F, 0xF, 0xF, false)); }
struct EpiGlu {
    static constexpr bool PERM = true, AFTER_DRAIN = false;
    bf16_t* G; const float* cw; const float* cb; int nrows;
    __device__ __forceinline__ void operator()(const pg8::f32x4 (&acc)[2][2][4][2], const pg8::Unit& u, int wr, int wc, int fr, int fq) const {
        const int ch0 = u.pn * 128 + wc * 32 + 8 * fq;
        float w0[8], w1[8], w2[8], bb[8];
#pragma unroll
        for (int hq = 0; hq < 2; ++hq) { const pg8::f32x4 q0 = *(const pg8::f32x4*)(cw + ch0 + 4 * hq), q1 = *(const pg8::f32x4*)(cw + DFF + ch0 + 4 * hq), q2 = *(const pg8::f32x4*)(cw + 2 * DFF + ch0 + 4 * hq), q3 = *(const pg8::f32x4*)(cb + ch0 + 4 * hq);
#pragma unroll
            for (int e = 0; e < 4; ++e) { w0[4 * hq + e] = q0[e]; w1[4 * hq + e] = q1[e]; w2[4 * hq + e] = q2[e]; bb[4 * hq + e] = q3[e]; } }
#pragma unroll
        for (int ai = 0; ai < 2; ++ai) {
            const int kb = u.pm * 4 + ai * 2 + wr;
            float ruP[8], rdC[8];
#pragma unroll
            for (int c = 0; c < 8; ++c) { ruP[c] = 0.f; rdC[c] = dpp_rol1(acc[ai][0][0][c >> 2][c & 3]); }
#pragma unroll
            for (int m = 0; m < 4; ++m) {
                const int rl = 16 * m + fr, gr = 62 * kb - 1 + rl;
                bool first, last; if (gr < ML) { const int t = gr & 8191; first = t == 0; last = t == 8191; } else { const int t = (gr - ML) & 255; first = t == 0; last = t == 255; }
                float res[8];
#pragma unroll
                for (int c = 0; c < 8; ++c) {
                    const int n = c >> 2, e = c & 3;
                    const float x0 = acc[ai][0][m][n][e];
                    const float ruC = dpp_ror1(x0), rdN = m < 3 ? dpp_rol1(acc[ai][0][m < 3 ? m + 1 : 3][n][e]) : 0.f;
                    float xu = fr == 0 ? ruP[c] : ruC, xd = fr == 15 ? rdN : rdC[c];
                    xu = first ? 0.f : xu; xd = last ? 0.f : xd;
                    ruP[c] = ruC; rdC[c] = rdN;
                    const float x = w0[c] * xu + w1[c] * x0 + w2[c] * xd + bb[c];
                    const float u2 = -2.302208198f * (x + 0.044715f * x * x * x);
                    res[c] = x * __builtin_amdgcn_rcpf(1.0f + __builtin_amdgcn_exp2f(u2)) * acc[ai][1][m][n][e];
                }
                if (rl >= 1 && rl <= 62 && gr < nrows) { v4u o; o.x = pk2(res[0], res[1]); o.y = pk2(res[2], res[3]); o.z = pk2(res[4], res[5]); o.w = pk2(res[6], res[7]);
                    *(v4u*)(G + (size_t)gr * DFF + ch0) = o; }
            }
        }
    }
};

struct EpiInProj {
    static constexpr bool PERM = true, AFTER_DRAIN = false;
    bf16_t *qa, *ka, *va, *qd, *kd, *vd, *hyr, *hyrc; const float *qn_a, *kn_a, *qn_d, *kn_d; const cf* rope;
    __device__ __forceinline__ void operator()(const pg8::f32x4 (&acc)[2][2][4][2], const pg8::Unit& u, int wr, int wc, int fr, int fq) const {
        const int pn = u.pn, lane = fr + 16 * fq;
        bool normed, keyrow; const float* gain = qn_a; float scale = 1.f; bf16_t* dbase; int dpitch, dcol, nh = 1, hidx = 0;
        if (pn == 0) { normed = true; gain = qn_a; scale = attn_body::C2; dbase = qa; dpitch = 256; keyrow = false; dcol = wc * 64; }
        else if (pn == 1) { keyrow = true; dpitch = 64; nh = 2; dcol = 0; if (wc < 2) { normed = true; gain = kn_a; dbase = ka; hidx = wc; } else { normed = false; dbase = va; hidx = wc - 2; } }
        else if (pn < 5) { normed = false; dbase = hyr; dpitch = 0; keyrow = false; dcol = (pn - 2) * 256 + wc * 64; }
        else if (pn < 7) { normed = true; gain = qn_d; scale = attn_body::C2; dbase = qd; dpitch = 512; keyrow = false; dcol = ((pn - 5) * 4 + wc) * 64; }
        else if (pn < 9) { normed = true; gain = kn_d; dbase = kd; dpitch = 64; keyrow = true; nh = 8; hidx = (pn - 7) * 4 + wc; dcol = 0; }
        else { normed = false; dbase = vd; dpitch = 128; keyrow = true; nh = 4; hidx = (pn - 9) * 2 + (wc >> 1); dcol = (wc & 1) * 64; }
        pg8::f32x4 gg[2][2];
#pragma unroll
        for (int bj = 0; bj < 2; ++bj)
#pragma unroll
            for (int n = 0; n < 2; ++n) gg[bj][n] = *(const pg8::f32x4*)(gain + 32 * bj + 8 * fq + 4 * n);
#pragma unroll
        for (int ai = 0; ai < 2; ++ai)
#pragma unroll
            for (int m = 0; m < 4; ++m) {
                const int r = u.pm * 256 + ai * 128 + wr * 64 + m * 16 + fr;
                const bool lat = r < ML; int b, t; if (lat) { b = r >> 13; t = r & 8191; } else { b = (r - ML) >> 8; t = (r - ML) & 255; }
                const size_t drow = keyrow ? (size_t)(b * nh + hidx) * NKEY + (lat ? 256 + t : t) : (size_t)r;
                if (pn >= 2 && pn < 5) {
                    bf16_t* cbp = lat ? hyr + (size_t)b * 768 * 8192 + t : hyrc + (size_t)b * 768 * 256 + t; const size_t cst = lat ? 8192 : 256;
#pragma unroll
                    for (int bj = 0; bj < 2; ++bj)
#pragma unroll
                        for (int n = 0; n < 2; ++n)
#pragma unroll
                            for (int e = 0; e < 4; ++e) cbp[(size_t)(dcol + 32 * bj + 8 * fq + 4 * n + e) * cst] = (bf16_t)f2bf(acc[ai][bj][m][n][e]);
                    continue;
                }
                bf16_t* dp = dbase + drow * dpitch + dcol + 8 * fq;
                float rinv = 1.f;
                if (normed) { float ss = 0.f;
#pragma unroll
                    for (int bj = 0; bj < 2; ++bj)
#pragma unroll
                        for (int n = 0; n < 2; ++n) { const pg8::f32x4 x = acc[ai][bj][m][n]; ss += (x[0] * x[0] + x[1] * x[1]) + (x[2] * x[2] + x[3] * x[3]); }
                    ss += shx(ss, 16, lane); ss += shx(ss, 32, lane);
                    rinv = scale * __builtin_amdgcn_rsqf(ss * (1.0f / 64.0f) + EPSF); }
#pragma unroll
                for (int bj = 0; bj < 2; ++bj) {
                    pg8::f32x4 y0 = acc[ai][bj][m][0], y1 = acc[ai][bj][m][1];
                    if (normed) {
                        y0 = y0 * rinv * gg[bj][0]; y1 = y1 * rinv * gg[bj][1];
                        if (lat) { const int p = bj == 0 ? (t >> 6) : (t & 63); const pg8::f32x4* rp = (const pg8::f32x4*)(rope + p * 16 + 4 * fq); const pg8::f32x4 c01 = rp[0], c23 = rp[1];
                            const pg8::f32x4 z0 = {y0[0] * c01[0] - y0[1] * c01[1], y0[0] * c01[1] + y0[1] * c01[0], y0[2] * c01[2] - y0[3] * c01[3], y0[2] * c01[3] + y0[3] * c01[2]};
                            const pg8::f32x4 z1 = {y1[0] * c23[0] - y1[1] * c23[1], y1[0] * c23[1] + y1[1] * c23[0], y1[2] * c23[2] - y1[3] * c23[3], y1[2] * c23[3] + y1[3] * c23[2]};
                            y0 = z0; y1 = z1; }
                    }
                    v4u o; o.x = pk2(y0[0], y0[1]); o.y = pk2(y0[2], y0[3]); o.z = pk2(y1[0], y1[1]); o.w = pk2(y1[2], y1[3]);
                    *(v4u*)(dp + 32 * bj) = o;
                }
            }
    }
};

template <int PERM_UP = 0> __device__ __forceinline__ void transpose_item(const float* W, int K, int N, bf16_t* WT, LAS float* scr, int item, int lane) {
    const int nblk = N / 32, kb = item / nblk, nb = item % nblk, k0 = 64 * kb, n0 = 32 * nb;
#pragma unroll 8
    for (int i = 0; i < 32; ++i) { const int kk = 2 * i + (lane >> 5); scr[kk * 33 + (lane & 31)] = W[(size_t)(k0 + kk) * N + n0 + (lane & 31)]; }
    asm volatile("s_waitcnt lgkmcnt(0)" ::: "memory");
    const int c = lane & 7;
#pragma unroll
    for (int j = 0; j < 4; ++j) { const int n = (lane >> 3) + 8 * j; const LAS float* s = scr + (8 * c) * 33 + n;
        v4u o; o.x = pk2(s[0 * 33], s[1 * 33]); o.y = pk2(s[2 * 33], s[3 * 33]); o.z = pk2(s[4 * 33], s[5 * 33]); o.w = pk2(s[6 * 33], s[7 * 33]);
        int row = n0 + n; if (PERM_UP == 2) { const int nl = row & 255; row = (row & ~255) + 128 * ((nl >> 5) & 1) + 32 * (nl >> 6) + (nl & 31); }
        if (PERM_UP == 1) { const bool isv = row >= DFF; const int ch = isv ? row - DFF : row; row = (ch >> 7) * 256 + (isv ? 128 : 0) + (ch & 127); }
        *(v4u*)(WT + (size_t)row * K + k0 + 8 * c) = o; }
    asm volatile("s_waitcnt lgkmcnt(0)" ::: "memory");
}

__device__ __forceinline__ void norm_mod(const float* xl, const float* xc, const float* g, const float* mod, int shoff, int scoff, bf16_t* H, int nrows, int gw, int NGW, int lane) {
    for (int r = gw; r < nrows; r += 4 * NGW) {
        int rr[4]; const float* xp[4]; const float* mp[4];
#pragma unroll
        for (int k = 0; k < 4; ++k) { const int rk = r + k * NGW; rr[k] = rk < nrows ? rk : r; xp[k] = rr[k] < ML ? xl + (size_t)rr[k] * 1024 : xc + (size_t)(rr[k] - ML) * 1024; mp[k] = mod + (rr[k] < ML ? (rr[k] >> 13) : 4) * 6144; }
        f32x4 v[4][4]; float ss[4];
#pragma unroll
        for (int k = 0; k < 4; ++k)
#pragma unroll
            for (int j = 0; j < 4; ++j) v[k][j] = ((const f32x4*)xp[k])[lane + 64 * j];
#pragma unroll
        for (int k = 0; k < 4; ++k) { ss[k] = 0.f;
#pragma unroll
            for (int j = 0; j < 4; ++j) ss[k] += (v[k][j].x * v[k][j].x + v[k][j].y * v[k][j].y) + (v[k][j].z * v[k][j].z + v[k][j].w * v[k][j].w); }
#pragma unroll
        for (int o = 1; o < 64; o <<= 1) {
#pragma unroll
            for (int k = 0; k < 4; ++k) ss[k] += shx(ss[k], o, lane); }
#pragma unroll
        for (int j = 0; j < 4; ++j) { const int col = 4 * lane + 256 * j;
            const f32x4 g4 = *(const f32x4*)(g + col);
#pragma unroll
            for (int k = 0; k < 4; ++k) { if (k == 0 || r + k * NGW < nrows) {
                const float rinv = 1.0f / sqrtf(ss[k] * (1.0f / 1024.0f) + EPSF);
                const f32x4 sc4 = *(const f32x4*)(mp[k] + scoff + col), sh4 = *(const f32x4*)(mp[k] + shoff + col); const f32x4 o = (v[k][j] * rinv * g4) * (sc4 + 1.0f) + sh4;
                v2u w; w.x = pk2(o.x, o.y); w.y = pk2(o.z, o.w); *(v2u*)(H + (size_t)rr[k] * 1024 + col) = w; } }
        }
    }
}

__device__ __forceinline__ cf mk2(float x, float y) { cf r; r.x = x; r.y = y; return r; }
__device__ __forceinline__ cf cmul(cf a, cf b) { return mk2(a.x * b.x - a.y * b.y, a.x * b.y + a.y * b.x); }
__device__ __forceinline__ cf cmulc(cf a, cf b) { return mk2(a.x * b.x + a.y * b.y, a.y * b.x - a.x * b.y); }
__device__ __forceinline__ cf ld_f2_l2(const cf* p) {
    const unsigned long long w = __hip_atomic_load((const unsigned long long*)p, __ATOMIC_RELAXED, __HIP_MEMORY_SCOPE_AGENT);
    return mk2(__uint_as_float((unsigned)w), __uint_as_float((unsigned)(w >> 32)));
}
__device__ __forceinline__ int PX(int i) { return i + (i >> 6); }
__device__ __forceinline__ cf twid(float frac) { return mk2(__builtin_amdgcn_cosf(frac), -__builtin_amdgcn_sinf(frac)); }
__device__ __forceinline__ void bfly4_fwd(cf& a0, cf& a1, cf& a2, cf& a3) {
    const cf s02 = a0 + a2, d02 = a0 - a2, s13 = a1 + a3, d13 = a1 - a3;
    a0 = s02 + s13; a2 = s02 - s13; a1 = mk2(d02.x + d13.y, d02.y - d13.x); a3 = mk2(d02.x - d13.y, d02.y + d13.x);
}
__device__ __forceinline__ void bfly4_inv(cf& a0, cf& a1, cf& a2, cf& a3) {
    const cf s02 = a0 + a2, d02 = a0 - a2, s13 = a1 + a3, d13 = a1 - a3;
    a0 = s02 + s13; a2 = s02 - s13; a1 = mk2(d02.x - d13.y, d02.y + d13.x); a3 = mk2(d02.x + d13.y, d02.y - d13.x);
}
template <int LG, bool INV> __device__ __forceinline__ void fft_pass2(LAS cf* X, int tid) {
    constexpr int L = 1 << LG, L16 = L >> 4, L4 = L >> 2; constexpr float fL = 1.0f / (float)L;
#pragma unroll 1
    for (int i = 0; i < 2; ++i) {
        const int it = tid + 512 * i; int g, j;
        if (LG == 14) { g = 0; j = it; } else if (LG == 10) { j = it & 63; g = it >> 6; } else { g = it & 255; j = it >> 8; }
        const int base = g * L + j;
        cf e[4][4];
#pragma unroll
        for (int r = 0; r < 4; ++r)
#pragma unroll
            for (int m = 0; m < 4; ++m) e[r][m] = X[PX(base + r * L16 + m * L4)];
        const cf v1 = twid((float)(4 * j) * fL), v2 = cmul(v1, v1), v3 = cmul(v2, v1);
        if (!INV) {
#pragma unroll
            for (int r = 0; r < 4; ++r) { bfly4_fwd(e[r][0], e[r][1], e[r][2], e[r][3]);
                const cf w1 = twid((float)(j + r * L16) * fL), w2 = cmul(w1, w1), w3 = cmul(w2, w1);
                e[r][1] = cmul(e[r][1], w1); e[r][2] = cmul(e[r][2], w2); e[r][3] = cmul(e[r][3], w3); }
#pragma unroll
            for (int p = 0; p < 4; ++p) { bfly4_fwd(e[0][p], e[1][p], e[2][p], e[3][p]); e[1][p] = cmul(e[1][p], v1); e[2][p] = cmul(e[2][p], v2); e[3][p] = cmul(e[3][p], v3); }
        } else {
#pragma unroll
            for (int p = 0; p < 4; ++p) { e[1][p] = cmulc(e[1][p], v1); e[2][p] = cmulc(e[2][p], v2); e[3][p] = cmulc(e[3][p], v3); bfly4_inv(e[0][p], e[1][p], e[2][p], e[3][p]); }
#pragma unroll
            for (int r = 0; r < 4; ++r) { const cf w1 = twid((float)(j + r * L16) * fL), w2 = cmul(w1, w1), w3 = cmul(w2, w1);
                e[r][1] = cmulc(e[r][1], w1); e[r][2] = cmulc(e[r][2], w2); e[r][3] = cmulc(e[r][3], w3); bfly4_inv(e[r][0], e[r][1], e[r][2], e[r][3]); }
        }
#pragma unroll
        for (int r = 0; r < 4; ++r)
#pragma unroll
            for (int m = 0; m < 4; ++m) X[PX(base + r * L16 + m * L4)] = e[r][m];
    }
    __syncthreads();
}
__device__ __forceinline__ void fft_last_fwd(LAS cf* X, int tid, cf* KFW, float bias, float scale) {
#pragma unroll 2
    for (int i = 0; i < 8; ++i) { const int it = tid + 512 * i, g = it & 255, k = it >> 8, base = g * 64 + 4 * k;
        cf e0 = X[PX(base)], e1 = X[PX(base + 1)], e2 = X[PX(base + 2)], e3 = X[PX(base + 3)];
        bfly4_fwd(e0, e1, e2, e3);
        if (KFW) { cf* o = KFW + (4 * k) * 256 + g; o[0] = mk2((e0.x + bias) * scale, e0.y * scale); o[256] = mk2((e1.x + bias) * scale, e1.y * scale); o[512] = mk2((e2.x + bias) * scale, e2.y * scale); o[768] = mk2((e3.x + bias) * scale, e3.y * scale); }
        else { X[PX(base)] = e0; X[PX(base + 1)] = e1; X[PX(base + 2)] = e2; X[PX(base + 3)] = e3; } }
    __syncthreads();
}
__device__ __forceinline__ void fft_first_inv_mul(LAS cf* X, int tid, const cf* KFR) {
#pragma unroll 2
    for (int i = 0; i < 8; ++i) { const int it = tid + 512 * i, g = it & 255, k = it >> 8, base = g * 64 + 4 * k; const cf* q = KFR + (4 * k) * 256 + g;
        cf e0 = cmul(X[PX(base)], ld_f2_l2(q)), e1 = cmul(X[PX(base + 1)], ld_f2_l2(q + 256)), e2 = cmul(X[PX(base + 2)], ld_f2_l2(q + 512)), e3 = cmul(X[PX(base + 3)], ld_f2_l2(q + 768));
        bfly4_inv(e0, e1, e2, e3);
        X[PX(base)] = e0; X[PX(base + 1)] = e1; X[PX(base + 2)] = e2; X[PX(base + 3)] = e3; }
    __syncthreads();
}
__device__ __forceinline__ void fft_mid_mul(LAS cf* X, int tid, const cf* KFR) {
#pragma unroll 2
    for (int i = 0; i < 8; ++i) { const int it = tid + 512 * i, g = it & 255, k = it >> 8, base = g * 64 + 4 * k; const cf* q = KFR + (4 * k) * 256 + g;
        cf e0 = X[PX(base)], e1 = X[PX(base + 1)], e2 = X[PX(base + 2)], e3 = X[PX(base + 3)];
        const cf k0 = ld_f2_l2(q), k1 = ld_f2_l2(q + 256), k2 = ld_f2_l2(q + 512), k3 = ld_f2_l2(q + 768);
        bfly4_fwd(e0, e1, e2, e3);
        e0 = cmul(e0, k0); e1 = cmul(e1, k1); e2 = cmul(e2, k2); e3 = cmul(e3, k3);
        bfly4_inv(e0, e1, e2, e3);
        X[PX(base)] = e0; X[PX(base + 1)] = e1; X[PX(base + 2)] = e2; X[PX(base + 3)] = e3; }
    __syncthreads();
}
__device__ __forceinline__ void fft_fwd_lds(LAS cf* X, int tid) { fft_pass2<14, false>(X, tid); fft_pass2<10, false>(X, tid); fft_pass2<6, false>(X, tid); }
__device__ __forceinline__ void fft_inv_lds(LAS cf* X, int tid) { fft_pass2<6, true>(X, tid); fft_pass2<10, true>(X, tid); fft_pass2<14, true>(X, tid); }
__device__ __forceinline__ void conv8(const bf16_t* p, int c, int n, float w0, float w1, float w2, float b, float (&o)[8]) {
    const v4u v = *(const v4u*)(p + 8 * c);
    const float um = c > 0 ? bf2f(p[8 * c - 1]) : 0.f, up = 8 * c + 8 < n ? bf2f(p[8 * c + 8]) : 0.f;
    const float u0 = bflo(v.x), u1 = bfhi(v.x), u2 = bflo(v.y), u3 = bfhi(v.y), u4 = bflo(v.z), u5 = bfhi(v.z), u6 = bflo(v.w), u7 = bfhi(v.w);
    o[0] = w0 * um + w1 * u0 + w2 * u1 + b; o[1] = w0 * u0 + w1 * u1 + w2 * u2 + b; o[2] = w0 * u1 + w1 * u2 + w2 * u3 + b; o[3] = w0 * u2 + w1 * u3 + w2 * u4 + b;
    o[4] = w0 * u3 + w1 * u4 + w2 * u5 + b; o[5] = w0 * u4 + w1 * u5 + w2 * u6 + b; o[6] = w0 * u5 + w1 * u6 + w2 * u7 + b; o[7] = w0 * u6 + w1 * u7 + w2 * up + b;
}
__device__ __forceinline__ float hy_in(const bf16_t* p, int t, int n, float w0, float w1, float w2, float b) {
    const float um = t > 0 ? bf2f(p[t - 1]) : 0.f, u0 = bf2f(p[t]), up = t < n - 1 ? bf2f(p[t + 1]) : 0.f;
    return w0 * um + w1 * u0 + w2 * up + b;
}

#define XB_TMO      128
#define XB_XCNT(j)  (256  + 64 * (j))
#define XB_XSUB(j)  (1280 + 64 * (j))
#define XB_XGEN(j)  (2304 + 64 * (j))
#define XB_TOP      3328
#define XB_TOPGEN   3392
#define XCD_BAR_WORDS 3456
#define XB_SPIN_CAP (1u << 18)

__device__ __forceinline__ unsigned xb_ld(unsigned* p)              { return __hip_atomic_load(p, __ATOMIC_RELAXED, __HIP_MEMORY_SCOPE_AGENT); }
__device__ __forceinline__ unsigned xb_add(unsigned* p, unsigned v) { return __hip_atomic_fetch_add(p, v, __ATOMIC_RELAXED, __HIP_MEMORY_SCOPE_AGENT); }
__device__ __forceinline__ unsigned xb_xcc_id() { return (unsigned)__builtin_amdgcn_s_getreg((3 << 11) | 20) & 0xFu; }
#define XB_SPIN(cond, bar) do { unsigned _sp = 0; while (cond) { __builtin_amdgcn_s_sleep(1); \
    if ((++_sp & 255u) == 0u) { if (xb_ld(&(bar)[XB_TMO])) break; if (_sp > XB_SPIN_CAP) { atomicAdd(&(bar)[XB_TMO], 1u); break; } } } } while (0)

struct XcdBarrier {
    unsigned* bar; unsigned x;
    volatile LAS unsigned* st;
};

__device__ __forceinline__ XcdBarrier xcd_barrier_post(unsigned* bar, volatile LAS unsigned* st) {
    XcdBarrier b; b.bar = bar; b.x = xb_xcc_id(); b.st = st;
    if (threadIdx.x == 0) (void)xb_add(&bar[XB_XCNT(b.x)], 1u);
    return b;
}
__device__ __forceinline__ void xcd_barrier_complete(unsigned* bar, unsigned x, unsigned& nloc, unsigned& nx) {
    const unsigned G = gridDim.x * gridDim.y * gridDim.z;
    unsigned sum, cnt, mine, sp = 0u;
    for (;;) {
        sum = 0u; cnt = 0u; mine = 0u;
#pragma unroll
        for (unsigned j = 0; j < 16; ++j) { const unsigned c = xb_ld(&bar[XB_XCNT(j)]); sum += c; cnt += (c > 0u) ? 1u : 0u; mine = (j == x) ? c : mine; }
        if (sum == G) break;
        __builtin_amdgcn_s_sleep(1);
        if ((++sp & 255u) == 0u) { if (xb_ld(&bar[XB_TMO])) break; if (sp > XB_SPIN_CAP) { atomicAdd(&bar[XB_TMO], 1u); break; } }
    }
    nloc = mine > 0u ? mine : 1u; nx = cnt > 0u ? cnt : 1u;
}

__device__ __forceinline__ void xcd_barrier(const XcdBarrier& b, const int wave0) {
    asm volatile("s_waitcnt vmcnt(0)" ::: "memory");
    __syncthreads();
    if (wave0 == 0 && lane_id_v() == 0) {
        unsigned* bar = b.bar;
        __builtin_amdgcn_s_waitcnt(0);
        unsigned nloc = b.st[0], nx = b.st[1];
        if (nloc == 0u) { xcd_barrier_complete(bar, b.x, nloc, nx); b.st[0] = nloc; b.st[1] = nx; }
        const unsigned old = xb_add(&bar[XB_XSUB(b.x)], 1u);
        const unsigned gen = old / nloc;
        if (old + 1u == (gen + 1u) * nloc) {
            __builtin_amdgcn_fence(__ATOMIC_RELEASE, "agent");
            asm volatile("s_waitcnt vmcnt(0)" ::: "memory");
            const unsigned og = xb_add(&bar[XB_TOP], 1u);
            const unsigned tg = og / nx;
            if (og + 1u == (tg + 1u) * nx) xb_add(&bar[XB_TOPGEN], 1u);
            else XB_SPIN(xb_ld(&bar[XB_TOPGEN]) == tg, bar);
            __builtin_amdgcn_fence(__ATOMIC_ACQUIRE, "agent");
            xb_add(&bar[XB_XGEN(b.x)], 1u);
            asm volatile("s_waitcnt vmcnt(0)" ::: "memory");
        } else {
            XB_SPIN(xb_ld(&bar[XB_XGEN(b.x)]) == gen, bar);
            __builtin_amdgcn_fence(__ATOMIC_ACQUIRE, "agent");
            asm volatile("s_waitcnt vmcnt(0)" ::: "memory");
        }
    }
    __syncthreads();
}


struct Args { const float* in[33]; float* out; unsigned char* ws; };
__device__ __forceinline__ unsigned char* wsb(unsigned char* p) { asm volatile("" : "+s"(p)); return p; }
__device__ __forceinline__ int opq(int i) { asm volatile("" : "+s"(i)); return i; }

#define MOD ((float*)(wsb(a.ws) + WS_MOD))
#define LAM ((float*)(wsb(a.ws) + WS_LAM))
#define ROPE ((cf*)(wsb(a.ws) + WS_ROPE))
#define TW ((cf*)(wsb(a.ws) + WS_TW))
#define WIN ((bf16_t*)(wsb(a.ws) + WS_WIN))
#define WOUT ((bf16_t*)(wsb(a.ws) + WS_WOUT))
#define WUP ((bf16_t*)(wsb(a.ws) + WS_WUP))
#define WDN ((bf16_t*)(wsb(a.ws) + WS_WDN))
#define CTXX ((float*)(wsb(a.ws) + WS_CTXX))
#define FILT ((float*)(wsb(a.ws) + WS_FILT))
#define FILTC ((float*)(wsb(a.ws) + WS_FILTC))
#define H ((bf16_t*)(wsb(a.ws) + WS_H))
#define KFB ((cf*)(wsb(a.ws) + WS_KF))
#define RAW ((bf16_t*)(wsb(a.ws) + WS_RAW))
#define YRAW ((bf16_t*)(wsb(a.ws) + WS_YRAW))
#define YH ((float*)(wsb(a.ws) + WS_YH))
#define YHC ((float*)(wsb(a.ws) + WS_YHC))
#define QA ((bf16_t*)(wsb(a.ws) + WS_QA))
#define KA ((bf16_t*)(wsb(a.ws) + WS_KA))
#define VA ((bf16_t*)(wsb(a.ws) + WS_VA))
#define QD ((bf16_t*)(wsb(a.ws) + WS_QD))
#define KD ((bf16_t*)(wsb(a.ws) + WS_KD))
#define VD ((bf16_t*)(wsb(a.ws) + WS_VD))
#define HYR ((bf16_t*)(wsb(a.ws) + WS_HYR))
#define HYRC ((bf16_t*)(wsb(a.ws) + WS_HYRC))
#define GB ((bf16_t*)(wsb(a.ws) + WS_G))
#define OUT (a.out)
__device__ __forceinline__ void prep_work(const Args& a, LAS unsigned char* lds, const int lp, const bool needc, const int widx, const int nwg, const bool do_main, const bool do_dn, const int tid, const int lane, const int wave) {
    LAS float* scr = (LAS float*)(lds + wave * 16384);
    constexpr int I_IN = 16 * 88, I_OUT = 16 * 32, I_UP = 16 * 176, I_DN = 44 * 32;
    for (int it = (do_main ? 0 : I_IN + I_OUT + I_UP) + widx * 8 + wave; it < (do_dn ? I_IN + I_OUT + I_UP + I_DN : I_IN + I_OUT + I_UP); it += nwg * 8) {
        int r = it;
        if (r < I_IN) { transpose_item<2>(a.in[opq(8)] + (size_t)lp * 1024 * INW, 1024, INW, WIN, scr, r, lane); continue; } r -= I_IN;
        if (r < I_OUT) { transpose_item(a.in[opq(28)] + (size_t)lp * 1024 * 1024, 1024, 1024, WOUT, scr, r, lane); continue; } r -= I_OUT;
        if (r < I_UP) { transpose_item<1>(a.in[opq(29)] + (size_t)lp * 1024 * 2 * DFF, 1024, 2 * DFF, WUP, scr, r, lane); continue; } r -= I_UP;
        transpose_item(a.in[opq(32)] + (size_t)lp * DFF * 1024, DFF, 1024, WDN, scr, r, lane);
    }
    __syncthreads();
    if (do_main) {
    const float* fw1 = a.in[opq(19)] + lp * 33 * 64; const float* fb1 = a.in[opq(20)] + lp * 64; const float* fw2 = a.in[opq(21)] + lp * 64 * 64; const float* fb2 = a.in[opq(22)] + lp * 64;
    const float* fw3 = a.in[opq(23)] + (size_t)lp * 64 * 1024; const float* fb3 = a.in[opq(24)] + lp * 1024; const float* freq = a.in[opq(25)] + lp * 64;
    LAS float* Z = (LAS float*)lds; LAS float* H1 = Z + 33 * 33; LAS float* H2 = H1 + 33 * 64; LAS float* W1 = H2 + 33 * 64; LAS float* W2 = W1 + 33 * 64; LAS float* FB = W2 + 64 * 64;
    for (int i = tid; i < 33 * 64; i += NTHR) W1[i] = fw1[i];
    for (int i = tid; i < 64 * 64; i += NTHR) W2[i] = fw2[i];
    if (tid < 64) { FB[tid] = fb1[tid]; FB[64 + tid] = fb2[tid]; FB[128 + tid] = freq[tid]; }
    const int npos = needc ? 33 : 32;
    for (int item = widx; item < 256; item += nwg) {
        __syncthreads();
        for (int i = tid; i < npos * 33; i += NTHR) { const int p = i / 33, e = i - p * 33; const bool isc = p == 32; const int n = isc ? item : item * 32 + p; const float NP = isc ? 256.0f : 8192.0f; float val;
            if (e == 0) val = (float)n / (NP - 1.0f);
            else { const int k = (e - 1) & 15; const float band = 1e-4f + (float)k * ((15.0f - 1e-4f) / 15.0f); const float w = 6.283185307179586f * (float)n / NP; const float arg = band * w;
                val = (e <= 16) ? cosf(arg) : -sinf(arg); }
            Z[i] = val; }
        __syncthreads();
        for (int i = tid; i < npos * 64; i += NTHR) { const int p = i >> 6, j = i & 63; float s = FB[j];
#pragma unroll
            for (int e = 0; e < 33; ++e) s += Z[p * 33 + e] * W1[e * 64 + j];
            H1[i] = sinf(FB[128 + j] * s); }
        __syncthreads();
        for (int i = tid; i < npos * 64; i += NTHR) { const int p = i >> 6, j = i & 63; float s = FB[64 + j];
#pragma unroll 16
            for (int e = 0; e < 64; ++e) s += H1[p * 64 + e] * W2[e * 64 + j];
            H2[i] = sinf(FB[128 + j] * s); }
        __syncthreads();
#pragma unroll 1
        for (int half = 0; half < 2; ++half) { const int q = tid + 512 * half, c = q & 255;
            float w[64];
#pragma unroll
            for (int e = 0; e < 64; ++e) w[e] = fw3[(size_t)e * 1024 + q];
            const float b3 = fb3[q], adelta = 3.0701134573253945f + (float)c * ((15.350567286626973f - 3.0701134573253945f) / 255.0f);
#pragma unroll 1
            for (int p = 0; p < npos; ++p) { float s = b3;
#pragma unroll
                for (int e = 0; e < 64; ++e) s += H2[p * 64 + e] * w[e];
                const bool isc = p == 32; const int n = isc ? item : item * 32 + p; const float t = (float)n / (isc ? 255.0f : 8191.0f);
                float* dst = isc ? FILTC + (size_t)q * 256 : FILT + (size_t)q * 8192;
                dst[n] = s * expf(-t * adelta); }
        }
    }
    __syncthreads();
    }
}

__global__ void __launch_bounds__(NTHR, 2) fwd_mega(Args a) {
    extern __shared__ __attribute__((aligned(16))) unsigned char lds_raw[];
    cg::grid_group grid = cg::this_grid();
    LAS unsigned char* lds = (LAS unsigned char*)lds_raw;
    const int G = gridDim.x, bx = blockIdx.x;
    const int NGW = G * 8;
const int wave0 = __builtin_amdgcn_readfirstlane(threadIdx.x >> 6);
#define PHASE_IDS int tid = wave0 * 64 + lane_id_v(); asm volatile("" : "+v"(tid)); const int lane = tid & 63, wave = __builtin_amdgcn_readfirstlane(tid >> 6); const int gw = bx * 8 + wave; (void)lane; (void)gw;

    volatile LAS unsigned* MISC = (volatile LAS unsigned*)(lds + 147392);
    if (threadIdx.x < 16) MISC[threadIdx.x] = 0u;
    __syncthreads();
    const XcdBarrier xbar = xcd_barrier_post((unsigned*)a.ws, MISC + 8);
    if (threadIdx.x == 0) MISC[2] = xb_add((unsigned*)a.ws + 4096 + 64 * xbar.x, 1u);
    {
        PHASE_IDS
        LAS float* S = (LAS float*)lds; LAS float* RED = S + 5 * 1024;
        const float* c = a.in[opq(1)]; const float* cctx = a.in[opq(3)];
        for (int i = tid; i < 5 * 1024; i += NTHR) { const float v = i < 4096 ? c[i] : cctx[i - 4096]; S[i] = v / (1.f + expf(-v)); }
        __syncthreads();
        const float* wmod = a.in[opq(6)]; const float* bmod = a.in[opq(7)];
        for (int item = bx; item < 384; item += G) {
            const int l = item / 96, cgi = item % 96, ks = tid >> 6, jl = tid & 63, col = cgi * 64 + jl;
            const float* w = wmod + ((size_t)l * 1024 + ks * 128) * 6144 + col;
            float a0 = 0.f, a1 = 0.f, a2 = 0.f, a3 = 0.f, a4 = 0.f;
#pragma unroll 8
            for (int k = 0; k < 128; ++k) { const float wv = w[(size_t)k * 6144]; const int kk = ks * 128 + k;
                a0 += S[kk] * wv; a1 += S[1024 + kk] * wv; a2 += S[2048 + kk] * wv; a3 += S[3072 + kk] * wv; a4 += S[4096 + kk] * wv; }
            RED[(ks * 5 + 0) * 64 + jl] = a0; RED[(ks * 5 + 1) * 64 + jl] = a1; RED[(ks * 5 + 2) * 64 + jl] = a2; RED[(ks * 5 + 3) * 64 + jl] = a3; RED[(ks * 5 + 4) * 64 + jl] = a4;
            __syncthreads();
            if (tid < 320) { const int bi = tid >> 6, j = tid & 63; float s = bmod[l * 6144 + cgi * 64 + j];
#pragma unroll
                for (int k2 = 0; k2 < 8; ++k2) s += RED[(k2 * 5 + bi) * 64 + j];
                MOD[((size_t)l * 5 + bi) * 6144 + cgi * 64 + j] = s; }
            __syncthreads();
        }
        if (bx == 0 && wave < 4) { const int l = wave;
            const float s1 = wave_sum(a.in[opq(13)][l * 64 + lane] * a.in[opq(14)][l * 64 + lane]), s2 = wave_sum(a.in[opq(15)][l * 64 + lane] * a.in[opq(16)][l * 64 + lane]);
            if (lane == 0) LAM[l] = expf(s1) - expf(s2) + (0.8f - 0.6f * expf(-0.3f * (float)l)); }
        const int gt = bx * NTHR + tid;
        if (gt < 2048) { const int p = gt >> 4, f = gt & 15; const float inv = powf(10000.0f, -(float)f / 16.0f); float sn, cs; sincosf((float)p * inv, &sn, &cs); ROPE[gt] = mk2(cs, sn); }
        for (int m = gt; m < FFTN; m += G * NTHR) { float sn, cs; sincospif((float)m / 8192.0f, &sn, &cs); TW[m] = mk2(cs, -sn); }
    }
    if (PROBE_PLAIN_LAUNCH) xcd_barrier(xbar, wave0); else grid.sync();
    if (threadIdx.x == 0) {
        bool ok = (G % 8 == 0) && xbar.x < 8u;
        for (int j = 0; j < 8; ++j) ok = ok && (xb_ld((unsigned*)a.ws + 4096 + 64 * j) == (unsigned)(G / 8));
        const unsigned rk = MISC[2];
        MISC[0] = ok ? rk * 8u + xbar.x : (unsigned)bx;
        MISC[1] = ok ? xbar.x * (unsigned)(G / 8) + rk : (unsigned)((G % 8 == 0) ? (bx % 8) * (G / 8) + bx / 8 : bx);
    }
    __syncthreads();
    const int cbx = __builtin_amdgcn_readfirstlane((int)MISC[0]), vcu = __builtin_amdgcn_readfirstlane((int)MISC[1]);

    for (int l = 0; l < DEPTH; ++l) {
        const bool need_ctx = l < DEPTH - 1;
        const float* xl = l == 0 ? a.in[opq(0)] : OUT; const float* xc = l == 0 ? a.in[opq(2)] : CTXX;
        const float* modl = MOD + (size_t)l * 5 * 6144;
        for (int rep_ = 0; rep_ < REP_PREP; ++rep_) {
            PHASE_IDS
            __syncthreads();
            prep_work(a, lds, l, need_ctx, bx, G, l == 0, true, tid, lane, wave);
            norm_mod(xl, xc, a.in[opq(4)] + l * 1024, modl, 0, 1024, H, MT, gw, NGW, lane);
        }
        xcd_barrier(xbar, wave0);
        {
            pg8::Gemm g{H, WIN, MT, INW, 1024}; pg8::StaticOrder S; S.init(MT, INW, G, cbx);
            EpiInProj E{QA, KA, VA, QD, KD, VD, HYR, HYRC, a.in[opq(9)] + l * 64, a.in[opq(10)] + l * 64, a.in[opq(11)] + l * 64, a.in[opq(12)] + l * 64, ROPE};
            pg8::gemm_phase<EpiInProj, pg8::StaticOrder, PG8_ALIGN, PG8_SP2>(lds, g, S, E, wave0);
        }
        xcd_barrier(xbar, wave0);
        {
            PHASE_IDS
            LAS cf* X = (LAS cf*)lds; LAS float* RED = (LAS float*)(lds + 135168);
            const float* cw = a.in[opq(17)] + l * 3 * 768; const float* cb = a.in[opq(18)] + l * 768; const float* hb_ = a.in[opq(26)] + l * 512;
            for (int rep_ = 0; rep_ < REP_HY; ++rep_) for (int c = vcu; c < 256; c += G) {
                const float wv0 = cw[c], wv1 = cw[768 + c], wv2 = cw[1536 + c], bv = cb[c];
                const float wa0 = cw[256 + c], wa1 = cw[768 + 256 + c], wa2 = cw[1536 + 256 + c], ba = cb[256 + c];
                const float wb0 = cw[512 + c], wb1 = cw[768 + 512 + c], wb2 = cw[1536 + 512 + c], bb = cb[512 + c];
                const float bias1 = hb_[c], bias2 = hb_[256 + c];
                cf* KF = KFB + (size_t)c * 2 * FFTN;
                const int cw = 8 * (lane & 7) + (lane >> 3);
                for (int o = 0; o < 2; ++o) {
                    const float* hf = FILT + ((size_t)(0 * 2 + o) * 256 + c) * 8192; const float* hb = FILT + ((size_t)(1 * 2 + o) * 256 + c) * 8192;
                    float s = 0.f; for (int i = tid; i < 8192; i += NTHR) s += fabsf(hf[i]) + fabsf(hb[i]);
                    s = block_sum(s, RED, tid); const float inv = 1.0f / (s + EPSF);
                    for (int i = tid; i < 8192; i += NTHR) { X[PX(i)] = mk2(hf[i] * inv, 0.f); X[PX(8192 + i)] = (i == 0) ? mk2(0.f, 0.f) : mk2(hb[8192 - i] * inv, 0.f); }
                    __syncthreads();
                    fft_fwd_lds(X, tid);
                    fft_last_fwd(X, tid, KF + o * FFTN, o == 0 ? bias1 : bias2, 1.0f / FFTN);
                }
                __threadfence(); __syncthreads();
                for (int bp = 0; bp < 2; ++bp) {
                    const int b0 = 2 * bp, b1 = b0 + 1;
                    const bf16_t* pv0 = HYR + ((size_t)b0 * 768 + c) * 8192; const bf16_t* pv1 = HYR + ((size_t)b1 * 768 + c) * 8192;
#pragma unroll 1
                    for (int k = 0; k < 2; ++k) { const int ch = 64 * (wave + 8 * k) + cw; float u0[8], u1[8];
                        conv8(pv0, ch, 8192, wv0, wv1, wv2, bv, u0); conv8(pv1, ch, 8192, wv0, wv1, wv2, bv, u1);
#pragma unroll
                        for (int e = 0; e < 8; ++e) { X[PX(8 * ch + e)] = mk2(u0[e], u1[e]); X[PX(8192 + 8 * ch + e)] = mk2(0.f, 0.f); } }
                    __syncthreads();
                    fft_fwd_lds(X, tid); fft_mid_mul(X, tid, KF); fft_inv_lds(X, tid);
#pragma unroll 1
                    for (int k = 0; k < 2; ++k) { const int ch = 64 * (wave + 8 * k) + cw; float a0_[8], a1_[8];
                        conv8(pv0 + 256 * 8192, ch, 8192, wa0, wa1, wa2, ba, a0_); conv8(pv1 + 256 * 8192, ch, 8192, wa0, wa1, wa2, ba, a1_);
#pragma unroll
                        for (int e = 0; e < 8; ++e) { const cf cv = X[PX(8 * ch + e)]; X[PX(8 * ch + e)] = mk2(a0_[e] * cv.x, a1_[e] * cv.y); X[PX(8192 + 8 * ch + e)] = mk2(0.f, 0.f); } }
                    __syncthreads();
                    fft_fwd_lds(X, tid); fft_mid_mul(X, tid, KF + FFTN); fft_inv_lds(X, tid);
#pragma unroll 1
                    for (int k = 0; k < 2; ++k) { const int ch = 64 * (wave + 8 * k) + cw; float x0_[8], x1_[8];
                        conv8(pv0 + 512 * 8192, ch, 8192, wb0, wb1, wb2, bb, x0_); conv8(pv1 + 512 * 8192, ch, 8192, wb0, wb1, wb2, bb, x1_);
                        f32x4 o0a, o0b, o1a, o1b;
#pragma unroll
                        for (int e = 0; e < 4; ++e) { const cf ca = X[PX(8 * ch + e)], cb2 = X[PX(8 * ch + 4 + e)]; o0a[e] = x0_[e] * ca.x; o1a[e] = x1_[e] * ca.y; o0b[e] = x0_[4 + e] * cb2.x; o1b[e] = x1_[4 + e] * cb2.y; }
                        float* y0p = YH + ((size_t)b0 * 256 + c) * 8192 + 8 * ch; float* y1p = YH + ((size_t)b1 * 256 + c) * 8192 + 8 * ch;
                        *(f32x4*)y0p = o0a; *(f32x4*)(y0p + 4) = o0b; *(f32x4*)y1p = o1a; *(f32x4*)(y1p + 4) = o1b; }
                    __syncthreads();
                }
                if (need_ctx) {
                    int tidc = tid; asm volatile("" : "+v"(tidc));
                    LAS float* KC = (LAS float*)lds; LAS float* U = KC + 1024; LAS float* XA = U + 1024; LAS float* XB = XA + 1024; LAS float* Z1 = XB + 1024;
                    for (int o = 0; o < 2; ++o) {
                        const float* hf = FILTC + ((size_t)(0 * 2 + o) * 256 + c) * 256; const float* hb = FILTC + ((size_t)(1 * 2 + o) * 256 + c) * 256;
                        const float f_ = tid < 256 ? hf[tid] : 0.f, b_ = tid < 256 ? hb[tid] : 0.f;
                        float s = fabsf(f_) + fabsf(b_);
                        s = block_sum(s, RED, tid); const float inv = 1.0f / (s + EPSF);
                        if (tid < 256) { KC[o * 512 + 255 + tid] = f_ * inv; if (tid > 0) KC[o * 512 + 255 - tid] = b_ * inv; }
                    }
#pragma unroll 1
                    for (int k = 0; k < 2; ++k) { const int i = tidc + 512 * k, b = i >> 8, t = i & 255; const bf16_t* p = HYRC + ((size_t)b * 768 + c) * 256;
                        U[i] = hy_in(p, t, 256, wv0, wv1, wv2, bv); XA[i] = hy_in(p + 256 * 256, t, 256, wa0, wa1, wa2, ba); XB[i] = hy_in(p + 512 * 256, t, 256, wb0, wb1, wb2, bb); }
                    __syncthreads();
#pragma unroll 1
                    for (int k = 0; k < 2; ++k) { const int i = tidc + 512 * k, b = i >> 8, t = i & 255; float acc = 0.f; const LAS float* kp = KC + 255 + t; const LAS float* up = U + b * 256;
#pragma unroll 8
                        for (int s = 0; s < 256; ++s) acc += kp[-s] * up[s];
                        Z1[i] = XA[i] * (acc + bias1 * U[i]); }
                    __syncthreads();
#pragma unroll 1
                    for (int k = 0; k < 2; ++k) { const int i = tidc + 512 * k, b = i >> 8, t = i & 255; float acc = 0.f; const LAS float* kp = KC + 512 + 255 + t; const LAS float* up = Z1 + b * 256;
#pragma unroll 8
                        for (int s = 0; s < 256; ++s) acc += kp[-s] * up[s];
                        YHC[((size_t)b * 256 + c) * 256 + t] = XB[i] * (acc + bias2 * Z1[i]); }
                    __syncthreads();
                }
            }
            for (int rep_ = 0; rep_ < REP_ATT; ++rep_) {
                const int nA = 16 * 32 + (need_ctx ? 16 : 0), nC = 32 * 32 + (need_ctx ? 32 : 0);
                for (int u = vcu; u < nA; u += G) {
                    const bool isc = u >= 16 * 32; const int hu = isc ? u - 16 * 32 : (u >> 5), qb = u & 31, b = hu >> 2, k = hu & 3, row0 = isc ? ML + b * 256 : b * 8192 + qb * 256;
                    attn_body::attn_unit<8, false, 256, 64, 64, 1280>((const attn_body::bf16*)(QA + k * 64 + (size_t)row0 * 256), (const attn_body::bf16*)(KA + (size_t)(b * 2 + (k >> 1)) * NKEY * 64), (const attn_body::bf16*)(VA + (size_t)(b * 2 + (k >> 1)) * NKEY * 64),
                        (attn_body::bf16*)(YRAW + k * 64 + (size_t)row0 * 1280), isc ? 4 : 132, (char*)lds_raw, wave0);
                }
                for (int u = vcu; u < nC; u += G) {
                    const bool isc = u >= 32 * 32; const int hu = isc ? u - 32 * 32 : (u >> 5), qb = u & 31, b = hu >> 3, h = (hu & 7) >> 1, j = hu & 1, row0 = isc ? ML + b * 256 : b * 8192 + qb * 256;
                    attn_body::attn_unit<8, true, 512, 64, 128, 1280>((const attn_body::bf16*)(QD + (h * 2 + j) * 64 + (size_t)row0 * 512), (const attn_body::bf16*)(KD + (size_t)(b * 8 + h * 2 + j) * NKEY * 64), (const attn_body::bf16*)(VD + (size_t)(b * 4 + h) * NKEY * 128),
                        (attn_body::bf16*)(YRAW + 256 + j * 512 + h * 128 + (size_t)row0 * 1280), isc ? 4 : 132, (char*)lds_raw, wave0);
                }
            }
        }
        xcd_barrier(xbar, wave0);
        for (int rep_ = 0; rep_ < REP_MERGE; ++rep_) {
            PHASE_IDS
            LAS float* S = (LAS float*)lds;
            const float* go = a.in[opq(27)] + l * 1024;
            const float lam = LAM[l], lam_init = 0.8f - 0.6f * expf(-0.3f * (float)l);
            const int ntile = need_ctx ? 528 : 512;
            for (int tl = bx; tl < ntile; tl += G) {
                const int r0 = tl * 64; const float* yb; int cstride;
                if (r0 < ML) { yb = YH + (size_t)(r0 >> 13) * 256 * 8192 + (r0 & 8191); cstride = 8192; } else { const int rr = r0 - ML; yb = YHC + (size_t)(rr >> 8) * 256 * 256 + (rr & 255); cstride = 256; }
                for (int i = 0; i < 32; ++i) { const int c = i * 8 + wave; S[lane * 257 + c] = yb[(size_t)c * cstride + lane]; }
                __syncthreads();
                for (int k = 0; k < 8; ++k) {
                    const int row = wave * 8 + k, r = r0 + row; const bf16_t* yr = YRAW + (size_t)r * 1280; bf16_t* hr = H + (size_t)r * 1024;
                    { const v2u w = *(const v2u*)(yr + 4 * lane); const float y0 = bflo(w.x), y1 = bfhi(w.x), y2 = bflo(w.y), y3 = bfhi(w.y);
                      const float ss = wave_sum(y0 * y0 + y1 * y1 + y2 * y2 + y3 * y3); const float rinv = 1.0f / sqrtf(ss * (1.0f / 256.0f) + EPSF);
                      const f32x4 g4 = *(const f32x4*)(go + 4 * lane); v2u o; o.x = pk2(y0 * rinv * g4.x, y1 * rinv * g4.y); o.y = pk2(y2 * rinv * g4.z, y3 * rinv * g4.w); *(v2u*)(hr + 4 * lane) = o; }
                    { const float y0 = S[row * 257 + 4 * lane], y1 = S[row * 257 + 4 * lane + 1], y2 = S[row * 257 + 4 * lane + 2], y3 = S[row * 257 + 4 * lane + 3];
                      const float ss = wave_sum(y0 * y0 + y1 * y1 + y2 * y2 + y3 * y3); const float rinv = 1.0f / sqrtf(ss * (1.0f / 256.0f) + EPSF);
                      const f32x4 g4 = *(const f32x4*)(go + 256 + 4 * lane); v2u o; o.x = pk2(y0 * rinv * g4.x, y1 * rinv * g4.y); o.y = pk2(y2 * rinv * g4.z, y3 * rinv * g4.w); *(v2u*)(hr + 256 + 4 * lane) = o; }
                    { const v4u w0 = *(const v4u*)(yr + 256 + 8 * lane), w1 = *(const v4u*)(yr + 768 + 8 * lane);
                      float d[8];
                      d[0] = bflo(w0.x) - lam * bflo(w1.x); d[1] = bfhi(w0.x) - lam * bfhi(w1.x); d[2] = bflo(w0.y) - lam * bflo(w1.y); d[3] = bfhi(w0.y) - lam * bfhi(w1.y);
                      d[4] = bflo(w0.z) - lam * bflo(w1.z); d[5] = bfhi(w0.z) - lam * bfhi(w1.z); d[6] = bflo(w0.w) - lam * bflo(w1.w); d[7] = bfhi(w0.w) - lam * bfhi(w1.w);
                      float ss = 0.f;
#pragma unroll
                      for (int q = 0; q < 8; ++q) ss += d[q] * d[q];
                      ss += shx(ss, 1, lane); ss += shx(ss, 2, lane); ss += shx(ss, 4, lane); ss += shx(ss, 8, lane);
                      const float rinv = (1.0f - lam_init) / sqrtf(ss * (1.0f / 128.0f) + EPSF);
                      const f32x4 ga = *(const f32x4*)(go + 512 + 8 * lane), gb = *(const f32x4*)(go + 512 + 8 * lane + 4);
                      v4u o; o.x = pk2(d[0] * rinv * ga.x, d[1] * rinv * ga.y); o.y = pk2(d[2] * rinv * ga.z, d[3] * rinv * ga.w); o.z = pk2(d[4] * rinv * gb.x, d[5] * rinv * gb.y); o.w = pk2(d[6] * rinv * gb.z, d[7] * rinv * gb.w);
                      *(v4u*)(hr + 512 + 8 * lane) = o; }
                }
                __syncthreads();
            }
        }
        xcd_barrier(xbar, wave0);
        for (int es_ = 0; es_ < EXTRA_SYNC; ++es_) xcd_barrier(xbar, wave0);
        const int M5 = need_ctx ? MT : ML;
        {
            pg8::Gemm g{H, WOUT, M5, 1024, 1024}; pg8::StaticOrder S; S.init(M5, 1024, G, cbx);
            EpiGateRes E{xl, OUT, xc, CTXX, modl + 2048, 0};
            pg8::gemm_phase<EpiGateRes, pg8::StaticOrder, PG8_ALIGN, PG8_SP2>(lds, g, S, E, wave0);
            for (int rep_ = 1; rep_ < REP_GEMM2; ++rep_) { EpiGateRes E2{OUT, OUT, CTXX, CTXX, (const float*)(wsb(a.ws) + 65536), 0}; pg8::gemm_phase<EpiGateRes, pg8::StaticOrder, PG8_ALIGN, PG8_SP2>(lds, g, S, E2, wave0); }
        }
        xcd_barrier(xbar, wave0);
        for (int rep_ = 0; rep_ < REP_N2; ++rep_) { PHASE_IDS norm_mod(OUT, CTXX, a.in[opq(5)] + l * 1024, modl, 3072, 4096, H, M5, gw, NGW, lane); }
        xcd_barrier(xbar, wave0);
        {
            const int ntm = (M5 + 247) / 248;
            pg8::Gemm g{H - 1024, WUP, ntm * 256, 2 * DFF, 1024}; pg8::StaticOrder S; S.init(ntm * 256, 2 * DFF, G, cbx);
            EpiGlu E{GB, a.in[opq(30)] + (size_t)l * 3 * DFF, a.in[opq(31)] + l * DFF, M5};
            pg8::gemm_phase<EpiGlu, pg8::StaticOrder, PG8_ALIGN, PG8_SP2, true>(lds, g, S, E, wave0);
        }
        xcd_barrier(xbar, wave0);
        {
            pg8::Gemm g{GB, WDN, M5, 1024, DFF}; pg8::StaticOrder S; S.init(M5, 1024, G, cbx);
            EpiGateRes E{OUT, OUT, CTXX, CTXX, modl + 5120, 0};
            pg8::gemm_phase<EpiGateRes, pg8::StaticOrder, PG8_ALIGN, PG8_SP2>(lds, g, S, E, wave0);
            if (l + 1 < DEPTH) { const int units = (M5 >> 8) * 4, first = units % G;
                if (cbx >= first) { PHASE_IDS __syncthreads(); prep_work(a, lds, l + 1, l + 1 < DEPTH - 1, cbx - first, G - first, true, false, tid, lane, wave); } }
        }
        xcd_barrier(xbar, wave0);
    }
}

extern "C" void kernel_launch(void* const* d_in, const int* in_sizes, int n_in, void* d_out, int out_size, void* d_ws, size_t ws_size, hipStream_t stream) {
    static int grid = 0;
    if (grid == 0) {
        if (n_in != 33 || out_size != ML * DMOD || ws_size < WS_END) { fprintf(stderr, "kernel_launch: unexpected shapes: n_in %d out %d ws %zu (need %zu)\n", n_in, out_size, ws_size, (size_t)WS_END); grid = -1; return; }
        int dev = 0, cus = 0, per_cu = 0;
        if (hipGetDevice(&dev) != hipSuccess || hipDeviceGetAttribute(&cus, hipDeviceAttributeMultiprocessorCount, dev) != hipSuccess) { grid = -1; return; }
        if (hipFuncSetAttribute((const void*)fwd_mega, hipFuncAttributeMaxDynamicSharedMemorySize, LDS_BYTES) != hipSuccess) { fprintf(stderr, "kernel_launch: hipFuncSetAttribute failed\n"); grid = -1; return; }
        if (hipOccupancyMaxActiveBlocksPerMultiprocessor(&per_cu, (const void*)fwd_mega, NTHR, LDS_BYTES) != hipSuccess || per_cu < 1) { fprintf(stderr, "kernel_launch: occupancy query says %d\n", per_cu); }
        (void)hipGetLastError();
        grid = cus;
    }
    if (grid < 0) return;
    Args a{};
    for (int i = 0; i < 33; ++i) a.in[i] = (const float*)d_in[i];
    a.out = (float*)d_out; a.ws = (unsigned char*)d_ws;
    if (hipMemsetAsync(d_ws, 0, 32768, stream) != hipSuccess) { fprintf(stderr, "kernel_launch: memset failed\n"); return; }
    void* args[] = {&a};
#if PROBE_PLAIN_LAUNCH
    hipLaunchKernelGGL(fwd_mega, dim3(grid), dim3(NTHR), LDS_BYTES, stream, a); const hipError_t e = hipPeekAtLastError(); (void)args;
#else
    const hipError_t e = hipLaunchCooperativeKernel((const void*)fwd_mega, dim3(grid), dim3(NTHR), args, LDS_BYTES, stream);
#endif
    if (e != hipSuccess) fprintf(stderr, "kernel_launch: cooperative launch failed: %s (grid %d)\n", hipGetErrorString(e), grid);
}
```

```cpp
#include <hip/hip_runtime.h>
#include <cstdio>
#include <cstdint>
__device__ __forceinline__ int lane_id_v() { int l; asm volatile("v_mbcnt_lo_u32_b32 %0, -1, 0\n\tv_mbcnt_hi_u32_b32 %0, -1, %0" : "=v"(l)); return l; }
namespace pg8 {
#define PG8_LAS __attribute__((address_space(3)))
typedef unsigned short bf16_t;
typedef short bf16x8 __attribute__((ext_vector_type(8)));
typedef float f32x4 __attribute__((ext_vector_type(4)));
typedef unsigned u32x4 __attribute__((ext_vector_type(4)));
constexpr int BM = 256, BK = 64, HALF = 128, HTB = HALF * BK * 2  , STAGE_BYTES = 8 * HTB, NXCD = 8, WGM = 8;

__host__ __device__ __forceinline__ int lds_byte(int r, int c) { const int st = (r >> 4) * 2 + (c >> 5), rr = r & 15, cc = c & 31, ob = rr * 64 + cc * 2; return st * 1024 + (ob ^ (((ob >> 9) & 1) << 5)); }
__host__ __device__ __forceinline__ void stage_rc(int b, int& R, int& C) { const int st = b / 1024, sb = b % 1024, swz = sb ^ (((sb >> 9) & 1) << 5); R = (st >> 1) * 16 + swz / 64; C = (st & 1) * 32 + (swz % 64) / 2; }
__host__ __device__ __forceinline__ int perm32(int rho) { const int n = rho >> 4, i = rho & 15; return 8 * (i >> 2) + 4 * n + (i & 3); }

struct Unit { int pm, pn; };
struct Gemm { const bf16_t* A; const bf16_t* Bt; int M, N, K; };

struct StaticOrder {
    int nM, nN, nwg, G, c;
    __host__ __device__ void init(int M, int N, int G_, int c_) { nM = M / BM; nN = N / BM; nwg = nM * nN; G = G_; c = c_; }
    __host__ __device__ bool next(int i, Unit& u) const {
        const long L = (long)i * G + c; if (L >= nwg) return false;
        int wgid = (int)L; { const int q = nwg / NXCD, r = nwg % NXCD, xcd = wgid % NXCD, off = wgid / NXCD; wgid = (xcd < r ? xcd * (q + 1) : r * (q + 1) + (xcd - r) * q) + off; }
        const int nig = WGM * nN, gid = wgid / nig, fm = gid * WGM, gsz = (nM - fm) < WGM ? (nM - fm) : WGM;
        u.pm = fm + ((wgid % nig) % gsz); u.pn = (wgid % nig) / gsz; return true;
    }
    __device__ __forceinline__ void a_ready(const Unit&) const {}
    __device__ __forceinline__ void done(const Unit&) const {}
};

__device__ __forceinline__ unsigned cvt_pk_bf16(float lo, float hi) { unsigned r; asm volatile("v_cvt_pk_bf16_f32 %0, %1, %2" : "=v"(r) : "v"(lo), "v"(hi)); return r; }
typedef float f32x2 __attribute__((ext_vector_type(2)));
__device__ __forceinline__ f32x2 gelu_pk(f32x2 v) {
    const f32x2 av = __builtin_elementwise_abs(v), d = av * 0.2316418882f + 1.0f;
    f32x2 t; t.x = __builtin_amdgcn_rcpf(d.x); t.y = __builtin_amdgcn_rcpf(d.y);
    f32x2 q = t * 0.5307027145f + (-0.7265760135f); q = q * t + 0.7107068705f; q = q * t + (-0.142248368f); q = q * t + 0.127414796f; q = q * t;
    const f32x2 s = (v * v) * (-0.72134752044f);
    f32x2 e; e.x = __builtin_amdgcn_exp2f(s.x); e.y = __builtin_amdgcn_exp2f(s.y);
    const f32x2 m = v * (q * e), r = v - m;
    f32x2 o; o.x = v.x < 0.f ? m.x : r.x; o.y = v.y < 0.f ? m.y : r.y; return o;
}

template <int ACT  > struct EpiBf16 {
    static constexpr bool PERM = true, AFTER_DRAIN = false; static_assert(ACT == 0 || ACT == 1, "EpiBf16: ACT is 0 (none) or 1 (gelu_pk)");
    bf16_t* O; int ldc; const float* bias; int split_cols; size_t split_stride; float scale0;
    __device__ __forceinline__ void operator()(const f32x4 (&acc)[2][2][4][2], const Unit& u, int wr, int wc, int fr, int fq) const {
        const int row0 = u.pm * BM + wr * 64 + fr; int colt = u.pn * BM; bf16_t* base = O;
        float sc = 1.f; if (split_cols) { const int t = colt / split_cols; base += (size_t)t * split_stride; colt -= t * split_cols; if (t == 0) sc = scale0; }
        const int col0 = colt + wc * 32 + 8 * fq, bcol0 = u.pn * BM + wc * 32 + 8 * fq;
        f32x4 bv[2][2];
#pragma unroll
        for (int bj = 0; bj < 2; ++bj)
#pragma unroll
            for (int n = 0; n < 2; ++n) bv[bj][n] = bias ? *(const f32x4*)(bias + bcol0 + bj * HALF + 4 * n) : (f32x4){0.f, 0.f, 0.f, 0.f};
#pragma unroll
        for (int ai = 0; ai < 2; ++ai)
#pragma unroll
            for (int m = 0; m < 4; ++m) { bf16_t* rowp = base + (size_t)(row0 + ai * HALF + m * 16) * ldc + col0;
#pragma unroll
                for (int bj = 0; bj < 2; ++bj) { f32x4 v0 = acc[ai][bj][m][0] + bv[bj][0], v1 = acc[ai][bj][m][1] + bv[bj][1];
                    if (ACT == 1) { f32x2 a = gelu_pk((f32x2){v0[0], v0[1]}), b = gelu_pk((f32x2){v0[2], v0[3]}), c = gelu_pk((f32x2){v1[0], v1[1]}), d = gelu_pk((f32x2){v1[2], v1[3]});
                        v0 = (f32x4){a.x, a.y, b.x, b.y}; v1 = (f32x4){c.x, c.y, d.x, d.y}; }
                    v0 = v0 * sc; v1 = v1 * sc; u32x4 w; w.x = cvt_pk_bf16(v0[0], v0[1]); w.y = cvt_pk_bf16(v0[2], v0[3]); w.z = cvt_pk_bf16(v1[0], v1[1]); w.w = cvt_pk_bf16(v1[2], v1[3]);
                    *(u32x4*)(rowp + bj * HALF) = w; } }
    }
};
template <class Epi, class Sched, bool ALIGN_EPI = false, bool SP2 = false, bool HALO = false>
__device__ __forceinline__ void gemm_phase(PG8_LAS unsigned char* lds, const Gemm g, const Sched& S, const Epi& E, const int wave0) {
    int tid_o = wave0 * 64 + lane_id_v(); asm volatile("" : "+v"(tid_o));
    const int tid = tid_o, wid = __builtin_amdgcn_readfirstlane(tid >> 6), lane = tid & 63, wr = wid >> 2, wc = wid & 3, fr = lane & 15, fq = lane >> 4;
    const int K = g.K, nt = K / BK;
    unsigned voffA[2], voffB[2];
#pragma unroll
    for (int i = 0; i < 2; ++i) { int R, C; stage_rc(tid * 16 + i * 8192, R, C); const int Rb = Epi::PERM ? ((R & ~31) + perm32(R & 31)) : R;
        voffA[i] = HALO ? (unsigned)(((R & 63) + 62 * (R >> 6)) * K + C) * 2u : (unsigned)(R * K + C) * 2u; voffB[i] = (unsigned)(Rb * K + C) * 2u; }
    const size_t kstep = (size_t)(BK * 2);
    const size_t hstep = (size_t)HALF * K * 2;
    const size_t tstep = 2 * hstep;
    const size_t hstepA = HALO ? (size_t)124 * K * 2 : hstep, tstepA = 2 * hstepA;
    const unsigned ldsw = (unsigned)wid * 1024u;
    const int aoff = lds_byte(wr * 64 + fr, fq * 8), boff = lds_byte(wc * 32 + fr, fq * 8);
#define PG8_SA(b, h) (((b) * 2 + (h)) * HTB)
#define PG8_SB(b, h) ((4 + (b) * 2 + (h)) * HTB)
#define PG8_STAGE(bufoff, gbase, voff) do { _Pragma("unroll") for (int _i = 0; _i < 2; ++_i) \
        __builtin_amdgcn_global_load_lds((const unsigned*)((const char*)(gbase) + (voff)[_i]), (PG8_LAS unsigned*)(lds + (bufoff) + ldsw + _i * 8192), 16, 0, 0); } while (0)
#define PG8_LDA(dst, b, h) do { _Pragma("unroll") for (int m = 0; m < 4; ++m) _Pragma("unroll") for (int k = 0; k < 2; ++k) dst[m][k] = *(const PG8_LAS bf16x8*)(lds + PG8_SA(b, h) + aoff + m * 2048 + k * 1024); } while (0)
#define PG8_LDB(dst, b, h) do { _Pragma("unroll") for (int n = 0; n < 2; ++n) _Pragma("unroll") for (int k = 0; k < 2; ++k) dst[n][k] = *(const PG8_LAS bf16x8*)(lds + PG8_SB(b, h) + boff + n * 2048 + k * 1024); } while (0)
#define PG8_MMA(ai, bj, At, Bt) do { __builtin_amdgcn_s_setprio(1); _Pragma("unroll") for (int m = 0; m < 4; ++m) _Pragma("unroll") for (int n = 0; n < 2; ++n) _Pragma("unroll") for (int k = 0; k < 2; ++k) \
        acc[ai][bj][m][n] = __builtin_amdgcn_mfma_f32_16x16x32_bf16(Bt[n][k], At[m][k], acc[ai][bj][m][n], 0, 0, 0); __builtin_amdgcn_s_setprio(0); } while (0)
#define PG8_WAIT_V(n) asm volatile("s_waitcnt vmcnt(" #n ")" ::: "memory")
#define PG8_WAIT_L(n) asm volatile("s_waitcnt lgkmcnt(" #n ")" ::: "memory")
#define PG8_BAR __builtin_amdgcn_s_barrier()
#define PG8_SCHED __builtin_amdgcn_sched_barrier(0)
    Unit cur, nxt; int ui = 0;
    if (!S.next(0, cur)) return;
    f32x4 acc[2][2][4][2];
#pragma unroll
    for (int a = 0; a < 2; ++a)
#pragma unroll
        for (int b = 0; b < 2; ++b)
#pragma unroll
            for (int m = 0; m < 4; ++m)
#pragma unroll
                for (int n = 0; n < 2; ++n) acc[a][b][m][n] = (f32x4){0.f, 0.f, 0.f, 0.f};
    bf16x8 At[4][2], B0[2][2], B1[2][2];
    const char* cA = (const char*)g.A + (size_t)cur.pm * tstepA; const char* cB = (const char*)g.Bt + (size_t)cur.pn * tstep;
    S.a_ready(cur);
    if constexpr (SP2) {
        PG8_STAGE(PG8_SB(0, 0), cB, voffB); PG8_STAGE(PG8_SB(0, 1), cB + hstep, voffB); PG8_STAGE(PG8_SA(0, 0), cA, voffA); PG8_STAGE(PG8_SA(0, 1), cA + hstepA, voffA);
        if (wr == 1) PG8_BAR;
        PG8_WAIT_V(2); PG8_BAR;
        PG8_STAGE(PG8_SB(1, 0), cB + kstep, voffB); PG8_STAGE(PG8_SA(1, 0), cA + kstep, voffA); PG8_STAGE(PG8_SB(1, 1), cB + hstep + kstep, voffB);
        PG8_WAIT_V(6); PG8_BAR;
    } else {
        PG8_STAGE(PG8_SB(0, 0), cB, voffB); PG8_STAGE(PG8_SA(0, 0), cA, voffA); PG8_STAGE(PG8_SB(0, 1), cB + hstep, voffB); PG8_STAGE(PG8_SA(0, 1), cA + hstepA, voffA);
        if (wr == 1) PG8_BAR;
        PG8_WAIT_V(4); PG8_BAR;
        PG8_STAGE(PG8_SB(1, 0), cB + kstep, voffB); PG8_STAGE(PG8_SA(1, 0), cA + kstep, voffA); PG8_STAGE(PG8_SB(1, 1), cB + hstep + kstep, voffB);
        PG8_WAIT_V(6); PG8_BAR;
    }
    for (;;) {
        const bool has_next = S.next(ui + 1, nxt);
        const char* nA = has_next ? (const char*)g.A + (size_t)nxt.pm * tstepA : cA; const char* nB = has_next ? (const char*)g.Bt + (size_t)nxt.pn * tstep : cB;
        for (int t = 0; t < nt; t += 2) {
            const bool last = (t == nt - 2);
            const char* a1 = cA + (size_t)(t + 1) * kstep;
            const char* a2 = last ? nA : cA + (size_t)(t + 2) * kstep; const char* b2 = last ? nB : cB + (size_t)(t + 2) * kstep;
            const char* a3 = a2 + kstep; const char* b3 = b2 + kstep;
            if (last && has_next) S.a_ready(nxt);
            if constexpr (SP2) {
            PG8_LDB(B0, 0, 0); PG8_LDB(B1, 0, 1); PG8_SCHED; PG8_LDA(At, 0, 0); PG8_STAGE(PG8_SA(1, 1), a1 + hstepA, voffA);
            PG8_WAIT_V(8); PG8_WAIT_L(0); PG8_BAR; PG8_MMA(0, 0, At, B0); PG8_MMA(0, 1, At, B1); PG8_BAR; PG8_SCHED;
            PG8_LDA(At, 0, 1); PG8_STAGE(PG8_SB(0, 0), b2, voffB); PG8_STAGE(PG8_SB(0, 1), b2 + hstep, voffB); PG8_STAGE(PG8_SA(0, 0), a2, voffA);
            PG8_WAIT_V(8); PG8_WAIT_L(0); PG8_BAR; PG8_MMA(1, 0, At, B0); PG8_MMA(1, 1, At, B1); PG8_BAR; PG8_SCHED;
            PG8_LDB(B0, 1, 0); PG8_LDB(B1, 1, 1); PG8_SCHED; PG8_LDA(At, 1, 0); PG8_STAGE(PG8_SA(0, 1), a2 + hstepA, voffA);
            PG8_WAIT_V(8); PG8_WAIT_L(0); PG8_BAR; PG8_MMA(0, 0, At, B0); PG8_MMA(0, 1, At, B1); PG8_BAR; PG8_SCHED;
            PG8_LDA(At, 1, 1); PG8_STAGE(PG8_SB(1, 0), b3, voffB); PG8_STAGE(PG8_SB(1, 1), b3 + hstep, voffB); PG8_STAGE(PG8_SA(1, 0), a3, voffA);
            PG8_WAIT_V(8); PG8_WAIT_L(0); PG8_BAR; PG8_MMA(1, 0, At, B0); PG8_MMA(1, 1, At, B1); PG8_BAR; PG8_SCHED;
            } else {
            PG8_LDB(B0, 0, 0); PG8_SCHED; PG8_LDA(At, 0, 0); PG8_STAGE(PG8_SA(1, 1), a1 + hstepA, voffA);
            PG8_WAIT_L(8); PG8_BAR; PG8_WAIT_L(0); PG8_MMA(0, 0, At, B0); PG8_BAR; PG8_SCHED;
            PG8_LDB(B1, 0, 1); PG8_STAGE(PG8_SB(0, 0), b2, voffB);
            PG8_BAR; PG8_WAIT_L(0); PG8_MMA(0, 1, At, B1); PG8_BAR;
            PG8_LDA(At, 0, 1); PG8_STAGE(PG8_SA(0, 0), a2, voffA);
            PG8_BAR; PG8_WAIT_L(0); PG8_MMA(1, 0, At, B0); PG8_BAR; PG8_SCHED;
            PG8_STAGE(PG8_SB(0, 1), b2 + hstep, voffB);
            PG8_WAIT_V(6); PG8_BAR; PG8_MMA(1, 1, At, B1); PG8_BAR;
            PG8_LDB(B0, 1, 0); PG8_SCHED; PG8_LDA(At, 1, 0); PG8_STAGE(PG8_SA(0, 1), a2 + hstepA, voffA);
            PG8_WAIT_L(8); PG8_BAR; PG8_WAIT_L(0); PG8_MMA(0, 0, At, B0); PG8_BAR; PG8_SCHED;
            PG8_LDB(B1, 1, 1); PG8_STAGE(PG8_SB(1, 0), b3, voffB);
            PG8_BAR; PG8_WAIT_L(0); PG8_MMA(0, 1, At, B1); PG8_BAR;
            PG8_LDA(At, 1, 1); PG8_STAGE(PG8_SA(1, 0), a3, voffA);
            PG8_BAR; PG8_WAIT_L(0); PG8_MMA(1, 0, At, B0); PG8_BAR; PG8_SCHED;
            PG8_STAGE(PG8_SB(1, 1), b3 + hstep, voffB);
            PG8_WAIT_V(6); PG8_BAR; PG8_MMA(1, 1, At, B1); PG8_BAR;
            }
        }
        if constexpr (ALIGN_EPI) { if (wr == 0) PG8_BAR; }
        if constexpr (!Epi::AFTER_DRAIN) { E(acc, cur, wr, wc, fr, fq); S.done(cur); }
        if (!has_next) break;
#pragma unroll
        for (int a = 0; a < 2; ++a)
#pragma unroll
            for (int b = 0; b < 2; ++b)
#pragma unroll
                for (int m = 0; m < 4; ++m)
#pragma unroll
                    for (int n = 0; n < 2; ++n) acc[a][b][m][n] = (f32x4){0.f, 0.f, 0.f, 0.f};
        cur = nxt; cA = nA; cB = nB; ++ui;
        if constexpr (ALIGN_EPI) { if (wr == 1) PG8_BAR; }
    }
    PG8_WAIT_V(0);
    if constexpr (!ALIGN_EPI) { if (wr == 0) PG8_BAR; }
    PG8_BAR;
    if constexpr (Epi::AFTER_DRAIN) { E.fused(acc, cur, wr, wc, fr, fq, lds, wid, lane); S.done(cur); }
#undef PG8_SA
#undef PG8_SB
#undef PG8_STAGE
#undef PG8_LDA
#undef PG8_LDB
#undef PG8_MMA
#undef PG8_WAIT_V
#undef PG8_WAIT_L
#undef PG8_BAR
#undef PG8_SCHED
}
}

#ifndef PG8_SP2
#define PG8_SP2 true
#endif
#ifndef PG8_ALIGN
#define PG8_ALIGN true
#endif
#include <hip/hip_bf16.h>
#include <cmath>
namespace attn_body {
using bf16=__hip_bfloat16;
using bf16x8=__attribute__((ext_vector_type(8)))short;
using s16x4=__attribute__((ext_vector_type(4)))short;
using f32x16=__attribute__((ext_vector_type(16)))float;
using u32x4=__attribute__((ext_vector_type(4)))unsigned;
constexpr int D=64;
constexpr int NW=8,QBLK=32,QB=QBLK*NW,KVBLK=64;
constexpr int ATTN_UNIT_ROWS=QB;
__device__ __forceinline__ int crow(int r,int hi){return (r&3)+8*(r>>2)+4*hi;}
#define SBAR() __builtin_amdgcn_sched_barrier(0)
__device__ __forceinline__ void cmask(f32x16&p0,f32x16&p1,int jb,int qrel,int hi){
  const float NEG=-INFINITY; int kb=64*jb+4*hi;
  #pragma unroll
  for(int r=0;r<16;++r){int kv=kb+(r&3)+8*(r>>2); if(kv>qrel)p0[r]=NEG; if(kv+32>qrel)p1[r]=NEG;}
}

constexpr int NSLOT=3, SLOTB=8192;
constexpr int LDS_K=0, LDS_V=NSLOT*SLOTB, LDS_WS=2*NSLOT*SLOTB, LDS_OST=LDS_WS+NW*64*4, LDS_BYTES=LDS_OST+NW*4096;
constexpr float C2=0.125f*1.4426950408889634f;
__device__ __forceinline__ void glds16(const void*gsrc,unsigned lds_dst){unsigned keep;
  asm volatile("s_mov_b32 %0, m0\n\ts_mov_b32 m0, %2\n\ts_nop 0\n\tglobal_load_lds_dwordx4 %1, off\n\ts_mov_b32 m0, %0":"=&s"(keep):"v"(gsrc),"s"(lds_dst):"memory");}
__device__ __forceinline__ float max3f(float a,float b,float c){float r;asm("v_max3_f32 %0, %1, %2, %3":"=v"(r):"v"(a),"v"(b),"v"(c));return r;}
__device__ __forceinline__ float max2f(float a,float b){float r;asm("v_max_f32_e32 %0, %1, %2":"=v"(r):"v"(a),"v"(b));return r;}
__device__ __forceinline__ float fadd_s(float a,float b){float r;asm("v_add_f32_e32 %0, %1, %2":"=v"(r):"v"(a),"v"(b));return r;}
__device__ __forceinline__ float fsub_s(float a,float b){float r;asm("v_sub_f32_e32 %0, %1, %2":"=v"(r):"v"(a),"v"(b));return r;}
typedef float f32x2_t __attribute__((ext_vector_type(2))); typedef __bf16 bf16x2_t __attribute__((ext_vector_type(2)));
__device__ __forceinline__ unsigned cvtpk_s(float lo,float hi){f32x2_t v={lo,hi};bf16x2_t b=__builtin_convertvector(v,bf16x2_t);return __builtin_bit_cast(unsigned,b);}
#define WAIT_BAR(N) asm volatile("s_waitcnt vmcnt(" #N ") lgkmcnt(0)\n\ts_barrier":::"memory")

__device__ __forceinline__ void qkt(f32x16&p0,f32x16&p1,const char*Kslot,const bf16x8*qr,const f32x16&negm,int r32,int hi){
  const char*kb=Kslot+hi*1024+r32*16;
  #pragma unroll
  for(int d0=0;d0<4;++d0){
    const bf16x8 b0=*reinterpret_cast<const bf16x8*>(kb+d0*2048);
    const bf16x8 b1=*reinterpret_cast<const bf16x8*>(kb+d0*2048+512);
    if(d0==0){p0=__builtin_amdgcn_mfma_f32_32x32x16_bf16(b0,qr[0],negm,0,0,0);p1=__builtin_amdgcn_mfma_f32_32x32x16_bf16(b1,qr[0],negm,0,0,0);}
    else{p0=__builtin_amdgcn_mfma_f32_32x32x16_bf16(b0,qr[d0],p0,0,0,0);p1=__builtin_amdgcn_mfma_f32_32x32x16_bf16(b1,qr[d0],p1,0,0,0);}}
}
typedef __attribute__((address_space(3))) const char* lds_cptr;
typedef short v4i16_t __attribute__((ext_vector_type(4)));
__device__ __forceinline__ void kload8(bf16x8*kf,lds_cptr kp){
  kf[0]=*(const __attribute__((address_space(3))) bf16x8*)(kp);      kf[1]=*(const __attribute__((address_space(3))) bf16x8*)(kp+512);
  kf[2]=*(const __attribute__((address_space(3))) bf16x8*)(kp+2048); kf[3]=*(const __attribute__((address_space(3))) bf16x8*)(kp+2560);
  kf[4]=*(const __attribute__((address_space(3))) bf16x8*)(kp+4096); kf[5]=*(const __attribute__((address_space(3))) bf16x8*)(kp+4608);
  kf[6]=*(const __attribute__((address_space(3))) bf16x8*)(kp+6144); kf[7]=*(const __attribute__((address_space(3))) bf16x8*)(kp+6656);
}
__device__ __forceinline__ void kload2(bf16x8*kf,lds_cptr kp,int j){ kf[2*j]=*(const __attribute__((address_space(3))) bf16x8*)(kp+j*2048); kf[2*j+1]=*(const __attribute__((address_space(3))) bf16x8*)(kp+j*2048+512); }
__device__ __forceinline__ s16x4 vtr(lds_cptr p){ return __builtin_bit_cast(s16x4,__builtin_amdgcn_ds_read_tr16_b64_v4i16((__attribute__((address_space(3))) v4i16_t*)p)); }
__device__ __forceinline__ float rowmax(const f32x16&p0,const f32x16&p1){
  float a=max3f(p0[0],p0[1],p1[0]),b=max3f(p0[2],p0[3],p1[1]);a=max3f(a,p1[2],p1[3]);
  #pragma unroll
  for(int r=4;r<16;r+=4){a=max3f(a,p0[r],p0[r+1]);b=max3f(b,p0[r+2],p0[r+3]);a=max3f(a,p1[r],p1[r+1]);b=max3f(b,p1[r+2],p1[r+3]);}
  const float m=max2f(a,b);
  auto rr=__builtin_amdgcn_permlane32_swap(__float_as_uint(m),__float_as_uint(m),false,false);
  return max2f(__uint_as_float(rr[0]),__uint_as_float(rr[1]));
}
__device__ __forceinline__ void pv(f32x16*o,int vb,bf16x8 pa0,bf16x8 pa1,bf16x8 pa2,bf16x8 pa3){
  #pragma unroll
  for(int d0=0;d0<2;++d0){s16x4 lo[4],hi[4];
    #pragma unroll
    for(int ks=0;ks<4;++ks){
      asm volatile("ds_read_b64_tr_b16 %0,%1 offset:%c2":"=&v"(lo[ks]):"v"(vb),"i"(d0*4096+ks*1024):"memory");
      asm volatile("ds_read_b64_tr_b16 %0,%1 offset:%c2":"=&v"(hi[ks]):"v"(vb),"i"(d0*4096+ks*1024+512):"memory");}
    asm volatile("s_waitcnt lgkmcnt(0)":::"memory");SBAR();
    #define PK(k) (bf16x8){lo[k][0],lo[k][1],lo[k][2],lo[k][3],hi[k][0],hi[k][1],hi[k][2],hi[k][3]}
    o[d0]=__builtin_amdgcn_mfma_f32_32x32x16_bf16(pa0,PK(0),o[d0],0,0,0);
    o[d0]=__builtin_amdgcn_mfma_f32_32x32x16_bf16(pa1,PK(1),o[d0],0,0,0);
    o[d0]=__builtin_amdgcn_mfma_f32_32x32x16_bf16(pa2,PK(2),o[d0],0,0,0);
    o[d0]=__builtin_amdgcn_mfma_f32_32x32x16_bf16(pa3,PK(3),o[d0],0,0,0);
    #undef PK
  }
}

#ifndef ATTN_STORE16
#define ATTN_STORE16(p,v) (*(u32x4*)(p)=(v))
#endif
template<int THRL,bool DV128,int PQ,int PK,int PV,int PO> __device__ __forceinline__ void attn_unit(const bf16*Qb,const bf16*__restrict__ Kb,const bf16*__restrict__ Vb,bf16*Ob,const int NT,char*shm,const int wave0){
  int tid_o=wave0*64+lane_id_v(); asm volatile("":"+v"(tid_o)); const int tid=tid_o,lane=tid&63,r32=lane&31,hi=lane>>5; const int wid=__builtin_amdgcn_readfirstlane(tid>>6);
  const bf16*Qw=Qb+(long)(wid*QBLK)*PQ;
  const bf16*Kh=Kb,*Vh=Vb;
  const unsigned lds0=(unsigned)(uintptr_t)shm;
  constexpr int VS=DV128?2:1, L_WS=LDS_V+NSLOT*SLOTB*VS, L_OST=L_WS+NW*64*4;
  float*wsf=(float*)(shm+L_WS)+wid*64;
  const bf16*ksrc=Kh+(long)lane*PK+wid*8;
  const bf16*vsrc=Vh+(long)(16*(wid&3)+(lane>>2))*PV+(wid>>2)*32+(lane&3)*8;
  const unsigned kdst=lds0+LDS_K+wid*1024, vdst=lds0+LDS_V+wid*1024;
  #define DMA_K(t,slot) glds16(ksrc+(long)(t)*KVBLK*PK,(unsigned)__builtin_amdgcn_readfirstlane(kdst+(slot)))
  #define DMA_V(t,slot) do{ glds16(vsrc+(long)(t)*KVBLK*PV,(unsigned)__builtin_amdgcn_readfirstlane(vdst+VS*(slot))); if constexpr(DV128){ glds16(vsrc+64+(long)(t)*KVBLK*PV,(unsigned)__builtin_amdgcn_readfirstlane(vdst+VS*(slot)+8192)); } }while(0)
  const char*Kbase=shm+LDS_K; bf16x8 kf[8];
  const lds_cptr shm3=(lds_cptr)shm; const lds_cptr kp0=shm3+LDS_K+hi*1024+r32*16; const lds_cptr vp0=shm3+LDS_V+((lane>>4)&1)*32+(lane&3)*8+(4*hi+((lane&15)>>2))*64;
  DMA_K(0,0);DMA_V(0,0);DMA_K(1,SLOTB);
  bf16x8 qr[4];
  #pragma unroll
  for(int d0=0;d0<4;++d0)qr[d0]=*reinterpret_cast<const bf16x8*>(&Qw[(long)r32*PQ+d0*16+hi*8]);
  float mhat=0.f,l_reg=0.f;f32x16 o[4];o[0]=f32x16{};o[1]=f32x16{};o[2]=f32x16{};o[3]=f32x16{};f32x16 negm=f32x16{};asm volatile("":"+v"(negm));
  #define CMASK(P0,P1,t) do{}while(0)
  bool resc=false;
  #define START(P0,P1) do{ const float rm=rowmax(P0,P1); resc=false; \
    { const float dl=rm; mhat=fadd_s(mhat,dl); \
      _Pragma("unroll") for(int r=0;r<16;++r){P0[r]=fsub_s(P0[r],dl);P1[r]=fsub_s(P1[r],dl);} \
      _Pragma("unroll") for(int r=0;r<16;++r)negm[r]=-mhat; asm volatile("":"+v"(negm)); } \
    _Pragma("unroll") for(int r=0;r<16;++r)P0[r]=__builtin_amdgcn_exp2f(P0[r]); }while(0)
  #define RESC() do{ if(resc){ asm volatile("s_waitcnt lgkmcnt(0)":::"memory"); \
      _Pragma("unroll") for(int d_=0;d_<2*VS;++d_) _Pragma("unroll") for(int r=0;r<16;++r)o[d_][r]*=wsf[crow(r,hi)]; } }while(0)
  f32x16 pA0,pA1,pB0,pB1;
  int sl_prev=0,sl_cur=0,sl_next=SLOTB;
  #define ROT() do{sl_prev=sl_cur;sl_cur=sl_next;sl_next=(sl_next==(NSLOT-1)*SLOTB)?0:sl_next+SLOTB;}while(0)
  DMA_K(2,2*SLOTB);
  WAIT_BAR(3);
  qkt(pA0,pA1,Kbase,qr,negm,r32,hi);asm volatile("s_nop 15\n\ts_nop 7":"+v"(pA0),"+v"(pA1));CMASK(pA0,pA1,0);
  START(pA0,pA1);
  _Pragma("unroll") for(int r=0;r<16;++r)pA1[r]=__builtin_amdgcn_exp2f(pA1[r]);
  WAIT_BAR(0);
  DMA_K(3,0);DMA_V(1,SLOTB);
  ROT();
  kload8(kf,kp0+sl_cur);
  #define WB2() do{ if constexpr(DV128){WAIT_BAR(3);}else{WAIT_BAR(2);} }while(0)
  #define WB1() do{ if constexpr(DV128){WAIT_BAR(2);}else{WAIT_BAR(1);} }while(0)
  WB2();
  s16x4 vlo[8],vhi[8]; u32x4 pw0,pw1,pw2,pw3;
  #define PKW(P,B) cvtpk_s(P[B],P[B+1])
  #define PAF(k) __builtin_bit_cast(bf16x8,pw##k)
  #define VFR(i) (bf16x8){vlo[i][0],vlo[i][1],vlo[i][2],vlo[i][3],vhi[i][0],vhi[i][1],vhi[i][2],vhi[i][3]}
  #define PIN(x) asm volatile("":"+v"(x))
  #define MX3(a,b,c) __builtin_fmaxf(__builtin_fmaxf((a),(b)),(c))
  #define GAPA(MF,A0,A1,A2,A3,W0,W1,PW) do{ MF; sacc+=A0; sacc+=A1; sacc+=A2; sacc+=A3; PIN(sacc); W0; W1; PIN(PW); SBAR(); }while(0)
  #define EX(v) __builtin_amdgcn_exp2f(v)
  #define GAPC(MF,X,B) do{ MF; X[B]=EX(X[B]); X[B+1]=EX(X[B+1]); PIN(X); SBAR(); }while(0)
  #define GAPB(MF,X,B) do{ MF; X[B]=EX(X[B]); X[B+1]=EX(X[B+1]); X[B+2]=EX(X[B+2]); X[B+3]=EX(X[B+3]); PIN(X); SBAR(); }while(0)
  #define VRD(i) do{ vlo[i]=vtr(vp_+(((i)>>2)*4096+((i)&3)*1024)); vhi[i]=vtr(vp_+(((i)>>2)*4096+((i)&3)*1024+512)); }while(0)
  #define KRD(G,j) do{ if(G){ kload2(kf,kp0+sl_next,j); SBAR(); } }while(0)
  #define STEP(C0,C1,P0,P1,t,GK,GV,GL) do{ SBAR(); \
    const lds_cptr vp_=vp0+VS*sl_prev; \
    VRD(0); SBAR(); float sacc=(P0[0]+P0[1]); \
    GAPA(C0=__builtin_amdgcn_mfma_f32_32x32x16_bf16(kf[0],qr[0],negm,0,0,0), P0[2],P0[3],P0[4],P0[5],     pw0[0]=PKW(P0,0), pw0[1]=PKW(P0,2), pw0); \
    VRD(4); SBAR(); GAPA(C1=__builtin_amdgcn_mfma_f32_32x32x16_bf16(kf[1],qr[0],negm,0,0,0), P0[6],P0[7],P0[8],P0[9],     pw0[2]=PKW(P0,4), pw0[3]=PKW(P0,6), pw0); \
    VRD(1); SBAR(); GAPA(C0=__builtin_amdgcn_mfma_f32_32x32x16_bf16(kf[2],qr[1],C0,0,0,0),   P0[10],P0[11],P0[12],P0[13], pw1[0]=PKW(P0,8), pw1[1]=PKW(P0,10), pw1); \
    VRD(5); SBAR(); GAPA(C1=__builtin_amdgcn_mfma_f32_32x32x16_bf16(kf[3],qr[1],C1,0,0,0),   P0[14],P0[15],P1[0],P1[1],   pw1[2]=PKW(P0,12),pw1[3]=PKW(P0,14), pw1); \
    VRD(2); SBAR(); GAPA(C0=__builtin_amdgcn_mfma_f32_32x32x16_bf16(kf[4],qr[2],C0,0,0,0),   P1[2],P1[3],P1[4],P1[5],     pw2[0]=PKW(P1,0), pw2[1]=PKW(P1,2), pw2); \
    VRD(6); SBAR(); GAPA(C1=__builtin_amdgcn_mfma_f32_32x32x16_bf16(kf[5],qr[2],C1,0,0,0),   P1[6],P1[7],P1[8],P1[9],     pw2[2]=PKW(P1,4), pw2[3]=PKW(P1,6), pw2); \
    VRD(3); SBAR(); GAPA(C0=__builtin_amdgcn_mfma_f32_32x32x16_bf16(kf[6],qr[3],C0,0,0,0),   P1[10],P1[11],P1[12],P1[13], pw3[0]=PKW(P1,8), pw3[1]=PKW(P1,10), pw3); \
    VRD(7); SBAR(); GAPA(C1=__builtin_amdgcn_mfma_f32_32x32x16_bf16(kf[7],qr[3],C1,0,0,0),   P1[14],P1[15],0.f,0.f,       pw3[2]=PKW(P1,12),pw3[3]=PKW(P1,14), pw3); \
    l_reg+=sacc; \
    if(GK){DMA_K((t)+3,sl_cur);} if(GV){DMA_V((t)+1,sl_next);} \
    CMASK(C0,C1,t); \
    { float a=MX3(C0[0],C0[1],C1[0]),b=MX3(C0[2],C0[3],C1[1]); a=MX3(a,C1[2],C1[3]); \
      _Pragma("unroll") for(int r=4;r<16;r+=4){a=MX3(a,C0[r],C0[r+1]);b=MX3(b,C0[r+2],C0[r+3]);a=MX3(a,C1[r],C1[r+1]);b=MX3(b,C1[r+2],C1[r+3]);} \
      float rm=__builtin_fmaxf(a,b); { auto rr=__builtin_amdgcn_permlane32_swap(__float_as_uint(rm),__float_as_uint(rm),false,false); rm=__builtin_fmaxf(__uint_as_float(rr[0]),__uint_as_float(rr[1])); } \
      resc=false; \
      if(__builtin_expect(__any(rm>(float)THRL),0)){ const float dl=__builtin_fmaxf(rm,0.f); mhat+=dl; \
        _Pragma("unroll") for(int r=0;r<16;++r){C0[r]-=dl;C1[r]-=dl;} \
        _Pragma("unroll") for(int r=0;r<16;++r)negm[r]=-mhat; asm volatile("":"+v"(negm)); \
        const float f=__builtin_amdgcn_exp2f(-dl); l_reg*=f; if(hi==0)wsf[r32]=f; resc=true; } } \
    SBAR(); \
    GAPB(o[0]=__builtin_amdgcn_mfma_f32_32x32x16_bf16(PAF(0),VFR(0),o[0],0,0,0), C0,0); \
    GAPB(o[1]=__builtin_amdgcn_mfma_f32_32x32x16_bf16(PAF(0),VFR(4),o[1],0,0,0), C0,4); \
    KRD(GL,0); GAPB(o[0]=__builtin_amdgcn_mfma_f32_32x32x16_bf16(PAF(1),VFR(1),o[0],0,0,0), C0,8); \
    KRD(GL,1); GAPB(o[1]=__builtin_amdgcn_mfma_f32_32x32x16_bf16(PAF(1),VFR(5),o[1],0,0,0), C0,12); \
    KRD(GL,2); GAPB(o[0]=__builtin_amdgcn_mfma_f32_32x32x16_bf16(PAF(2),VFR(2),o[0],0,0,0), C1,0); \
    KRD(GL,3); GAPB(o[1]=__builtin_amdgcn_mfma_f32_32x32x16_bf16(PAF(2),VFR(6),o[1],0,0,0), C1,4); \
    GAPB(o[0]=__builtin_amdgcn_mfma_f32_32x32x16_bf16(PAF(3),VFR(3),o[0],0,0,0), C1,8); \
    GAPB(o[1]=__builtin_amdgcn_mfma_f32_32x32x16_bf16(PAF(3),VFR(7),o[1],0,0,0), C1,12); \
    }while(0)
  #define VRD2(i) do{ vlo[i]=vtr(vp_+(8192+((i)>>2)*4096+((i)&3)*1024)); vhi[i]=vtr(vp_+(8192+((i)>>2)*4096+((i)&3)*1024+512)); }while(0)
  #define STEP128(C0,C1,P0,P1,t,GK,GV,GL) do{ SBAR(); \
    const lds_cptr vp_=vp0+VS*sl_prev; \
    float sacc=(P0[0]+P0[1]); \
    GAPA(C0=__builtin_amdgcn_mfma_f32_32x32x16_bf16(kf[0],qr[0],negm,0,0,0), P0[2],P0[3],P0[4],P0[5],     pw0[0]=PKW(P0,0), pw0[1]=PKW(P0,2), pw0); \
    GAPA(C1=__builtin_amdgcn_mfma_f32_32x32x16_bf16(kf[1],qr[0],negm,0,0,0), P0[6],P0[7],P0[8],P0[9],     pw0[2]=PKW(P0,4), pw0[3]=PKW(P0,6), pw0); \
    GAPA(C0=__builtin_amdgcn_mfma_f32_32x32x16_bf16(kf[2],qr[1],C0,0,0,0),   P0[10],P0[11],P0[12],P0[13], pw1[0]=PKW(P0,8), pw1[1]=PKW(P0,10), pw1); \
    GAPA(C1=__builtin_amdgcn_mfma_f32_32x32x16_bf16(kf[3],qr[1],C1,0,0,0),   P0[14],P0[15],P1[0],P1[1],   pw1[2]=PKW(P0,12),pw1[3]=PKW(P0,14), pw1); \
    GAPA(C0=__builtin_amdgcn_mfma_f32_32x32x16_bf16(kf[4],qr[2],C0,0,0,0),   P1[2],P1[3],P1[4],P1[5],     pw2[0]=PKW(P1,0), pw2[1]=PKW(P1,2), pw2); \
    GAPA(C1=__builtin_amdgcn_mfma_f32_32x32x16_bf16(kf[5],qr[2],C1,0,0,0),   P1[6],P1[7],P1[8],P1[9],     pw2[2]=PKW(P1,4), pw2[3]=PKW(P1,6), pw2); \
    GAPA(C0=__builtin_amdgcn_mfma_f32_32x32x16_bf16(kf[6],qr[3],C0,0,0,0),   P1[10],P1[11],P1[12],P1[13], pw3[0]=PKW(P1,8), pw3[1]=PKW(P1,10), pw3); \
    GAPA(C1=__builtin_amdgcn_mfma_f32_32x32x16_bf16(kf[7],qr[3],C1,0,0,0),   P1[14],P1[15],0.f,0.f,       pw3[2]=PKW(P1,12),pw3[3]=PKW(P1,14), pw3); \
    l_reg+=sacc; \
    if(GK){DMA_K((t)+3,sl_cur);} if(GV){DMA_V((t)+1,sl_next);} \
    CMASK(C0,C1,t); \
    { float a=MX3(C0[0],C0[1],C1[0]),b=MX3(C0[2],C0[3],C1[1]); a=MX3(a,C1[2],C1[3]); \
      _Pragma("unroll") for(int r=4;r<16;r+=4){a=MX3(a,C0[r],C0[r+1]);b=MX3(b,C0[r+2],C0[r+3]);a=MX3(a,C1[r],C1[r+1]);b=MX3(b,C1[r+2],C1[r+3]);} \
      float rm=__builtin_fmaxf(a,b); { auto rr=__builtin_amdgcn_permlane32_swap(__float_as_uint(rm),__float_as_uint(rm),false,false); rm=__builtin_fmaxf(__uint_as_float(rr[0]),__uint_as_float(rr[1])); } \
      resc=false; \
      if(__builtin_expect(__any(rm>(float)THRL),0)){ const float dl=__builtin_fmaxf(rm,0.f); mhat+=dl; \
        _Pragma("unroll") for(int r=0;r<16;++r){C0[r]-=dl;C1[r]-=dl;} \
        _Pragma("unroll") for(int r=0;r<16;++r)negm[r]=-mhat; asm volatile("":"+v"(negm)); \
        const float f=__builtin_amdgcn_exp2f(-dl); l_reg*=f; if(hi==0)wsf[r32]=f; resc=true; } } \
    SBAR(); \
    VRD(0); VRD(4); VRD(1); VRD(5); SBAR(); \
    GAPC(o[0]=__builtin_amdgcn_mfma_f32_32x32x16_bf16(PAF(0),VFR(0),o[0],0,0,0), C0,0); VRD(2); SBAR(); \
    GAPC(o[1]=__builtin_amdgcn_mfma_f32_32x32x16_bf16(PAF(0),VFR(4),o[1],0,0,0), C0,2); VRD(6); SBAR(); \
    KRD(GL,0); GAPC(o[0]=__builtin_amdgcn_mfma_f32_32x32x16_bf16(PAF(1),VFR(1),o[0],0,0,0), C0,4); VRD(3); SBAR(); \
    KRD(GL,1); GAPC(o[1]=__builtin_amdgcn_mfma_f32_32x32x16_bf16(PAF(1),VFR(5),o[1],0,0,0), C0,6); VRD(7); SBAR(); \
    KRD(GL,2); GAPC(o[0]=__builtin_amdgcn_mfma_f32_32x32x16_bf16(PAF(2),VFR(2),o[0],0,0,0), C0,8); VRD2(0); SBAR(); \
    KRD(GL,3); GAPC(o[1]=__builtin_amdgcn_mfma_f32_32x32x16_bf16(PAF(2),VFR(6),o[1],0,0,0), C0,10); VRD2(4); SBAR(); \
    GAPC(o[0]=__builtin_amdgcn_mfma_f32_32x32x16_bf16(PAF(3),VFR(3),o[0],0,0,0), C0,12); VRD2(1); SBAR(); \
    GAPC(o[1]=__builtin_amdgcn_mfma_f32_32x32x16_bf16(PAF(3),VFR(7),o[1],0,0,0), C0,14); VRD2(5); SBAR(); \
    GAPC(o[2]=__builtin_amdgcn_mfma_f32_32x32x16_bf16(PAF(0),VFR(0),o[2],0,0,0), C1,0); VRD2(2); SBAR(); \
    GAPC(o[3]=__builtin_amdgcn_mfma_f32_32x32x16_bf16(PAF(0),VFR(4),o[3],0,0,0), C1,2); VRD2(6); SBAR(); \
    GAPC(o[2]=__builtin_amdgcn_mfma_f32_32x32x16_bf16(PAF(1),VFR(1),o[2],0,0,0), C1,4); VRD2(3); SBAR(); \
    GAPC(o[3]=__builtin_amdgcn_mfma_f32_32x32x16_bf16(PAF(1),VFR(5),o[3],0,0,0), C1,6); VRD2(7); SBAR(); \
    GAPC(o[2]=__builtin_amdgcn_mfma_f32_32x32x16_bf16(PAF(2),VFR(2),o[2],0,0,0), C1,8); \
    GAPC(o[3]=__builtin_amdgcn_mfma_f32_32x32x16_bf16(PAF(2),VFR(6),o[3],0,0,0), C1,10); \
    GAPC(o[2]=__builtin_amdgcn_mfma_f32_32x32x16_bf16(PAF(3),VFR(3),o[2],0,0,0), C1,12); \
    GAPC(o[3]=__builtin_amdgcn_mfma_f32_32x32x16_bf16(PAF(3),VFR(7),o[3],0,0,0), C1,14); \
    }while(0)
  #define STEPX(...) do{ if constexpr(DV128){ STEP128(__VA_ARGS__); } else { STEP(__VA_ARGS__); } }while(0)
  int t=1;
  #undef CMASK
  #define CMASK(P0,P1,t) do{}while(0)
  for(;t+5<NT;t+=2){
    STEPX(pB0,pB1,pA0,pA1,t,true,true,true);     WB2(); RESC(); ROT();
    STEPX(pA0,pA1,pB0,pB1,t+1,true,true,true);   WB2(); RESC(); ROT();
  }
  #undef CMASK
  #define CMASK(P0,P1,t) do{}while(0)
  #define ENDW(tt) do{ if((tt)+3<NT){WB2();} else if((tt)+2<NT){WB1();} else {WAIT_BAR(0);} }while(0)
  for(;t+1<NT;t+=2){
    STEPX(pB0,pB1,pA0,pA1,t,(t+3<NT),(t+1<NT),(t+1<NT));       ENDW(t);   RESC(); ROT();
    STEPX(pA0,pA1,pB0,pB1,t+1,(t+4<NT),(t+2<NT),(t+2<NT));     ENDW(t+1); RESC(); ROT();
  }
  STEPX(pB0,pB1,pA0,pA1,NT-1,false,false,false); RESC();
  { float sacc=pB0[0]+pB0[1]; _Pragma("unroll") for(int r=2;r<16;++r)sacc+=pB0[r]; _Pragma("unroll") for(int r=0;r<16;++r)sacc+=pB1[r]; l_reg+=sacc;
    pw0=(u32x4){PKW(pB0,0),PKW(pB0,2),PKW(pB0,4),PKW(pB0,6)};pw1=(u32x4){PKW(pB0,8),PKW(pB0,10),PKW(pB0,12),PKW(pB0,14)};pw2=(u32x4){PKW(pB1,0),PKW(pB1,2),PKW(pB1,4),PKW(pB1,6)};pw3=(u32x4){PKW(pB1,8),PKW(pB1,10),PKW(pB1,12),PKW(pB1,14)};
    int lane_d=lane; asm volatile("":"+v"(lane_d)); const int vb0=(int)(lds0+LDS_V)+((lane_d>>4)&1)*32+(lane_d&3)*8+(4*(lane_d>>5)+((lane_d&15)>>2))*64;
    SBAR(); pv(o,vb0+VS*sl_cur,PAF(0),PAF(1),PAF(2),PAF(3)); if constexpr(DV128){ pv(o+2,vb0+VS*sl_cur+8192,PAF(0),PAF(1),PAF(2),PAF(3)); } }
  #undef PKW
  #undef PAF
  #undef VFR
  #undef PIN
  #undef MX3
  #undef GAPA
  #undef GAPB
  #undef GAPC
  #undef EX
  #undef VRD
  #undef KRD
  #undef STEP
  #undef STEP128
  #undef STEPX
  #undef VRD2
  #undef WB2
  #undef WB1
  #undef ENDW
  {auto rr=__builtin_amdgcn_permlane32_swap(__float_as_uint(l_reg),__float_as_uint(l_reg),false,false);l_reg=__uint_as_float(rr[0])+__uint_as_float(rr[1]);}
  if(hi==0)wsf[32+r32]=l_reg;asm volatile("s_waitcnt lgkmcnt(0)":::"memory");
  float rli[16];
  #pragma unroll
  for(int r=0;r<16;++r)rli[r]=__builtin_amdgcn_rcpf(wsf[32+crow(r,hi)]);
  bf16*Ow=Ob+(long)(wid*QBLK)*PO;
  { bf16*stg=(bf16*)(shm+L_OST)+wid*2048;
    #pragma unroll
    for(int hf=0;hf<VS;++hf){
      #pragma unroll
      for(int r=0;r<16;++r){const int orow=crow(r,hi);
        #pragma unroll
        for(int d0=0;d0<2;++d0)stg[orow*64+d0*32+r32]=__float2bfloat16(o[2*hf+d0][r]*rli[r]);}
      asm volatile("s_waitcnt lgkmcnt(0)":::"memory");
      #pragma unroll
      for(int i=0;i<4;++i){const int row=i*8+(lane>>3),ch=lane&7; const u32x4 v=*(const u32x4*)(stg+row*64+ch*8); ATTN_STORE16(Ow+(long)row*PO+hf*64+ch*8,v);}
      asm volatile("s_waitcnt lgkmcnt(0)":::"memory"); } }
  asm volatile("s_waitcnt lgkmcnt(0)\n\ts_barrier":::"memory");
  #undef DMA_K
  #undef DMA_V
  #undef CMASK
  #undef START
  #undef RESC
  #undef ROT
}
constexpr int ATTN_LDS_BYTES=LDS_BYTES;
#undef SBAR
#undef WAIT_BAR
}
#include <hip/hip_cooperative_groups.h>
namespace cg = cooperative_groups;
#define LAS __attribute__((address_space(3)))
typedef unsigned short bf16_t;
typedef unsigned v4u __attribute__((ext_vector_type(4)));
typedef unsigned v2u __attribute__((ext_vector_type(2)));
typedef float f32x4 __attribute__((ext_vector_type(4)));
typedef float cf __attribute__((ext_vector_type(2)));

constexpr int NTHR = 512;
constexpr int DMOD = 1024, NBATCH = 4, SEQ = 8192, CTXL = 256, DEPTH = 4;
constexpr int ML = NBATCH * SEQ, MC = NBATCH * CTXL, MT = ML + MC;
constexpr int INW = 2816, DFF = 2816, NKEY = SEQ + CTXL;
constexpr float EPSF = 1e-6f;
constexpr int FFTN = 16384;

constexpr size_t MiB = 1u << 20;
constexpr size_t WS_MOD = 1 * MiB;
constexpr size_t WS_LAM = 1 * MiB + 512 * 1024;
constexpr size_t WS_ROPE = WS_LAM + 256;
constexpr size_t WS_TW = 1 * MiB + 768 * 1024;
constexpr size_t WS_WIN = 2 * MiB, WS_WOUT = WS_WIN + (size_t)INW * 1024 * 2, WS_WUP = WS_WOUT + 2 * MiB, WS_WDN = WS_WUP + (size_t)2 * DFF * 1024 * 2;
constexpr size_t WS_CTXX = 26 * MiB;
constexpr size_t WS_FILT = 30 * MiB, WS_FILTC = 62 * MiB;
constexpr size_t WS_H = 64 * MiB;
constexpr size_t WS_KF = 64 * MiB;
constexpr size_t WS_RAW = 130 * MiB;
constexpr size_t WS_YRAW = 130 * MiB;
constexpr size_t WS_YH = 213 * MiB, WS_YHC = 245 * MiB;
constexpr size_t WS_QA = 312 * MiB, WS_KA = 329 * MiB, WS_VA = 338 * MiB, WS_QD = 347 * MiB, WS_KD = 380 * MiB, WS_VD = 413 * MiB;
constexpr size_t WS_HYR = 446 * MiB, WS_HYRC = 494 * MiB;
constexpr size_t WS_G = 130 * MiB;
constexpr size_t WS_END = 496 * MiB;
static_assert(WS_WDN + (size_t)DFF * 1024 * 2 <= WS_CTXX, "weights");
static_assert(WS_H + (size_t)MT * 1024 * 2 <= WS_RAW && WS_RAW + (size_t)MT * INW * 2 <= WS_QA, "map1");
static_assert(WS_YRAW + (size_t)MT * 1280 * 2 <= WS_YH && WS_G + (size_t)MT * DFF * 2 <= WS_QA, "map2");
constexpr int LDS_BYTES = 147456;
#ifndef PHM
#define PHM 0xffff
#endif
#define PH(b) ((PHM >> (b)) & 1)
#ifndef REP_ATT
#define REP_ATT 1
#endif
#ifndef REP_HY
#define REP_HY 1
#endif
#ifndef REP_GEMM
#define REP_GEMM 1
#endif
#ifndef REP_PREP
#define REP_PREP 1
#endif
#ifndef REP_PP
#define REP_PP 1
#endif
#ifndef REP_MERGE
#define REP_MERGE 1
#endif
#ifndef REP_N2
#define REP_N2 1
#endif
#ifndef REP_GLU
#define REP_GLU 1
#endif
#ifndef REP_GEMM2
#define REP_GEMM2 1
#endif
#ifndef REP_PRO
#define REP_PRO 1
#endif
#ifndef PROBE_PLAIN_LAUNCH
#define PROBE_PLAIN_LAUNCH 0
#endif
#ifndef EXTRA_SYNC
#define EXTRA_SYNC 0
#endif

typedef float f32x2_cv __attribute__((ext_vector_type(2))); typedef __bf16 bf16x2_cv __attribute__((ext_vector_type(2)));
__device__ __forceinline__ unsigned pk2(float lo, float hi) { const f32x2_cv v = {lo, hi}; const bf16x2_cv b = __builtin_convertvector(v, bf16x2_cv); return __builtin_bit_cast(unsigned, b); }
__device__ __forceinline__ unsigned f2bf(float f) { return pk2(f, f) & 0xffffu; }

__device__ __forceinline__ float bf2f(bf16_t u) { return __uint_as_float((unsigned)u << 16); }
__device__ __forceinline__ float bflo(unsigned w) { return __uint_as_float(w << 16); }
__device__ __forceinline__ float bfhi(unsigned w) { return __uint_as_float(w & 0xffff0000u); }
__device__ __forceinline__ float shx(float v, int m, int lane) { return __builtin_bit_cast(float, __builtin_amdgcn_ds_bpermute((lane ^ m) << 2, __builtin_bit_cast(int, v))); }
template <int CTRL> __device__ __forceinline__ float dpp_mov(float v) { return __builtin_bit_cast(float, __builtin_amdgcn_update_dpp(0, __builtin_bit_cast(int, v), CTRL, 0xF, 0xF, false)); }
__device__ __forceinline__ float row16_sum(float v) {
    v += dpp_mov<0xB1>(v);
    v += dpp_mov<0x4E>(v);
    v += dpp_mov<0x141>(v);
    v += dpp_mov<0x140>(v);
    return v;
}
__device__ __forceinline__ float xrow_sum(float v) {
    { const auto rr = __builtin_amdgcn_permlane16_swap(__float_as_uint(v), __float_as_uint(v), false, false); v = __uint_as_float(rr[0]) + __uint_as_float(rr[1]); }
    { const auto rr = __builtin_amdgcn_permlane32_swap(__float_as_uint(v), __float_as_uint(v), false, false); v = __uint_as_float(rr[0]) + __uint_as_float(rr[1]); }
    return v;
}
__device__ __forceinline__ float wave_sum(float v) {
    return xrow_sum(row16_sum(v));
}
__device__ __forceinline__ float wave_sum_bperm(float v) {
    const int lane = lane_id_v();
#pragma unroll
    for (int o = 1; o < 64; o <<= 1) v += shx(v, o, lane);
    return v;
}
__device__ __forceinline__ float block_sum(float v, LAS float* RED, int tid) {
    v = wave_sum(v); __syncthreads(); if ((tid & 63) == 0) RED[tid >> 6] = v; __syncthreads();
    float s = 0.f;
#pragma unroll
    for (int w = 0; w < 8; ++w) s += RED[w];
    return s;
}

struct EpiGateRes {
    static constexpr bool PERM = false, AFTER_DRAIN = false;
    const float* base_lat; float* out_lat; const float* base_ctx; float* out_ctx; const float* gate; int row_off;
    __device__ __forceinline__ void operator()(const pg8::f32x4 (&acc)[2][2][4][2], const pg8::Unit& u, int wr, int wc, int fr, int fq) const {
        const int col0 = u.pn * 256 + wc * 32 + 4 * fq;
#pragma unroll
        for (int ai = 0; ai < 2; ++ai)
#pragma unroll
            for (int m = 0; m < 4; ++m) {
                const int r = row_off + u.pm * 256 + ai * 128 + wr * 64 + m * 16 + fr;
                const bool lat = r < ML; const int bi = lat ? (r >> 13) : 4;
                const size_t off = lat ? (size_t)r * 1024 : (size_t)(r - ML) * 1024;
                const float* bp = (lat ? base_lat : base_ctx) + off + col0; float* op = (lat ? out_lat : out_ctx) + off + col0;
                const float* gp = gate + bi * 6144 + col0;
#pragma unroll
                for (int bj = 0; bj < 2; ++bj)
#pragma unroll
                    for (int n = 0; n < 2; ++n) {
                        const pg8::f32x4 g4 = *(const pg8::f32x4*)(gp + bj * 128 + n * 16), b4 = *(const pg8::f32x4*)(bp + bj * 128 + n * 16);
                        *(pg8::f32x4*)(op + bj * 128 + n * 16) = b4 + g4 * acc[ai][bj][m][n];
                    }
            }
    }
};

__device__ __forceinline__ float dpp_ror1(float v) { return __builtin_bit_cast(float, __builtin_amdgcn_update_dpp(0, __builtin_bit_cast(int, v), 0x121, 0xF, 0xF, false)); }
__device__ __forceinline__ float dpp_rol1(float v) { return __builtin_bit_cast(float, __builtin_amdgcn_update_dpp(0, __builtin_bit_cast(int, v), 0x12F, 0xF, 0xF, false)); }
struct EpiGlu {
    static constexpr bool PERM = true, AFTER_DRAIN = false;
    bf16_t* G; const float* cw; const float* cb; int nrows;
    __device__ __forceinline__ void operator()(const pg8::f32x4 (&acc)[2][2][4][2], const pg8::Unit& u, int wr, int wc, int fr, int fq) const {
        const int ch0 = u.pn * 128 + wc * 32 + 8 * fq;
        float w0[8], w1[8], w2[8], bb[8];
#pragma unroll
        for (int hq = 0; hq < 2; ++hq) { const pg8::f32x4 q0 = *(const pg8::f32x4*)(cw + ch0 + 4 * hq), q1 = *(const pg8::f32x4*)(cw + DFF + ch0 + 4 * hq), q2 = *(const pg8::f32x4*)(cw + 2 * DFF + ch0 + 4 * hq), q3 = *(const pg8::f32x4*)(cb + ch0 + 4 * hq);
#pragma unroll
            for (int e = 0; e < 4; ++e) { w0[4 * hq + e] = q0[e]; w1[4 * hq + e] = q1[e]; w2[4 * hq + e] = q2[e]; bb[4 * hq + e] = q3[e]; } }
#pragma unroll
        for (int ai = 0; ai < 2; ++ai) {
            const int kb = u.pm * 4 + ai * 2 + wr;
            float ruP[8], rdC[8];
#pragma unroll
            for (int c = 0; c < 8; ++c) { ruP[c] = 0.f; rdC[c] = dpp_rol1(acc[ai][0][0][c >> 2][c & 3]); }
#pragma unroll
            for (int m = 0; m < 4; ++m) {
                const int rl = 16 * m + fr, gr = 62 * kb - 1 + rl;
                bool first, last; if (gr < ML) { const int t = gr & 8191; first = t == 0; last = t == 8191; } else { const int t = (gr - ML) & 255; first = t == 0; last = t == 255; }
                float res[8];
#pragma unroll
                for (int c = 0; c < 8; ++c) {
                    const int n = c >> 2, e = c & 3;
                    const float x0 = acc[ai][0][m][n][e];
                    const float ruC = dpp_ror1(x0), rdN = m < 3 ? dpp_rol1(acc[ai][0][m < 3 ? m + 1 : 3][n][e]) : 0.f;
                    float xu = fr == 0 ? ruP[c] : ruC, xd = fr == 15 ? rdN : rdC[c];
                    xu = first ? 0.f : xu; xd = last ? 0.f : xd;
                    ruP[c] = ruC; rdC[c] = rdN;
                    const float x = w0[c] * xu + w1[c] * x0 + w2[c] * xd + bb[c];
                    const float u2 = -2.302208198f * (x + 0.044715f * x * x * x);
                    res[c] = x * __builtin_amdgcn_rcpf(1.0f + __builtin_amdgcn_exp2f(u2)) * acc[ai][1][m][n][e];
                }
                if (rl >= 1 && rl <= 62 && gr < nrows) { v4u o; o.x = pk2(res[0], res[1]); o.y = pk2(res[2], res[3]); o.z = pk2(res[4], res[5]); o.w = pk2(res[6], res[7]);
                    *(v4u*)(G + (size_t)gr * DFF + ch0) = o; }
            }
        }
    }
};

struct EpiInProj {
    static constexpr bool PERM = true, AFTER_DRAIN = false;
    bf16_t *qa, *ka, *va, *qd, *kd, *vd, *hyr, *hyrc; const float *qn_a, *kn_a, *qn_d, *kn_d; const cf* rope;
    __device__ __forceinline__ void operator()(const pg8::f32x4 (&acc)[2][2][4][2], const pg8::Unit& u, int wr, int wc, int fr, int fq) const {
        const int pn = u.pn, lane = fr + 16 * fq;
        bool normed, keyrow; const float* gain = qn_a; float scale = 1.f; bf16_t* dbase; int dpitch, dcol, nh = 1, hidx = 0;
        if (pn == 0) { normed = true; gain = qn_a; scale = attn_body::C2; dbase = qa; dpitch = 256; keyrow = false; dcol = wc * 64; }
        else if (pn == 1) { keyrow = true; dpitch = 64; nh = 2; dcol = 0; if (wc < 2) { normed = true; gain = kn_a; dbase = ka; hidx = wc; } else { normed = false; dbase = va; hidx = wc - 2; } }
        else if (pn < 5) { normed = false; dbase = hyr; dpitch = 0; keyrow = false; dcol = (pn - 2) * 256 + wc * 64; }
        else if (pn < 7) { normed = true; gain = qn_d; scale = attn_body::C2; dbase = qd; dpitch = 512; keyrow = false; dcol = ((pn - 5) * 4 + wc) * 64; }
        else if (pn < 9) { normed = true; gain = kn_d; dbase = kd; dpitch = 64; keyrow = true; nh = 8; hidx = (pn - 7) * 4 + wc; dcol = 0; }
        else { normed = false; dbase = vd; dpitch = 128; keyrow = true; nh = 4; hidx = (pn - 9) * 2 + (wc >> 1); dcol = (wc & 1) * 64; }
        pg8::f32x4 gg[2][2];
#pragma unroll
        for (int bj = 0; bj < 2; ++bj)
#pragma unroll
            for (int n = 0; n < 2; ++n) gg[bj][n] = *(const pg8::f32x4*)(gain + 32 * bj + 8 * fq + 4 * n);
#pragma unroll
        for (int ai = 0; ai < 2; ++ai)
#pragma unroll
            for (int m = 0; m < 4; ++m) {
                const int r = u.pm * 256 + ai * 128 + wr * 64 + m * 16 + fr;
                const bool lat = r < ML; int b, t; if (lat) { b = r >> 13; t = r & 8191; } else { b = (r - ML) >> 8; t = (r - ML) & 255; }
                const size_t drow = keyrow ? (size_t)(b * nh + hidx) * NKEY + (lat ? 256 + t : t) : (size_t)r;
                if (pn >= 2 && pn < 5) {
                    bf16_t* cbp = lat ? hyr + (size_t)b * 768 * 8192 + t : hyrc + (size_t)b * 768 * 256 + t; const size_t cst = lat ? 8192 : 256;
#pragma unroll
                    for (int bj = 0; bj < 2; ++bj)
#pragma unroll
                        for (int n = 0; n < 2; ++n)
#pragma unroll
                            for (int e = 0; e < 4; ++e) cbp[(size_t)(dcol + 32 * bj + 8 * fq + 4 * n + e) * cst] = (bf16_t)f2bf(acc[ai][bj][m][n][e]);
                    continue;
                }
                bf16_t* dp = dbase + drow * dpitch + dcol + 8 * fq;
                float rinv = 1.f;
                if (normed) { float ss = 0.f;
#pragma unroll
                    for (int bj = 0; bj < 2; ++bj)
#pragma unroll
                        for (int n = 0; n < 2; ++n) { const pg8::f32x4 x = acc[ai][bj][m][n]; ss += (x[0] * x[0] + x[1] * x[1]) + (x[2] * x[2] + x[3] * x[3]); }
                    ss = xrow_sum(ss);
                    rinv = scale * __builtin_amdgcn_rsqf(ss * (1.0f / 64.0f) + EPSF); }
#pragma unroll
                for (int bj = 0; bj < 2; ++bj) {
                    pg8::f32x4 y0 = acc[ai][bj][m][0], y1 = acc[ai][bj][m][1];
                    if (normed) {
                        y0 = y0 * rinv * gg[bj][0]; y1 = y1 * rinv * gg[bj][1];
                        if (lat) { const int p = bj == 0 ? (t >> 6) : (t & 63); const pg8::f32x4* rp = (const pg8::f32x4*)(rope + p * 16 + 4 * fq); const pg8::f32x4 c01 = rp[0], c23 = rp[1];
                            const pg8::f32x4 z0 = {y0[0] * c01[0] - y0[1] * c01[1], y0[0] * c01[1] + y0[1] * c01[0], y0[2] * c01[2] - y0[3] * c01[3], y0[2] * c01[3] + y0[3] * c01[2]};
                            const pg8::f32x4 z1 = {y1[0] * c23[0] - y1[1] * c23[1], y1[0] * c23[1] + y1[1] * c23[0], y1[2] * c23[2] - y1[3] * c23[3], y1[2] * c23[3] + y1[3] * c23[2]};
                            y0 = z0; y1 = z1; }
                    }
                    v4u o; o.x = pk2(y0[0], y0[1]); o.y = pk2(y0[2], y0[3]); o.z = pk2(y1[0], y1[1]); o.w = pk2(y1[2], y1[3]);
                    *(v4u*)(dp + 32 * bj) = o;
                }
            }
    }
};

template <int PERM_UP = 0> __device__ __forceinline__ void transpose_item(const float* W, int K, int N, bf16_t* WT, LAS float* scr, int item, int lane) {
    const int nblk = N / 32, kb = item / nblk, nb = item % nblk, k0 = 64 * kb, n0 = 32 * nb;
#pragma unroll 8
    for (int i = 0; i < 32; ++i) { const int kk = 2 * i + (lane >> 5); scr[kk * 33 + (lane & 31)] = W[(size_t)(k0 + kk) * N + n0 + (lane & 31)]; }
    asm volatile("s_waitcnt lgkmcnt(0)" ::: "memory");
    const int c = lane & 7;
#pragma unroll
    for (int j = 0; j < 4; ++j) { const int n = (lane >> 3) + 8 * j; const LAS float* s = scr + (8 * c) * 33 + n;
        v4u o; o.x = pk2(s[0 * 33], s[1 * 33]); o.y = pk2(s[2 * 33], s[3 * 33]); o.z = pk2(s[4 * 33], s[5 * 33]); o.w = pk2(s[6 * 33], s[7 * 33]);
        int row = n0 + n; if (PERM_UP == 2) { const int nl = row & 255; row = (row & ~255) + 128 * ((nl >> 5) & 1) + 32 * (nl >> 6) + (nl & 31); }
        if (PERM_UP == 1) { const bool isv = row >= DFF; const int ch = isv ? row - DFF : row; row = (ch >> 7) * 256 + (isv ? 128 : 0) + (ch & 127); }
        *(v4u*)(WT + (size_t)row * K + k0 + 8 * c) = o; }
    asm volatile("s_waitcnt lgkmcnt(0)" ::: "memory");
}

__device__ __forceinline__ void norm_mod(const float* xl, const float* xc, const float* g, const float* mod, int shoff, int scoff, bf16_t* H, int nrows, int gw, int NGW, int lane) {
    for (int r = gw; r < nrows; r += 4 * NGW) {
        int rr[4]; const float* xp[4]; const float* mp[4];
#pragma unroll
        for (int k = 0; k < 4; ++k) { const int rk = r + k * NGW; rr[k] = rk < nrows ? rk : r; xp[k] = rr[k] < ML ? xl + (size_t)rr[k] * 1024 : xc + (size_t)(rr[k] - ML) * 1024; mp[k] = mod + (rr[k] < ML ? (rr[k] >> 13) : 4) * 6144; }
        f32x4 v[4][4]; float ss[4];
#pragma unroll
        for (int k = 0; k < 4; ++k)
#pragma unroll
            for (int j = 0; j < 4; ++j) v[k][j] = ((const f32x4*)xp[k])[lane + 64 * j];
#pragma unroll
        for (int k = 0; k < 4; ++k) { ss[k] = 0.f;
#pragma unroll
            for (int j = 0; j < 4; ++j) ss[k] += (v[k][j].x * v[k][j].x + v[k][j].y * v[k][j].y) + (v[k][j].z * v[k][j].z + v[k][j].w * v[k][j].w); }
#pragma unroll
        for (int o = 1; o < 64; o <<= 1) {
#pragma unroll
            for (int k = 0; k < 4; ++k) { if (o == 1) ss[k] = wave_sum(ss[k]); } }
#pragma unroll
        for (int j = 0; j < 4; ++j) { const int col = 4 * lane + 256 * j;
            const f32x4 g4 = *(const f32x4*)(g + col);
#pragma unroll
            for (int k = 0; k < 4; ++k) { if (k == 0 || r + k * NGW < nrows) {
                const float rinv = 1.0f / sqrtf(ss[k] * (1.0f / 1024.0f) + EPSF);
                const f32x4 sc4 = *(const f32x4*)(mp[k] + scoff + col), sh4 = *(const f32x4*)(mp[k] + shoff + col); const f32x4 o = (v[k][j] * rinv * g4) * (sc4 + 1.0f) + sh4;
                v2u w; w.x = pk2(o.x, o.y); w.y = pk2(o.z, o.w); *(v2u*)(H + (size_t)rr[k] * 1024 + col) = w; } }
        }
    }
}

__device__ __forceinline__ cf mk2(float x, float y) { cf r; r.x = x; r.y = y; return r; }
__device__ __forceinline__ cf cmul(cf a, cf b) { return mk2(a.x * b.x - a.y * b.y, a.x * b.y + a.y * b.x); }
__device__ __forceinline__ cf cmulc(cf a, cf b) { return mk2(a.x * b.x + a.y * b.y, a.y * b.x - a.x * b.y); }
__device__ __forceinline__ cf ld_f2_l2(const cf* p) {
    const unsigned long long w = __hip_atomic_load((const unsigned long long*)p, __ATOMIC_RELAXED, __HIP_MEMORY_SCOPE_AGENT);
    return mk2(__uint_as_float((unsigned)w), __uint_as_float((unsigned)(w >> 32)));
}
__device__ __forceinline__ int PX(int i) { return i + (i >> 6); }
__device__ __forceinline__ cf twid(float frac) { return mk2(__builtin_amdgcn_cosf(frac), -__builtin_amdgcn_sinf(frac)); }
__device__ __forceinline__ void bfly4_fwd(cf& a0, cf& a1, cf& a2, cf& a3) {
    const cf s02 = a0 + a2, d02 = a0 - a2, s13 = a1 + a3, d13 = a1 - a3;
    a0 = s02 + s13; a2 = s02 - s13; a1 = mk2(d02.x + d13.y, d02.y - d13.x); a3 = mk2(d02.x - d13.y, d02.y + d13.x);
}
__device__ __forceinline__ void bfly4_inv(cf& a0, cf& a1, cf& a2, cf& a3) {
    const cf s02 = a0 + a2, d02 = a0 - a2, s13 = a1 + a3, d13 = a1 - a3;
    a0 = s02 + s13; a2 = s02 - s13; a1 = mk2(d02.x - d13.y, d02.y + d13.x); a3 = mk2(d02.x + d13.y, d02.y - d13.x);
}
template <int LG, bool INV> __device__ __forceinline__ void fft_pass2(LAS cf* X, int tid) {
    constexpr int L = 1 << LG, L16 = L >> 4, L4 = L >> 2; constexpr float fL = 1.0f / (float)L;
#pragma unroll 1
    for (int i = 0; i < 2; ++i) {
        const int it = tid + 512 * i; int g, j;
        if (LG == 14) { g = 0; j = it; } else if (LG == 10) { j = it & 63; g = it >> 6; } else { g = it & 255; j = it >> 8; }
        const int base = g * L + j;
        cf e[4][4];
#pragma unroll
        for (int r = 0; r < 4; ++r)
#pragma unroll
            for (int m = 0; m < 4; ++m) e[r][m] = X[PX(base + r * L16 + m * L4)];
        const cf v1 = twid((float)(4 * j) * fL), v2 = cmul(v1, v1), v3 = cmul(v2, v1);
        if (!INV) {
#pragma unroll
            for (int r = 0; r < 4; ++r) { bfly4_fwd(e[r][0], e[r][1], e[r][2], e[r][3]);
                const cf w1 = twid((float)(j + r * L16) * fL), w2 = cmul(w1, w1), w3 = cmul(w2, w1);
                e[r][1] = cmul(e[r][1], w1); e[r][2] = cmul(e[r][2], w2); e[r][3] = cmul(e[r][3], w3); }
#pragma unroll
            for (int p = 0; p < 4; ++p) { bfly4_fwd(e[0][p], e[1][p], e[2][p], e[3][p]); e[1][p] = cmul(e[1][p], v1); e[2][p] = cmul(e[2][p], v2); e[3][p] = cmul(e[3][p], v3); }
        } else {
#pragma unroll
            for (int p = 0; p < 4; ++p) { e[1][p] = cmulc(e[1][p], v1); e[2][p] = cmulc(e[2][p], v2); e[3][p] = cmulc(e[3][p], v3); bfly4_inv(e[0][p], e[1][p], e[2][p], e[3][p]); }
#pragma unroll
            for (int r = 0; r < 4; ++r) { const cf w1 = twid((float)(j + r * L16) * fL), w2 = cmul(w1, w1), w3 = cmul(w2, w1);
                e[r][1] = cmulc(e[r][1], w1); e[r][2] = cmulc(e[r][2], w2); e[r][3] = cmulc(e[r][3], w3); bfly4_inv(e[r][0], e[r][1], e[r][2], e[r][3]); }
        }
#pragma unroll
        for (int r = 0; r < 4; ++r)
#pragma unroll
            for (int m = 0; m < 4; ++m) X[PX(base + r * L16 + m * L4)] = e[r][m];
    }
    __syncthreads();
}
__device__ __forceinline__ void fft_last_fwd(LAS cf* X, int tid, cf* KFW, float bias, float scale) {
#pragma unroll 2
    for (int i = 0; i < 8; ++i) { const int it = tid + 512 * i, g = it & 255, k = it >> 8, base = g * 64 + 4 * k;
        cf e0 = X[PX(base)], e1 = X[PX(base + 1)], e2 = X[PX(base + 2)], e3 = X[PX(base + 3)];
        bfly4_fwd(e0, e1, e2, e3);
        if (KFW) { cf* o = KFW + (4 * k) * 256 + g; o[0] = mk2((e0.x + bias) * scale, e0.y * scale); o[256] = mk2((e1.x + bias) * scale, e1.y * scale); o[512] = mk2((e2.x + bias) * scale, e2.y * scale); o[768] = mk2((e3.x + bias) * scale, e3.y * scale); }
        else { X[PX(base)] = e0; X[PX(base + 1)] = e1; X[PX(base + 2)] = e2; X[PX(base + 3)] = e3; } }
    __syncthreads();
}
__device__ __forceinline__ void fft_first_inv_mul(LAS cf* X, int tid, const cf* KFR) {
#pragma unroll 2
    for (int i = 0; i < 8; ++i) { const int it = tid + 512 * i, g = it & 255, k = it >> 8, base = g * 64 + 4 * k; const cf* q = KFR + (4 * k) * 256 + g;
        cf e0 = cmul(X[PX(base)], ld_f2_l2(q)), e1 = cmul(X[PX(base + 1)], ld_f2_l2(q + 256)), e2 = cmul(X[PX(base + 2)], ld_f2_l2(q + 512)), e3 = cmul(X[PX(base + 3)], ld_f2_l2(q + 768));
        bfly4_inv(e0, e1, e2, e3);
        X[PX(base)] = e0; X[PX(base + 1)] = e1; X[PX(base + 2)] = e2; X[PX(base + 3)] = e3; }
    __syncthreads();
}
__device__ __forceinline__ void fft_mid_mul(LAS cf* X, int tid, const cf* KFR) {
#pragma unroll 2
    for (int i = 0; i < 8; ++i) { const int it = tid + 512 * i, g = it & 255, k = it >> 8, base = g * 64 + 4 * k; const cf* q = KFR + (4 * k) * 256 + g;
        cf e0 = X[PX(base)], e1 = X[PX(base + 1)], e2 = X[PX(base + 2)], e3 = X[PX(base + 3)];
        const cf k0 = ld_f2_l2(q), k1 = ld_f2_l2(q + 256), k2 = ld_f2_l2(q + 512), k3 = ld_f2_l2(q + 768);
        bfly4_fwd(e0, e1, e2, e3);
        e0 = cmul(e0, k0); e1 = cmul(e1, k1); e2 = cmul(e2, k2); e3 = cmul(e3, k3);
        bfly4_inv(e0, e1, e2, e3);
        X[PX(base)] = e0; X[PX(base + 1)] = e1; X[PX(base + 2)] = e2; X[PX(base + 3)] = e3; }
    __syncthreads();
}
__device__ __forceinline__ void fft_fwd_lds(LAS cf* X, int tid) { fft_pass2<14, false>(X, tid); fft_pass2<10, false>(X, tid); fft_pass2<6, false>(X, tid); }
__device__ __forceinline__ void fft_inv_lds(LAS cf* X, int tid) { fft_pass2<6, true>(X, tid); fft_pass2<10, true>(X, tid); fft_pass2<14, true>(X, tid); }
__device__ __forceinline__ void conv8(const bf16_t* p, int c, int n, float w0, float w1, float w2, float b, float (&o)[8]) {
    const v4u v = *(const v4u*)(p + 8 * c);
    const float um = c > 0 ? bf2f(p[8 * c - 1]) : 0.f, up = 8 * c + 8 < n ? bf2f(p[8 * c + 8]) : 0.f;
    const float u0 = bflo(v.x), u1 = bfhi(v.x), u2 = bflo(v.y), u3 = bfhi(v.y), u4 = bflo(v.z), u5 = bfhi(v.z), u6 = bflo(v.w), u7 = bfhi(v.w);
    o[0] = w0 * um + w1 * u0 + w2 * u1 + b; o[1] = w0 * u0 + w1 * u1 + w2 * u2 + b; o[2] = w0 * u1 + w1 * u2 + w2 * u3 + b; o[3] = w0 * u2 + w1 * u3 + w2 * u4 + b;
    o[4] = w0 * u3 + w1 * u4 + w2 * u5 + b; o[5] = w0 * u4 + w1 * u5 + w2 * u6 + b; o[6] = w0 * u5 + w1 * u6 + w2 * u7 + b; o[7] = w0 * u6 + w1 * u7 + w2 * up + b;
}
__device__ __forceinline__ float hy_in(const bf16_t* p, int t, int n, float w0, float w1, float w2, float b) {
    const float um = t > 0 ? bf2f(p[t - 1]) : 0.f, u0 = bf2f(p[t]), up = t < n - 1 ? bf2f(p[t + 1]) : 0.f;
    return w0 * um + w1 * u0 + w2 * up + b;
}

#define XB_TMO      128
#define XB_XCNT(j)  (256  + 64 * (j))
#define XB_XSUB(j)  (1280 + 64 * (j))
#define XB_XGEN(j)  (2304 + 64 * (j))
#define XB_TOP      3328
#define XB_TOPGEN   3392
#define XCD_BAR_WORDS 3456
#define XB_SPIN_CAP (1u << 18)

__device__ __forceinline__ unsigned xb_ld(unsigned* p)              { return __hip_atomic_load(p, __ATOMIC_RELAXED, __HIP_MEMORY_SCOPE_AGENT); }
__device__ __forceinline__ unsigned xb_add(unsigned* p, unsigned v) { return __hip_atomic_fetch_add(p, v, __ATOMIC_RELAXED, __HIP_MEMORY_SCOPE_AGENT); }
__device__ __forceinline__ unsigned xb_xcc_id() { return (unsigned)__builtin_amdgcn_s_getreg((3 << 11) | 20) & 0xFu; }
#define XB_SPIN(cond, bar) do { unsigned _sp = 0; while (cond) { __builtin_amdgcn_s_sleep(1); \
    if ((++_sp & 255u) == 0u) { if (xb_ld(&(bar)[XB_TMO])) break; if (_sp > XB_SPIN_CAP) { atomicAdd(&(bar)[XB_TMO], 1u); break; } } } } while (0)

struct XcdBarrier {
    unsigned* bar; unsigned x;
    volatile LAS unsigned* st;
};

__device__ __forceinline__ XcdBarrier xcd_barrier_post(unsigned* bar, volatile LAS unsigned* st) {
    XcdBarrier b; b.bar = bar; b.x = xb_xcc_id(); b.st = st;
    if (threadIdx.x == 0) (void)xb_add(&bar[XB_XCNT(b.x)], 1u);
    return b;
}
__device__ __forceinline__ void xcd_barrier_complete(unsigned* bar, unsigned x, unsigned& nloc, unsigned& nx) {
    const unsigned G = gridDim.x * gridDim.y * gridDim.z;
    unsigned sum, cnt, mine, sp = 0u;
    for (;;) {
        sum = 0u; cnt = 0u; mine = 0u;
#pragma unroll
        for (unsigned j = 0; j < 16; ++j) { const unsigned c = xb_ld(&bar[XB_XCNT(j)]); sum += c; cnt += (c > 0u) ? 1u : 0u; mine = (j == x) ? c : mine; }
        if (sum == G) break;
        __builtin_amdgcn_s_sleep(1);
        if ((++sp & 255u) == 0u) { if (xb_ld(&bar[XB_TMO])) break; if (sp > XB_SPIN_CAP) { atomicAdd(&bar[XB_TMO], 1u); break; } }
    }
    nloc = mine > 0u ? mine : 1u; nx = cnt > 0u ? cnt : 1u;
}

__device__ __forceinline__ void xcd_barrier(const XcdBarrier& b, const int wave0) {
    asm volatile("s_waitcnt vmcnt(0)" ::: "memory");
    __syncthreads();
    if (wave0 == 0 && lane_id_v() == 0) {
        unsigned* bar = b.bar;
        __builtin_amdgcn_s_waitcnt(0);
        unsigned nloc = b.st[0], nx = b.st[1];
        if (nloc == 0u) { xcd_barrier_complete(bar, b.x, nloc, nx); b.st[0] = nloc; b.st[1] = nx; }
        const unsigned old = xb_add(&bar[XB_XSUB(b.x)], 1u);
        const unsigned gen = old / nloc;
        if (old + 1u == (gen + 1u) * nloc) {
            __builtin_amdgcn_fence(__ATOMIC_RELEASE, "agent");
            asm volatile("s_waitcnt vmcnt(0)" ::: "memory");
            const unsigned og = xb_add(&bar[XB_TOP], 1u);
            const unsigned tg = og / nx;
            if (og + 1u == (tg + 1u) * nx) xb_add(&bar[XB_TOPGEN], 1u);
            else XB_SPIN(xb_ld(&bar[XB_TOPGEN]) == tg, bar);
            __builtin_amdgcn_fence(__ATOMIC_ACQUIRE, "agent");
            xb_add(&bar[XB_XGEN(b.x)], 1u);
            asm volatile("s_waitcnt vmcnt(0)" ::: "memory");
        } else {
            XB_SPIN(xb_ld(&bar[XB_XGEN(b.x)]) == gen, bar);
            __builtin_amdgcn_fence(__ATOMIC_ACQUIRE, "agent");
            asm volatile("s_waitcnt vmcnt(0)" ::: "memory");
        }
    }
    __syncthreads();
}


struct Args { const float* in[33]; float* out; unsigned char* ws; };
__device__ __forceinline__ unsigned char* wsb(unsigned char* p) { asm volatile("" : "+s"(p)); return p; }
__device__ __forceinline__ int opq(int i) { asm volatile("" : "+s"(i)); return i; }

#define MOD ((float*)(wsb(a.ws) + WS_MOD))
#define LAM ((float*)(wsb(a.ws) + WS_LAM))
#define ROPE ((cf*)(wsb(a.ws) + WS_ROPE))
#define TW ((cf*)(wsb(a.ws) + WS_TW))
#define WIN ((bf16_t*)(wsb(a.ws) + WS_WIN))
#define WOUT ((bf16_t*)(wsb(a.ws) + WS_WOUT))
#define WUP ((bf16_t*)(wsb(a.ws) + WS_WUP))
#define WDN ((bf16_t*)(wsb(a.ws) + WS_WDN))
#define CTXX ((float*)(wsb(a.ws) + WS_CTXX))
#define FILT ((float*)(wsb(a.ws) + WS_FILT))
#define FILTC ((float*)(wsb(a.ws) + WS_FILTC))
#define H ((bf16_t*)(wsb(a.ws) + WS_H))
#define KFB ((cf*)(wsb(a.ws) + WS_KF))
#define RAW ((bf16_t*)(wsb(a.ws) + WS_RAW))
#define YRAW ((bf16_t*)(wsb(a.ws) + WS_YRAW))
#define YH ((float*)(wsb(a.ws) + WS_YH))
#define YHC ((float*)(wsb(a.ws) + WS_YHC))
#define QA ((bf16_t*)(wsb(a.ws) + WS_QA))
#define KA ((bf16_t*)(wsb(a.ws) + WS_KA))
#define VA ((bf16_t*)(wsb(a.ws) + WS_VA))
#define QD ((bf16_t*)(wsb(a.ws) + WS_QD))
#define KD ((bf16_t*)(wsb(a.ws) + WS_KD))
#define VD ((bf16_t*)(wsb(a.ws) + WS_VD))
#define HYR ((bf16_t*)(wsb(a.ws) + WS_HYR))
#define HYRC ((bf16_t*)(wsb(a.ws) + WS_HYRC))
#define GB ((bf16_t*)(wsb(a.ws) + WS_G))
#define OUT (a.out)
__device__ __forceinline__ void prep_work(const Args& a, LAS unsigned char* lds, const int lp, const bool needc, const int widx, const int nwg, const bool do_main, const bool do_dn, const int tid, const int lane, const int wave) {
    LAS float* scr = (LAS float*)(lds + wave * 16384);
    constexpr int I_IN = 16 * 88, I_OUT = 16 * 32, I_UP = 16 * 176, I_DN = 44 * 32;
    for (int it = (do_main ? 0 : I_IN + I_OUT + I_UP) + widx * 8 + wave; it < (do_dn ? I_IN + I_OUT + I_UP + I_DN : I_IN + I_OUT + I_UP); it += nwg * 8) {
        int r = it;
        if (r < I_IN) { transpose_item<2>(a.in[opq(8)] + (size_t)lp * 1024 * INW, 1024, INW, WIN, scr, r, lane); continue; } r -= I_IN;
        if (r < I_OUT) { transpose_item(a.in[opq(28)] + (size_t)lp * 1024 * 1024, 1024, 1024, WOUT, scr, r, lane); continue; } r -= I_OUT;
        if (r < I_UP) { transpose_item<1>(a.in[opq(29)] + (size_t)lp * 1024 * 2 * DFF, 1024, 2 * DFF, WUP, scr, r, lane); continue; } r -= I_UP;
        transpose_item(a.in[opq(32)] + (size_t)lp * DFF * 1024, DFF, 1024, WDN, scr, r, lane);
    }
    __syncthreads();
    if (do_main) {
    const float* fw1 = a.in[opq(19)] + lp * 33 * 64; const float* fb1 = a.in[opq(20)] + lp * 64; const float* fw2 = a.in[opq(21)] + lp * 64 * 64; const float* fb2 = a.in[opq(22)] + lp * 64;
    const float* fw3 = a.in[opq(23)] + (size_t)lp * 64 * 1024; const float* fb3 = a.in[opq(24)] + lp * 1024; const float* freq = a.in[opq(25)] + lp * 64;
    LAS float* Z = (LAS float*)lds; LAS float* H1 = Z + 33 * 33; LAS float* H2 = H1 + 33 * 64; LAS float* W1 = H2 + 33 * 64; LAS float* W2 = W1 + 33 * 64; LAS float* FB = W2 + 64 * 64;
    for (int i = tid; i < 33 * 64; i += NTHR) W1[i] = fw1[i];
    for (int i = tid; i < 64 * 64; i += NTHR) W2[i] = fw2[i];
    if (tid < 64) { FB[tid] = fb1[tid]; FB[64 + tid] = fb2[tid]; FB[128 + tid] = freq[tid]; }
    const int npos = needc ? 33 : 32;
    for (int item = widx; item < 256; item += nwg) {
        __syncthreads();
        for (int i = tid; i < npos * 33; i += NTHR) { const int p = i / 33, e = i - p * 33; const bool isc = p == 32; const int n = isc ? item : item * 32 + p; const float NP = isc ? 256.0f : 8192.0f; float val;
            if (e == 0) val = (float)n / (NP - 1.0f);
            else { const int k = (e - 1) & 15; const float band = 1e-4f + (float)k * ((15.0f - 1e-4f) / 15.0f); const float w = 6.283185307179586f * (float)n / NP; const float arg = band * w;
                val = (e <= 16) ? cosf(arg) : -sinf(arg); }
            Z[i] = val; }
        __syncthreads();
        for (int i = tid; i < npos * 64; i += NTHR) { const int p = i >> 6, j = i & 63; float s = FB[j];
#pragma unroll
            for (int e = 0; e < 33; ++e) s += Z[p * 33 + e] * W1[e * 64 + j];
            H1[i] = sinf(FB[128 + j] * s); }
        __syncthreads();
        for (int i = tid; i < npos * 64; i += NTHR) { const int p = i >> 6, j = i & 63; float s = FB[64 + j];
#pragma unroll 16
            for (int e = 0; e < 64; ++e) s += H1[p * 64 + e] * W2[e * 64 + j];
            H2[i] = sinf(FB[128 + j] * s); }
        __syncthreads();
#pragma unroll 1
        for (int half = 0; half < 2; ++half) { const int q = tid + 512 * half, c = q & 255;
            float w[64];
#pragma unroll
            for (int e = 0; e < 64; ++e) w[e] = fw3[(size_t)e * 1024 + q];
            const float b3 = fb3[q], adelta = 3.0701134573253945f + (float)c * ((15.350567286626973f - 3.0701134573253945f) / 255.0f);
#pragma unroll 1
            for (int p = 0; p < npos; ++p) { float s = b3;
#pragma unroll
                for (int e = 0; e < 64; ++e) s += H2[p * 64 + e] * w[e];
                const bool isc = p == 32; const int n = isc ? item : item * 32 + p; const float t = (float)n / (isc ? 255.0f : 8191.0f);
                float* dst = isc ? FILTC + (size_t)q * 256 : FILT + (size_t)q * 8192;
                dst[n] = s * expf(-t * adelta); }
        }
    }
    __syncthreads();
    }
}

__global__ void __launch_bounds__(NTHR, 2) fwd_mega(Args a) {
    extern __shared__ __attribute__((aligned(16))) unsigned char lds_raw[];
    cg::grid_group grid = cg::this_grid();
    LAS unsigned char* lds = (LAS unsigned char*)lds_raw;
    const int G = gridDim.x, bx = blockIdx.x;
    const int NGW = G * 8;
const int wave0 = __builtin_amdgcn_readfirstlane(threadIdx.x >> 6);
#define PHASE_IDS int tid = wave0 * 64 + lane_id_v(); asm volatile("" : "+v"(tid)); const int lane = tid & 63, wave = __builtin_amdgcn_readfirstlane(tid >> 6); const int gw = bx * 8 + wave; (void)lane; (void)gw;

    volatile LAS unsigned* MISC = (volatile LAS unsigned*)(lds + 147392);
    if (threadIdx.x < 16) MISC[threadIdx.x] = 0u;
    __syncthreads();
    const XcdBarrier xbar = xcd_barrier_post((unsigned*)a.ws, MISC + 8);
    if (threadIdx.x == 0) MISC[2] = xb_add((unsigned*)a.ws + 4096 + 64 * xbar.x, 1u);
    {
        PHASE_IDS
        LAS float* S = (LAS float*)lds; LAS float* RED = S + 5 * 1024;
        const float* c = a.in[opq(1)]; const float* cctx = a.in[opq(3)];
        for (int i = tid; i < 5 * 1024; i += NTHR) { const float v = i < 4096 ? c[i] : cctx[i - 4096]; S[i] = v / (1.f + expf(-v)); }
        __syncthreads();
        const float* wmod = a.in[opq(6)]; const float* bmod = a.in[opq(7)];
        for (int item = bx; item < 384; item += G) {
            const int l = item / 96, cgi = item % 96, ks = tid >> 6, jl = tid & 63, col = cgi * 64 + jl;
            const float* w = wmod + ((size_t)l * 1024 + ks * 128) * 6144 + col;
            float a0 = 0.f, a1 = 0.f, a2 = 0.f, a3 = 0.f, a4 = 0.f;
#pragma unroll 8
            for (int k = 0; k < 128; ++k) { const float wv = w[(size_t)k * 6144]; const int kk = ks * 128 + k;
                a0 += S[kk] * wv; a1 += S[1024 + kk] * wv; a2 += S[2048 + kk] * wv; a3 += S[3072 + kk] * wv; a4 += S[4096 + kk] * wv; }
            RED[(ks * 5 + 0) * 64 + jl] = a0; RED[(ks * 5 + 1) * 64 + jl] = a1; RED[(ks * 5 + 2) * 64 + jl] = a2; RED[(ks * 5 + 3) * 64 + jl] = a3; RED[(ks * 5 + 4) * 64 + jl] = a4;
            __syncthreads();
            if (tid < 320) { const int bi = tid >> 6, j = tid & 63; float s = bmod[l * 6144 + cgi * 64 + j];
#pragma unroll
                for (int k2 = 0; k2 < 8; ++k2) s += RED[(k2 * 5 + bi) * 64 + j];
                MOD[((size_t)l * 5 + bi) * 6144 + cgi * 64 + j] = s; }
            __syncthreads();
        }
        if (bx == 0 && wave < 4) { const int l = wave;
            const float s1 = wave_sum(a.in[opq(13)][l * 64 + lane] * a.in[opq(14)][l * 64 + lane]), s2 = wave_sum(a.in[opq(15)][l * 64 + lane] * a.in[opq(16)][l * 64 + lane]);
            if (lane == 0) LAM[l] = expf(s1) - expf(s2) + (0.8f - 0.6f * expf(-0.3f * (float)l)); }
        const int gt = bx * NTHR + tid;
        if (gt < 2048) { const int p = gt >> 4, f = gt & 15; const float inv = powf(10000.0f, -(float)f / 16.0f); float sn, cs; sincosf((float)p * inv, &sn, &cs); ROPE[gt] = mk2(cs, sn); }
        for (int m = gt; m < FFTN; m += G * NTHR) { float sn, cs; sincospif((float)m / 8192.0f, &sn, &cs); TW[m] = mk2(cs, -sn); }
    }
    if (PROBE_PLAIN_LAUNCH) xcd_barrier(xbar, wave0); else grid.sync();
    if (threadIdx.x == 0) {
        bool ok = (G % 8 == 0) && xbar.x < 8u;
        for (int j = 0; j < 8; ++j) ok = ok && (xb_ld((unsigned*)a.ws + 4096 + 64 * j) == (unsigned)(G / 8));
        const unsigned rk = MISC[2];
        MISC[0] = ok ? rk * 8u + xbar.x : (unsigned)bx;
        MISC[1] = ok ? xbar.x * (unsigned)(G / 8) + rk : (unsigned)((G % 8 == 0) ? (bx % 8) * (G / 8) + bx / 8 : bx);
    }
    __syncthreads();
    const int cbx = __builtin_amdgcn_readfirstlane((int)MISC[0]), vcu = __builtin_amdgcn_readfirstlane((int)MISC[1]);

    for (int l = 0; l < DEPTH; ++l) {
        const bool need_ctx = l < DEPTH - 1;
        const float* xl = l == 0 ? a.in[opq(0)] : OUT; const float* xc = l == 0 ? a.in[opq(2)] : CTXX;
        const float* modl = MOD + (size_t)l * 5 * 6144;
        for (int rep_ = 0; rep_ < REP_PREP; ++rep_) {
            PHASE_IDS
            __syncthreads();
            prep_work(a, lds, l, need_ctx, bx, G, l == 0, true, tid, lane, wave);
            norm_mod(xl, xc, a.in[opq(4)] + l * 1024, modl, 0, 1024, H, MT, gw, NGW, lane);
        }
        xcd_barrier(xbar, wave0);
        {
            pg8::Gemm g{H, WIN, MT, INW, 1024}; pg8::StaticOrder S; S.init(MT, INW, G, cbx);
            EpiInProj E{QA, KA, VA, QD, KD, VD, HYR, HYRC, a.in[opq(9)] + l * 64, a.in[opq(10)] + l * 64, a.in[opq(11)] + l * 64, a.in[opq(12)] + l * 64, ROPE};
            pg8::gemm_phase<EpiInProj, pg8::StaticOrder, PG8_ALIGN, PG8_SP2>(lds, g, S, E, wave0);
        }
        xcd_barrier(xbar, wave0);
        {
            PHASE_IDS
            LAS cf* X = (LAS cf*)lds; LAS float* RED = (LAS float*)(lds + 135168);
            const float* cw = a.in[opq(17)] + l * 3 * 768; const float* cb = a.in[opq(18)] + l * 768; const float* hb_ = a.in[opq(26)] + l * 512;
            for (int rep_ = 0; rep_ < REP_HY; ++rep_) for (int c = vcu; c < 256; c += G) {
                const float wv0 = cw[c], wv1 = cw[768 + c], wv2 = cw[1536 + c], bv = cb[c];
                const float wa0 = cw[256 + c], wa1 = cw[768 + 256 + c], wa2 = cw[1536 + 256 + c], ba = cb[256 + c];
                const float wb0 = cw[512 + c], wb1 = cw[768 + 512 + c], wb2 = cw[1536 + 512 + c], bb = cb[512 + c];
                const float bias1 = hb_[c], bias2 = hb_[256 + c];
                cf* KF = KFB + (size_t)c * 2 * FFTN;
                const int cw = 8 * (lane & 7) + (lane >> 3);
                for (int o = 0; o < 2; ++o) {
                    const float* hf = FILT + ((size_t)(0 * 2 + o) * 256 + c) * 8192; const float* hb = FILT + ((size_t)(1 * 2 + o) * 256 + c) * 8192;
                    float s = 0.f; for (int i = tid; i < 8192; i += NTHR) s += fabsf(hf[i]) + fabsf(hb[i]);
                    s = block_sum(s, RED, tid); const float inv = 1.0f / (s + EPSF);
                    for (int i = tid; i < 8192; i += NTHR) { X[PX(i)] = mk2(hf[i] * inv, 0.f); X[PX(8192 + i)] = (i == 0) ? mk2(0.f, 0.f) : mk2(hb[8192 - i] * inv, 0.f); }
                    __syncthreads();
                    fft_fwd_lds(X, tid);
                    fft_last_fwd(X, tid, KF + o * FFTN, o == 0 ? bias1 : bias2, 1.0f / FFTN);
                }
                __threadfence(); __syncthreads();
                for (int bp = 0; bp < 2; ++bp) {
                    const int b0 = 2 * bp, b1 = b0 + 1;
                    const bf16_t* pv0 = HYR + ((size_t)b0 * 768 + c) * 8192; const bf16_t* pv1 = HYR + ((size_t)b1 * 768 + c) * 8192;
#pragma unroll 1
                    for (int k = 0; k < 2; ++k) { const int ch = 64 * (wave + 8 * k) + cw; float u0[8], u1[8];
                        conv8(pv0, ch, 8192, wv0, wv1, wv2, bv, u0); conv8(pv1, ch, 8192, wv0, wv1, wv2, bv, u1);
#pragma unroll
                        for (int e = 0; e < 8; ++e) { X[PX(8 * ch + e)] = mk2(u0[e], u1[e]); X[PX(8192 + 8 * ch + e)] = mk2(0.f, 0.f); } }
                    __syncthreads();
                    fft_fwd_lds(X, tid); fft_mid_mul(X, tid, KF); fft_inv_lds(X, tid);
#pragma unroll 1
                    for (int k = 0; k < 2; ++k) { const int ch = 64 * (wave + 8 * k) + cw; float a0_[8], a1_[8];
                        conv8(pv0 + 256 * 8192, ch, 8192, wa0, wa1, wa2, ba, a0_); conv8(pv1 + 256 * 8192, ch, 8192, wa0, wa1, wa2, ba, a1_);
#pragma unroll
                        for (int e = 0; e < 8; ++e) { const cf cv = X[PX(8 * ch + e)]; X[PX(8 * ch + e)] = mk2(a0_[e] * cv.x, a1_[e] * cv.y); X[PX(8192 + 8 * ch + e)] = mk2(0.f, 0.f); } }
                    __syncthreads();
                    fft_fwd_lds(X, tid); fft_mid_mul(X, tid, KF + FFTN); fft_inv_lds(X, tid);
#pragma unroll 1
                    for (int k = 0; k < 2; ++k) { const int ch = 64 * (wave + 8 * k) + cw; float x0_[8], x1_[8];
                        conv8(pv0 + 512 * 8192, ch, 8192, wb0, wb1, wb2, bb, x0_); conv8(pv1 + 512 * 8192, ch, 8192, wb0, wb1, wb2, bb, x1_);
                        f32x4 o0a, o0b, o1a, o1b;
#pragma unroll
                        for (int e = 0; e < 4; ++e) { const cf ca = X[PX(8 * ch + e)], cb2 = X[PX(8 * ch + 4 + e)]; o0a[e] = x0_[e] * ca.x; o1a[e] = x1_[e] * ca.y; o0b[e] = x0_[4 + e] * cb2.x; o1b[e] = x1_[4 + e] * cb2.y; }
                        float* y0p = YH + ((size_t)b0 * 256 + c) * 8192 + 8 * ch; float* y1p = YH + ((size_t)b1 * 256 + c) * 8192 + 8 * ch;
                        *(f32x4*)y0p = o0a; *(f32x4*)(y0p + 4) = o0b; *(f32x4*)y1p = o1a; *(f32x4*)(y1p + 4) = o1b; }
                    __syncthreads();
                }
                if (need_ctx) {
                    int tidc = tid; asm volatile("" : "+v"(tidc));
                    LAS float* KC = (LAS float*)lds; LAS float* U = KC + 1024; LAS float* XA = U + 1024; LAS float* XB = XA + 1024; LAS float* Z1 = XB + 1024;
                    for (int o = 0; o < 2; ++o) {
                        const float* hf = FILTC + ((size_t)(0 * 2 + o) * 256 + c) * 256; const float* hb = FILTC + ((size_t)(1 * 2 + o) * 256 + c) * 256;
                        const float f_ = tid < 256 ? hf[tid] : 0.f, b_ = tid < 256 ? hb[tid] : 0.f;
                        float s = fabsf(f_) + fabsf(b_);
                        s = block_sum(s, RED, tid); const float inv = 1.0f / (s + EPSF);
                        if (tid < 256) { KC[o * 512 + 255 + tid] = f_ * inv; if (tid > 0) KC[o * 512 + 255 - tid] = b_ * inv; }
                    }
#pragma unroll 1
                    for (int k = 0; k < 2; ++k) { const int i = tidc + 512 * k, b = i >> 8, t = i & 255; const bf16_t* p = HYRC + ((size_t)b * 768 + c) * 256;
                        U[i] = hy_in(p, t, 256, wv0, wv1, wv2, bv); XA[i] = hy_in(p + 256 * 256, t, 256, wa0, wa1, wa2, ba); XB[i] = hy_in(p + 512 * 256, t, 256, wb0, wb1, wb2, bb); }
                    __syncthreads();
#pragma unroll 1
                    for (int k = 0; k < 2; ++k) { const int i = tidc + 512 * k, b = i >> 8, t = i & 255; float acc = 0.f; const LAS float* kp = KC + 255 + t; const LAS float* up = U + b * 256;
#pragma unroll 8
                        for (int s = 0; s < 256; ++s) acc += kp[-s] * up[s];
                        Z1[i] = XA[i] * (acc + bias1 * U[i]); }
                    __syncthreads();
#pragma unroll 1
                    for (int k = 0; k < 2; ++k) { const int i = tidc + 512 * k, b = i >> 8, t = i & 255; float acc = 0.f; const LAS float* kp = KC + 512 + 255 + t; const LAS float* up = Z1 + b * 256;
#pragma unroll 8
                        for (int s = 0; s < 256; ++s) acc += kp[-s] * up[s];
                        YHC[((size_t)b * 256 + c) * 256 + t] = XB[i] * (acc + bias2 * Z1[i]); }
                    __syncthreads();
                }
            }
            for (int rep_ = 0; rep_ < REP_ATT; ++rep_) {
                const int nA = 16 * 32 + (need_ctx ? 16 : 0), nC = 32 * 32 + (need_ctx ? 32 : 0);
                for (int u = vcu; u < nA; u += G) {
                    const bool isc = u >= 16 * 32; const int hu = isc ? u - 16 * 32 : (u >> 5), qb = u & 31, b = hu >> 2, k = hu & 3, row0 = isc ? ML + b * 256 : b * 8192 + qb * 256;
                    attn_body::attn_unit<8, false, 256, 64, 64, 1280>((const attn_body::bf16*)(QA + k * 64 + (size_t)row0 * 256), (const attn_body::bf16*)(KA + (size_t)(b * 2 + (k >> 1)) * NKEY * 64), (const attn_body::bf16*)(VA + (size_t)(b * 2 + (k >> 1)) * NKEY * 64),
                        (attn_body::bf16*)(YRAW + k * 64 + (size_t)row0 * 1280), isc ? 4 : 132, (char*)lds_raw, wave0);
                }
                for (int u = vcu; u < nC; u += G) {
                    const bool isc = u >= 32 * 32; const int hu = isc ? u - 32 * 32 : (u >> 5), qb = u & 31, b = hu >> 3, h = (hu & 7) >> 1, j = hu & 1, row0 = isc ? ML + b * 256 : b * 8192 + qb * 256;
                    attn_body::attn_unit<8, true, 512, 64, 128, 1280>((const attn_body::bf16*)(QD + (h * 2 + j) * 64 + (size_t)row0 * 512), (const attn_body::bf16*)(KD + (size_t)(b * 8 + h * 2 + j) * NKEY * 64), (const attn_body::bf16*)(VD + (size_t)(b * 4 + h) * NKEY * 128),
                        (attn_body::bf16*)(YRAW + 256 + j * 512 + h * 128 + (size_t)row0 * 1280), isc ? 4 : 132, (char*)lds_raw, wave0);
                }
            }
        }
        xcd_barrier(xbar, wave0);
        for (int rep_ = 0; rep_ < REP_MERGE; ++rep_) {
            PHASE_IDS
            LAS float* S = (LAS float*)lds;
            const float* go = a.in[opq(27)] + l * 1024;
            const float lam = LAM[l], lam_init = 0.8f - 0.6f * expf(-0.3f * (float)l);
            const int ntile = need_ctx ? 528 : 512;
            for (int tl = bx; tl < ntile; tl += G) {
                const int r0 = tl * 64; const float* yb; int cstride;
                if (r0 < ML) { yb = YH + (size_t)(r0 >> 13) * 256 * 8192 + (r0 & 8191); cstride = 8192; } else { const int rr = r0 - ML; yb = YHC + (size_t)(rr >> 8) * 256 * 256 + (rr & 255); cstride = 256; }
                for (int i = 0; i < 32; ++i) { const int c = i * 8 + wave; S[lane * 257 + c] = yb[(size_t)c * cstride + lane]; }
                __syncthreads();
                for (int k = 0; k < 8; ++k) {
                    const int row = wave * 8 + k, r = r0 + row; const bf16_t* yr = YRAW + (size_t)r * 1280; bf16_t* hr = H + (size_t)r * 1024;
                    { const v2u w = *(const v2u*)(yr + 4 * lane); const float y0 = bflo(w.x), y1 = bfhi(w.x), y2 = bflo(w.y), y3 = bfhi(w.y);
                      const float ss = wave_sum(y0 * y0 + y1 * y1 + y2 * y2 + y3 * y3); const float rinv = 1.0f / sqrtf(ss * (1.0f / 256.0f) + EPSF);
                      const f32x4 g4 = *(const f32x4*)(go + 4 * lane); v2u o; o.x = pk2(y0 * rinv * g4.x, y1 * rinv * g4.y); o.y = pk2(y2 * rinv * g4.z, y3 * rinv * g4.w); *(v2u*)(hr + 4 * lane) = o; }
                    { const float y0 = S[row * 257 + 4 * lane], y1 = S[row * 257 + 4 * lane + 1], y2 = S[row * 257 + 4 * lane + 2], y3 = S[row * 257 + 4 * lane + 3];
                      const float ss = wave_sum(y0 * y0 + y1 * y1 + y2 * y2 + y3 * y3); const float rinv = 1.0f / sqrtf(ss * (1.0f / 256.0f) + EPSF);
                      const f32x4 g4 = *(const f32x4*)(go + 256 + 4 * lane); v2u o; o.x = pk2(y0 * rinv * g4.x, y1 * rinv * g4.y); o.y = pk2(y2 * rinv * g4.z, y3 * rinv * g4.w); *(v2u*)(hr + 256 + 4 * lane) = o; }
                    { const v4u w0 = *(const v4u*)(yr + 256 + 8 * lane), w1 = *(const v4u*)(yr + 768 + 8 * lane);
                      float d[8];
                      d[0] = bflo(w0.x) - lam * bflo(w1.x); d[1] = bfhi(w0.x) - lam * bfhi(w1.x); d[2] = bflo(w0.y) - lam * bflo(w1.y); d[3] = bfhi(w0.y) - lam * bfhi(w1.y);
                      d[4] = bflo(w0.z) - lam * bflo(w1.z); d[5] = bfhi(w0.z) - lam * bfhi(w1.z); d[6] = bflo(w0.w) - lam * bflo(w1.w); d[7] = bfhi(w0.w) - lam * bfhi(w1.w);
                      float ss = 0.f;
#pragma unroll
                      for (int q = 0; q < 8; ++q) ss += d[q] * d[q];
                      ss = row16_sum(ss);
                      const float rinv = (1.0f - lam_init) / sqrtf(ss * (1.0f / 128.0f) + EPSF);
                      const f32x4 ga = *(const f32x4*)(go + 512 + 8 * lane), gb = *(const f32x4*)(go + 512 + 8 * lane + 4);
                      v4u o; o.x = pk2(d[0] * rinv * ga.x, d[1] * rinv * ga.y); o.y = pk2(d[2] * rinv * ga.z, d[3] * rinv * ga.w); o.z = pk2(d[4] * rinv * gb.x, d[5] * rinv * gb.y); o.w = pk2(d[6] * rinv * gb.z, d[7] * rinv * gb.w);
                      *(v4u*)(hr + 512 + 8 * lane) = o; }
                }
                __syncthreads();
            }
        }
        xcd_barrier(xbar, wave0);
        for (int es_ = 0; es_ < EXTRA_SYNC; ++es_) xcd_barrier(xbar, wave0);
        const int M5 = need_ctx ? MT : ML;
        {
            pg8::Gemm g{H, WOUT, M5, 1024, 1024}; pg8::StaticOrder S; S.init(M5, 1024, G, cbx);
            EpiGateRes E{xl, OUT, xc, CTXX, modl + 2048, 0};
            pg8::gemm_phase<EpiGateRes, pg8::StaticOrder, PG8_ALIGN, PG8_SP2>(lds, g, S, E, wave0);
            for (int rep_ = 1; rep_ < REP_GEMM2; ++rep_) { EpiGateRes E2{OUT, OUT, CTXX, CTXX, (const float*)(wsb(a.ws) + 65536), 0}; pg8::gemm_phase<EpiGateRes, pg8::StaticOrder, PG8_ALIGN, PG8_SP2>(lds, g, S, E2, wave0); }
        }
        xcd_barrier(xbar, wave0);
        for (int rep_ = 0; rep_ < REP_N2; ++rep_) { PHASE_IDS norm_mod(OUT, CTXX, a.in[opq(5)] + l * 1024, modl, 3072, 4096, H, M5, gw, NGW, lane); }
        xcd_barrier(xbar, wave0);
        {
            const int ntm = (M5 + 247) / 248;
            pg8::Gemm g{H - 1024, WUP, ntm * 256, 2 * DFF, 1024}; pg8::StaticOrder S; S.init(ntm * 256, 2 * DFF, G, cbx);
            EpiGlu E{GB, a.in[opq(30)] + (size_t)l * 3 * DFF, a.in[opq(31)] + l * DFF, M5};
            pg8::gemm_phase<EpiGlu, pg8::StaticOrder, PG8_ALIGN, PG8_SP2, true>(lds, g, S, E, wave0);
        }
        xcd_barrier(xbar, wave0);
        {
            pg8::Gemm g{GB, WDN, M5, 1024, DFF}; pg8::StaticOrder S; S.init(M5, 1024, G, cbx);
            EpiGateRes E{OUT, OUT, CTXX, CTXX, modl + 5120, 0};
            pg8::gemm_phase<EpiGateRes, pg8::StaticOrder, PG8_ALIGN, PG8_SP2>(lds, g, S, E, wave0);
            if (l + 1 < DEPTH) { const int units = (M5 >> 8) * 4, first = units % G;
                if (cbx >= first) { PHASE_IDS __syncthreads(); prep_work(a, lds, l + 1, l + 1 < DEPTH - 1, cbx - first, G - first, true, false, tid, lane, wave); } }
        }
        xcd_barrier(xbar, wave0);
    }
}

extern "C" void kernel_launch(void* const* d_in, const int* in_sizes, int n_in, void* d_out, int out_size, void* d_ws, size_t ws_size, hipStream_t stream) {
    static int grid = 0;
    if (grid == 0) {
        if (n_in != 33 || out_size != ML * DMOD || ws_size < WS_END) { fprintf(stderr, "kernel_launch: unexpected shapes: n_in %d out %d ws %zu (need %zu)\n", n_in, out_size, ws_size, (size_t)WS_END); grid = -1; return; }
        int dev = 0, cus = 0, per_cu = 0;
        if (hipGetDevice(&dev) != hipSuccess || hipDeviceGetAttribute(&cus, hipDeviceAttributeMultiprocessorCount, dev) != hipSuccess) { grid = -1; return; }
        if (hipFuncSetAttribute((const void*)fwd_mega, hipFuncAttributeMaxDynamicSharedMemorySize, LDS_BYTES) != hipSuccess) { fprintf(stderr, "kernel_launch: hipFuncSetAttribute failed\n"); grid = -1; return; }
        if (hipOccupancyMaxActiveBlocksPerMultiprocessor(&per_cu, (const void*)fwd_mega, NTHR, LDS_BYTES) != hipSuccess || per_cu < 1) { fprintf(stderr, "kernel_launch: occupancy query says %d\n", per_cu); }
        (void)hipGetLastError();
        grid = cus;
    }
    if (grid < 0) return;
    Args a{};
    for (int i = 0; i < 33; ++i) a.in[i] = (const float*)d_in[i];
    a.out = (float*)d_out; a.ws = (unsigned char*)d_ws;
    if (hipMemsetAsync(d_ws, 0, 32768, stream) != hipSuccess) { fprintf(stderr, "kernel_launch: memset failed\n"); return; }
    void* args[] = {&a};
#if PROBE_PLAIN_LAUNCH
    hipLaunchKernelGGL(fwd_mega, dim3(grid), dim3(NTHR), LDS_BYTES, stream, a); const hipError_t e = hipPeekAtLastError(); (void)args;
#else
    const hipError_t e = hipLaunchCooperativeKernel((const void*)fwd_mega, dim3(grid), dim3(NTHR), args, LDS_BYTES, stream);
#endif
    if (e != hipSuccess) fprintf(stderr, "kernel_launch: cooperative launch failed: %s (grid %d)\n", hipGetErrorString(e), grid);
}
```

```cpp
#include <hip/hip_runtime.h>
#include <cstdio>
#include <cstdint>
__device__ __forceinline__ int lane_id_v() { int l; asm volatile("v_mbcnt_lo_u32_b32 %0, -1, 0\n\tv_mbcnt_hi_u32_b32 %0, -1, %0" : "=v"(l)); return l; }
namespace pg8 {
#define PG8_LAS __attribute__((address_space(3)))
typedef unsigned short bf16_t;
typedef short bf16x8 __attribute__((ext_vector_type(8)));
typedef float f32x4 __attribute__((ext_vector_type(4)));
typedef unsigned u32x4 __attribute__((ext_vector_type(4)));
constexpr int BM = 256, BK = 64, HALF = 128, HTB = HALF * BK * 2  , STAGE_BYTES = 8 * HTB, NXCD = 8, WGM = 8;

__host__ __device__ __forceinline__ int lds_byte(int r, int c) { const int st = (r >> 4) * 2 + (c >> 5), rr = r & 15, cc = c & 31, ob = rr * 64 + cc * 2; return st * 1024 + (ob ^ (((ob >> 9) & 1) << 5)); }
__host__ __device__ __forceinline__ void stage_rc(int b, int& R, int& C) { const int st = b / 1024, sb = b % 1024, swz = sb ^ (((sb >> 9) & 1) << 5); R = (st >> 1) * 16 + swz / 64; C = (st & 1) * 32 + (swz % 64) / 2; }
__host__ __device__ __forceinline__ int perm32(int rho) { const int n = rho >> 4, i = rho & 15; return 8 * (i >> 2) + 4 * n + (i & 3); }

struct Unit { int pm, pn; };
struct Gemm { const bf16_t* A; const bf16_t* Bt; int M, N, K; };

struct StaticOrder {
    int nM, nN, nwg, G, c;
    __host__ __device__ void init(int M, int N, int G_, int c_) { nM = M / BM; nN = N / BM; nwg = nM * nN; G = G_; c = c_; }
    __host__ __device__ bool next(int i, Unit& u) const {
        const long L = (long)i * G + c; if (L >= nwg) return false;
        int wgid = (int)L; { const int q = nwg / NXCD, r = nwg % NXCD, xcd = wgid % NXCD, off = wgid / NXCD; wgid = (xcd < r ? xcd * (q + 1) : r * (q + 1) + (xcd - r) * q) + off; }
        const int nig = WGM * nN, gid = wgid / nig, fm = gid * WGM, gsz = (nM - fm) < WGM ? (nM - fm) : WGM;
        u.pm = fm + ((wgid % nig) % gsz); u.pn = (wgid % nig) / gsz; return true;
    }
    __device__ __forceinline__ void a_ready(const Unit&) const {}
    __device__ __forceinline__ void done(const Unit&) const {}
};

__device__ __forceinline__ unsigned cvt_pk_bf16(float lo, float hi) { unsigned r; asm volatile("v_cvt_pk_bf16_f32 %0, %1, %2" : "=v"(r) : "v"(lo), "v"(hi)); return r; }
typedef float f32x2 __attribute__((ext_vector_type(2)));
__device__ __forceinline__ f32x2 gelu_pk(f32x2 v) {
    const f32x2 av = __builtin_elementwise_abs(v), d = av * 0.2316418882f + 1.0f;
    f32x2 t; t.x = __builtin_amdgcn_rcpf(d.x); t.y = __builtin_amdgcn_rcpf(d.y);
    f32x2 q = t * 0.5307027145f + (-0.7265760135f); q = q * t + 0.7107068705f; q = q * t + (-0.142248368f); q = q * t + 0.127414796f; q = q * t;
    const f32x2 s = (v * v) * (-0.72134752044f);
    f32x2 e; e.x = __builtin_amdgcn_exp2f(s.x); e.y = __builtin_amdgcn_exp2f(s.y);
    const f32x2 m = v * (q * e), r = v - m;
    f32x2 o; o.x = v.x < 0.f ? m.x : r.x; o.y = v.y < 0.f ? m.y : r.y; return o;
}

template <int ACT  > struct EpiBf16 {
    static constexpr bool PERM = true, AFTER_DRAIN = false; static_assert(ACT == 0 || ACT == 1, "EpiBf16: ACT is 0 (none) or 1 (gelu_pk)");
    bf16_t* O; int ldc; const float* bias; int split_cols; size_t split_stride; float scale0;
    __device__ __forceinline__ void operator()(const f32x4 (&acc)[2][2][4][2], const Unit& u, int wr, int wc, int fr, int fq) const {
        const int row0 = u.pm * BM + wr * 64 + fr; int colt = u.pn * BM; bf16_t* base = O;
        float sc = 1.f; if (split_cols) { const int t = colt / split_cols; base += (size_t)t * split_stride; colt -= t * split_cols; if (t == 0) sc = scale0; }
        const int col0 = colt + wc * 32 + 8 * fq, bcol0 = u.pn * BM + wc * 32 + 8 * fq;
        f32x4 bv[2][2];
#pragma unroll
        for (int bj = 0; bj < 2; ++bj)
#pragma unroll
            for (int n = 0; n < 2; ++n) bv[bj][n] = bias ? *(const f32x4*)(bias + bcol0 + bj * HALF + 4 * n) : (f32x4){0.f, 0.f, 0.f, 0.f};
#pragma unroll
        for (int ai = 0; ai < 2; ++ai)
#pragma unroll
            for (int m = 0; m < 4; ++m) { bf16_t* rowp = base + (size_t)(row0 + ai * HALF + m * 16) * ldc + col0;
#pragma unroll
                for (int bj = 0; bj < 2; ++bj) { f32x4 v0 = acc[ai][bj][m][0] + bv[bj][0], v1 = acc[ai][bj][m][1] + bv[bj][1];
                    if (ACT == 1) { f32x2 a = gelu_pk((f32x2){v0[0], v0[1]}), b = gelu_pk((f32x2){v0[2], v0[3]}), c = gelu_pk((f32x2){v1[0], v1[1]}), d = gelu_pk((f32x2){v1[2], v1[3]});
                        v0 = (f32x4){a.x, a.y, b.x, b.y}; v1 = (f32x4){c.x, c.y, d.x, d.y}; }
                    v0 = v0 * sc; v1 = v1 * sc; u32x4 w; w.x = cvt_pk_bf16(v0[0], v0[1]); w.y = cvt_pk_bf16(v0[2], v0[3]); w.z = cvt_pk_bf16(v1[0], v1[1]); w.w = cvt_pk_bf16(v1[2], v1[3]);
                    *(u32x4*)(rowp + bj * HALF) = w; } }
    }
};
template <class Epi, class Sched, bool ALIGN_EPI = false, bool SP2 = false, bool HALO = false>
__device__ __forceinline__ void gemm_phase(PG8_LAS unsigned char* lds, const Gemm g, const Sched& S, const Epi& E, const int wave0) {
    int tid_o = wave0 * 64 + lane_id_v(); asm volatile("" : "+v"(tid_o));
    const int tid = tid_o, wid = __builtin_amdgcn_readfirstlane(tid >> 6), lane = tid & 63, wr = wid >> 2, wc = wid & 3, fr = lane & 15, fq = lane >> 4;
    const int K = g.K, nt = K / BK;
    unsigned voffA[2], voffB[2];
#pragma unroll
    for (int i = 0; i < 2; ++i) { int R, C; stage_rc(tid * 16 + i * 8192, R, C); const int Rb = Epi::PERM ? ((R & ~31) + perm32(R & 31)) : R;
        voffA[i] = HALO ? (unsigned)(((R & 63) + 62 * (R >> 6)) * K + C) * 2u : (unsigned)(R * K + C) * 2u; voffB[i] = (unsigned)(Rb * K + C) * 2u; }
    const size_t kstep = (size_t)(BK * 2);
    const size_t hstep = (size_t)HALF * K * 2;
    const size_t tstep = 2 * hstep;
    const size_t hstepA = HALO ? (size_t)124 * K * 2 : hstep, tstepA = 2 * hstepA;
    const unsigned ldsw = (unsigned)wid * 1024u;
    const int aoff = lds_byte(wr * 64 + fr, fq * 8), boff = lds_byte(wc * 32 + fr, fq * 8);
#define PG8_SA(b, h) (((b) * 2 + (h)) * HTB)
#define PG8_SB(b, h) ((4 + (b) * 2 + (h)) * HTB)
#define PG8_STAGE(bufoff, gbase, voff) do { _Pragma("unroll") for (int _i = 0; _i < 2; ++_i) \
        __builtin_amdgcn_global_load_lds((const unsigned*)((const char*)(gbase) + (voff)[_i]), (PG8_LAS unsigned*)(lds + (bufoff) + ldsw + _i * 8192), 16, 0, 0); } while (0)
#define PG8_LDA(dst, b, h) do { _Pragma("unroll") for (int m = 0; m < 4; ++m) _Pragma("unroll") for (int k = 0; k < 2; ++k) dst[m][k] = *(const PG8_LAS bf16x8*)(lds + PG8_SA(b, h) + aoff + m * 2048 + k * 1024); } while (0)
#define PG8_LDB(dst, b, h) do { _Pragma("unroll") for (int n = 0; n < 2; ++n) _Pragma("unroll") for (int k = 0; k < 2; ++k) dst[n][k] = *(const PG8_LAS bf16x8*)(lds + PG8_SB(b, h) + boff + n * 2048 + k * 1024); } while (0)
#define PG8_MMA(ai, bj, At, Bt) do { __builtin_amdgcn_s_setprio(1); _Pragma("unroll") for (int m = 0; m < 4; ++m) _Pragma("unroll") for (int n = 0; n < 2; ++n) _Pragma("unroll") for (int k = 0; k < 2; ++k) \
        acc[ai][bj][m][n] = __builtin_amdgcn_mfma_f32_16x16x32_bf16(Bt[n][k], At[m][k], acc[ai][bj][m][n], 0, 0, 0); __builtin_amdgcn_s_setprio(0); } while (0)
#define PG8_WAIT_V(n) asm volatile("s_waitcnt vmcnt(" #n ")" ::: "memory")
#define PG8_WAIT_L(n) asm volatile("s_waitcnt lgkmcnt(" #n ")" ::: "memory")
#define PG8_BAR __builtin_amdgcn_s_barrier()
#define PG8_SCHED __builtin_amdgcn_sched_barrier(0)
    Unit cur, nxt; int ui = 0;
    if (!S.next(0, cur)) return;
    f32x4 acc[2][2][4][2];
#pragma unroll
    for (int a = 0; a < 2; ++a)
#pragma unroll
        for (int b = 0; b < 2; ++b)
#pragma unroll
            for (int m = 0; m < 4; ++m)
#pragma unroll
                for (int n = 0; n < 2; ++n) acc[a][b][m][n] = (f32x4){0.f, 0.f, 0.f, 0.f};
    bf16x8 At[4][2], B0[2][2], B1[2][2];
    const char* cA = (const char*)g.A + (size_t)cur.pm * tstepA; const char* cB = (const char*)g.Bt + (size_t)cur.pn * tstep;
    S.a_ready(cur);
    if constexpr (SP2) {
        PG8_STAGE(PG8_SB(0, 0), cB, voffB); PG8_STAGE(PG8_SB(0, 1), cB + hstep, voffB); PG8_STAGE(PG8_SA(0, 0), cA, voffA); PG8_STAGE(PG8_SA(0, 1), cA + hstepA, voffA);
        if (wr == 1) PG8_BAR;
        PG8_WAIT_V(2); PG8_BAR;
        PG8_STAGE(PG8_SB(1, 0), cB + kstep, voffB); PG8_STAGE(PG8_SA(1, 0), cA + kstep, voffA); PG8_STAGE(PG8_SB(1, 1), cB + hstep + kstep, voffB);
        PG8_WAIT_V(6); PG8_BAR;
    } else {
        PG8_STAGE(PG8_SB(0, 0), cB, voffB); PG8_STAGE(PG8_SA(0, 0), cA, voffA); PG8_STAGE(PG8_SB(0, 1), cB + hstep, voffB); PG8_STAGE(PG8_SA(0, 1), cA + hstepA, voffA);
        if (wr == 1) PG8_BAR;
        PG8_WAIT_V(4); PG8_BAR;
        PG8_STAGE(PG8_SB(1, 0), cB + kstep, voffB); PG8_STAGE(PG8_SA(1, 0), cA + kstep, voffA); PG8_STAGE(PG8_SB(1, 1), cB + hstep + kstep, voffB);
        PG8_WAIT_V(6); PG8_BAR;
    }
    for (;;) {
        const bool has_next = S.next(ui + 1, nxt);
        const char* nA = has_next ? (const char*)g.A + (size_t)nxt.pm * tstepA : cA; const char* nB = has_next ? (const char*)g.Bt + (size_t)nxt.pn * tstep : cB;
        for (int t = 0; t < nt; t += 2) {
            const bool last = (t == nt - 2);
            const char* a1 = cA + (size_t)(t + 1) * kstep;
            const char* a2 = last ? nA : cA + (size_t)(t + 2) * kstep; const char* b2 = last ? nB : cB + (size_t)(t + 2) * kstep;
            const char* a3 = a2 + kstep; const char* b3 = b2 + kstep;
            if (last && has_next) S.a_ready(nxt);
            if constexpr (SP2) {
            PG8_LDB(B0, 0, 0); PG8_LDB(B1, 0, 1); PG8_SCHED; PG8_LDA(At, 0, 0); PG8_STAGE(PG8_SA(1, 1), a1 + hstepA, voffA);
            PG8_WAIT_V(8); PG8_WAIT_L(0); PG8_BAR; PG8_MMA(0, 0, At, B0); PG8_MMA(0, 1, At, B1); PG8_BAR; PG8_SCHED;
            PG8_LDA(At, 0, 1); PG8_STAGE(PG8_SB(0, 0), b2, voffB); PG8_STAGE(PG8_SB(0, 1), b2 + hstep, voffB); PG8_STAGE(PG8_SA(0, 0), a2, voffA);
            PG8_WAIT_V(8); PG8_WAIT_L(0); PG8_BAR; PG8_MMA(1, 0, At, B0); PG8_MMA(1, 1, At, B1); PG8_BAR; PG8_SCHED;
            PG8_LDB(B0, 1, 0); PG8_LDB(B1, 1, 1); PG8_SCHED; PG8_LDA(At, 1, 0); PG8_STAGE(PG8_SA(0, 1), a2 + hstepA, voffA);
            PG8_WAIT_V(8); PG8_WAIT_L(0); PG8_BAR; PG8_MMA(0, 0, At, B0); PG8_MMA(0, 1, At, B1); PG8_BAR; PG8_SCHED;
            PG8_LDA(At, 1, 1); PG8_STAGE(PG8_SB(1, 0), b3, voffB); PG8_STAGE(PG8_SB(1, 1), b3 + hstep, voffB); PG8_STAGE(PG8_SA(1, 0), a3, voffA);
            PG8_WAIT_V(8); PG8_WAIT_L(0); PG8_BAR; PG8_MMA(1, 0, At, B0); PG8_MMA(1, 1, At, B1); PG8_BAR; PG8_SCHED;
            } else {
            PG8_LDB(B0, 0, 0); PG8_SCHED; PG8_LDA(At, 0, 0); PG8_STAGE(PG8_SA(1, 1), a1 + hstepA, voffA);
            PG8_WAIT_L(8); PG8_BAR; PG8_WAIT_L(0); PG8_MMA(0, 0, At, B0); PG8_BAR; PG8_SCHED;
            PG8_LDB(B1, 0, 1); PG8_STAGE(PG8_SB(0, 0), b2, voffB);
            PG8_BAR; PG8_WAIT_L(0); PG8_MMA(0, 1, At, B1); PG8_BAR;
            PG8_LDA(At, 0, 1); PG8_STAGE(PG8_SA(0, 0), a2, voffA);
            PG8_BAR; PG8_WAIT_L(0); PG8_MMA(1, 0, At, B0); PG8_BAR; PG8_SCHED;
            PG8_STAGE(PG8_SB(0, 1), b2 + hstep, voffB);
            PG8_WAIT_V(6); PG8_BAR; PG8_MMA(1, 1, At, B1); PG8_BAR;
            PG8_LDB(B0, 1, 0); PG8_SCHED; PG8_LDA(At, 1, 0); PG8_STAGE(PG8_SA(0, 1), a2 + hstepA, voffA);
            PG8_WAIT_L(8); PG8_BAR; PG8_WAIT_L(0); PG8_MMA(0, 0, At, B0); PG8_BAR; PG8_SCHED;
            PG8_LDB(B1, 1, 1); PG8_STAGE(PG8_SB(1, 0), b3, voffB);
            PG8_BAR; PG8_WAIT_L(0); PG8_MMA(0, 1, At, B1); PG8_BAR;
            PG8_LDA(At, 1, 1); PG8_STAGE(PG8_SA(1, 0), a3, voffA);
            PG8_BAR; PG8_WAIT_L(0); PG8_MMA(1, 0, At, B0); PG8_BAR; PG8_SCHED;
            PG8_STAGE(PG8_SB(1, 1), b3 + hstep, voffB);
            PG8_WAIT_V(6); PG8_BAR; PG8_MMA(1, 1, At, B1); PG8_BAR;
            }
        }
        if constexpr (ALIGN_EPI) { if (wr == 0) PG8_BAR; }
        if constexpr (!Epi::AFTER_DRAIN) { E(acc, cur, wr, wc, fr, fq); S.done(cur); }
        if (!has_next) break;
#pragma unroll
        for (int a = 0; a < 2; ++a)
#pragma unroll
            for (int b = 0; b < 2; ++b)
#pragma unroll
                for (int m = 0; m < 4; ++m)
#pragma unroll
                    for (int n = 0; n < 2; ++n) acc[a][b][m][n] = (f32x4){0.f, 0.f, 0.f, 0.f};
        cur = nxt; cA = nA; cB = nB; ++ui;
        if constexpr (ALIGN_EPI) { if (wr == 1) PG8_BAR; }
    }
    PG8_WAIT_V(0);
    if constexpr (!ALIGN_EPI) { if (wr == 0) PG8_BAR; }
    PG8_BAR;
    if constexpr (Epi::AFTER_DRAIN) { E.fused(acc, cur, wr, wc, fr, fq, lds, wid, lane); S.done(cur); }
#undef PG8_SA
#undef PG8_SB
#undef PG8_STAGE
#undef PG8_LDA
#undef PG8_LDB
#undef PG8_MMA
#undef PG8_WAIT_V
#undef PG8_WAIT_L
#undef PG8_BAR
#undef PG8_SCHED
}
}

#ifndef PG8_SP2
#define PG8_SP2 true
#endif
#ifndef PG8_ALIGN
#define PG8_ALIGN true
#endif
#include <hip/hip_bf16.h>
#include <cmath>
namespace attn_body {
using bf16=__hip_bfloat16;
using bf16x8=__attribute__((ext_vector_type(8)))short;
using s16x4=__attribute__((ext_vector_type(4)))short;
using f32x16=__attribute__((ext_vector_type(16)))float;
using u32x4=__attribute__((ext_vector_type(4)))unsigned;
constexpr int D=64;
constexpr int NW=8,QBLK=32,QB=QBLK*NW,KVBLK=64;
constexpr int ATTN_UNIT_ROWS=QB;
__device__ __forceinline__ int crow(int r,int hi){return (r&3)+8*(r>>2)+4*hi;}
#define SBAR() __builtin_amdgcn_sched_barrier(0)
__device__ __forceinline__ void cmask(f32x16&p0,f32x16&p1,int jb,int qrel,int hi){
  const float NEG=-INFINITY; int kb=64*jb+4*hi;
  #pragma unroll
  for(int r=0;r<16;++r){int kv=kb+(r&3)+8*(r>>2); if(kv>qrel)p0[r]=NEG; if(kv+32>qrel)p1[r]=NEG;}
}

constexpr int NSLOT=3, SLOTB=8192;
constexpr int LDS_K=0, LDS_V=NSLOT*SLOTB, LDS_WS=2*NSLOT*SLOTB, LDS_OST=LDS_WS+NW*64*4, LDS_BYTES=LDS_OST+NW*4096;
constexpr float C2=0.125f*1.4426950408889634f;
__device__ __forceinline__ void glds16(const void*gsrc,unsigned lds_dst){unsigned keep;
  asm volatile("s_mov_b32 %0, m0\n\ts_mov_b32 m0, %2\n\ts_nop 0\n\tglobal_load_lds_dwordx4 %1, off\n\ts_mov_b32 m0, %0":"=&s"(keep):"v"(gsrc),"s"(lds_dst):"memory");}
__device__ __forceinline__ float max3f(float a,float b,float c){float r;asm("v_max3_f32 %0, %1, %2, %3":"=v"(r):"v"(a),"v"(b),"v"(c));return r;}
__device__ __forceinline__ float max2f(float a,float b){float r;asm("v_max_f32_e32 %0, %1, %2":"=v"(r):"v"(a),"v"(b));return r;}
__device__ __forceinline__ float fadd_s(float a,float b){float r;asm("v_add_f32_e32 %0, %1, %2":"=v"(r):"v"(a),"v"(b));return r;}
__device__ __forceinline__ float fsub_s(float a,float b){float r;asm("v_sub_f32_e32 %0, %1, %2":"=v"(r):"v"(a),"v"(b));return r;}
typedef float f32x2_t __attribute__((ext_vector_type(2))); typedef __bf16 bf16x2_t __attribute__((ext_vector_type(2)));
__device__ __forceinline__ unsigned cvtpk_s(float lo,float hi){f32x2_t v={lo,hi};bf16x2_t b=__builtin_convertvector(v,bf16x2_t);return __builtin_bit_cast(unsigned,b);}
#define WAIT_BAR(N) asm volatile("s_waitcnt vmcnt(" #N ") lgkmcnt(0)\n\ts_barrier":::"memory")

__device__ __forceinline__ void qkt(f32x16&p0,f32x16&p1,const char*Kslot,const bf16x8*qr,const f32x16&negm,int r32,int hi){
  const char*kb=Kslot+hi*1024+r32*16;
  #pragma unroll
  for(int d0=0;d0<4;++d0){
    const bf16x8 b0=*reinterpret_cast<const bf16x8*>(kb+d0*2048);
    const bf16x8 b1=*reinterpret_cast<const bf16x8*>(kb+d0*2048+512);
    if(d0==0){p0=__builtin_amdgcn_mfma_f32_32x32x16_bf16(b0,qr[0],negm,0,0,0);p1=__builtin_amdgcn_mfma_f32_32x32x16_bf16(b1,qr[0],negm,0,0,0);}
    else{p0=__builtin_amdgcn_mfma_f32_32x32x16_bf16(b0,qr[d0],p0,0,0,0);p1=__builtin_amdgcn_mfma_f32_32x32x16_bf16(b1,qr[d0],p1,0,0,0);}}
}
typedef __attribute__((address_space(3))) const char* lds_cptr;
typedef short v4i16_t __attribute__((ext_vector_type(4)));
__device__ __forceinline__ void kload8(bf16x8*kf,lds_cptr kp){
  kf[0]=*(const __attribute__((address_space(3))) bf16x8*)(kp);      kf[1]=*(const __attribute__((address_space(3))) bf16x8*)(kp+512);
  kf[2]=*(const __attribute__((address_space(3))) bf16x8*)(kp+2048); kf[3]=*(const __attribute__((address_space(3))) bf16x8*)(kp+2560);
  kf[4]=*(const __attribute__((address_space(3))) bf16x8*)(kp+4096); kf[5]=*(const __attribute__((address_space(3))) bf16x8*)(kp+4608);
  kf[6]=*(const __attribute__((address_space(3))) bf16x8*)(kp+6144); kf[7]=*(const __attribute__((address_space(3))) bf16x8*)(kp+6656);
}
__device__ __forceinline__ void kload2(bf16x8*kf,lds_cptr kp,int j){ kf[2*j]=*(const __attribute__((address_space(3))) bf16x8*)(kp+j*2048); kf[2*j+1]=*(const __attribute__((address_space(3))) bf16x8*)(kp+j*2048+512); }
__device__ __forceinline__ s16x4 vtr(lds_cptr p){ return __builtin_bit_cast(s16x4,__builtin_amdgcn_ds_read_tr16_b64_v4i16((__attribute__((address_space(3))) v4i16_t*)p)); }
__device__ __forceinline__ float rowmax(const f32x16&p0,const f32x16&p1){
  float a=max3f(p0[0],p0[1],p1[0]),b=max3f(p0[2],p0[3],p1[1]);a=max3f(a,p1[2],p1[3]);
  #pragma unroll
  for(int r=4;r<16;r+=4){a=max3f(a,p0[r],p0[r+1]);b=max3f(b,p0[r+2],p0[r+3]);a=max3f(a,p1[r],p1[r+1]);b=max3f(b,p1[r+2],p1[r+3]);}
  const float m=max2f(a,b);
  auto rr=__builtin_amdgcn_permlane32_swap(__float_as_uint(m),__float_as_uint(m),false,false);
  return max2f(__uint_as_float(rr[0]),__uint_as_float(rr[1]));
}
__device__ __forceinline__ void pv(f32x16*o,int vb,bf16x8 pa0,bf16x8 pa1,bf16x8 pa2,bf16x8 pa3){
  #pragma unroll
  for(int d0=0;d0<2;++d0){s16x4 lo[4],hi[4];
    #pragma unroll
    for(int ks=0;ks<4;++ks){
      asm volatile("ds_read_b64_tr_b16 %0,%1 offset:%c2":"=&v"(lo[ks]):"v"(vb),"i"(d0*4096+ks*1024):"memory");
      asm volatile("ds_read_b64_tr_b16 %0,%1 offset:%c2":"=&v"(hi[ks]):"v"(vb),"i"(d0*4096+ks*1024+512):"memory");}
    asm volatile("s_waitcnt lgkmcnt(0)":::"memory");SBAR();
    #define PK(k) (bf16x8){lo[k][0],lo[k][1],lo[k][2],lo[k][3],hi[k][0],hi[k][1],hi[k][2],hi[k][3]}
    o[d0]=__builtin_amdgcn_mfma_f32_32x32x16_bf16(pa0,PK(0),o[d0],0,0,0);
    o[d0]=__builtin_amdgcn_mfma_f32_32x32x16_bf16(pa1,PK(1),o[d0],0,0,0);
    o[d0]=__builtin_amdgcn_mfma_f32_32x32x16_bf16(pa2,PK(2),o[d0],0,0,0);
    o[d0]=__builtin_amdgcn_mfma_f32_32x32x16_bf16(pa3,PK(3),o[d0],0,0,0);
    #undef PK
  }
}

#ifndef ATTN_STORE16
#define ATTN_STORE16(p,v) (*(u32x4*)(p)=(v))
#endif
template<int THRL,bool DV128,int PQ,int PK,int PV,int PO> __device__ __forceinline__ void attn_unit(const bf16*Qb,const bf16*__restrict__ Kb,const bf16*__restrict__ Vb,bf16*Ob,const int NT,char*shm,const int wave0){
  int tid_o=wave0*64+lane_id_v(); asm volatile("":"+v"(tid_o)); const int tid=tid_o,lane=tid&63,r32=lane&31,hi=lane>>5; const int wid=__builtin_amdgcn_readfirstlane(tid>>6);
  const bf16*Qw=Qb+(long)(wid*QBLK)*PQ;
  const bf16*Kh=Kb,*Vh=Vb;
  const unsigned lds0=(unsigned)(uintptr_t)shm;
  constexpr int VS=DV128?2:1, L_WS=LDS_V+NSLOT*SLOTB*VS, L_OST=L_WS+NW*64*4;
  float*wsf=(float*)(shm+L_WS)+wid*64;
  const bf16*ksrc=Kh+(long)lane*PK+wid*8;
  const bf16*vsrc=Vh+(long)(16*(wid&3)+(lane>>2))*PV+(wid>>2)*32+(lane&3)*8;
  const unsigned kdst=lds0+LDS_K+wid*1024, vdst=lds0+LDS_V+wid*1024;
  #define DMA_K(t,slot) glds16(ksrc+(long)(t)*KVBLK*PK,(unsigned)__builtin_amdgcn_readfirstlane(kdst+(slot)))
  #define DMA_V(t,slot) do{ glds16(vsrc+(long)(t)*KVBLK*PV,(unsigned)__builtin_amdgcn_readfirstlane(vdst+VS*(slot))); if constexpr(DV128){ glds16(vsrc+64+(long)(t)*KVBLK*PV,(unsigned)__builtin_amdgcn_readfirstlane(vdst+VS*(slot)+8192)); } }while(0)
  const char*Kbase=shm+LDS_K; bf16x8 kf[8];
  const lds_cptr shm3=(lds_cptr)shm; const lds_cptr kp0=shm3+LDS_K+hi*1024+r32*16; const lds_cptr vp0=shm3+LDS_V+((lane>>4)&1)*32+(lane&3)*8+(4*hi+((lane&15)>>2))*64;
  DMA_K(0,0);DMA_V(0,0);DMA_K(1,SLOTB);
  bf16x8 qr[4];
  #pragma unroll
  for(int d0=0;d0<4;++d0)qr[d0]=*reinterpret_cast<const bf16x8*>(&Qw[(long)r32*PQ+d0*16+hi*8]);
  float mhat=0.f,l_reg=0.f;f32x16 o[4];o[0]=f32x16{};o[1]=f32x16{};o[2]=f32x16{};o[3]=f32x16{};f32x16 negm=f32x16{};asm volatile("":"+v"(negm));
  #define CMASK(P0,P1,t) do{}while(0)
  bool resc=false;
  #define START(P0,P1) do{ const float rm=rowmax(P0,P1); resc=false; \
    { const float dl=rm; mhat=fadd_s(mhat,dl); \
      _Pragma("unroll") for(int r=0;r<16;++r){P0[r]=fsub_s(P0[r],dl);P1[r]=fsub_s(P1[r],dl);} \
      _Pragma("unroll") for(int r=0;r<16;++r)negm[r]=-mhat; asm volatile("":"+v"(negm)); } \
    _Pragma("unroll") for(int r=0;r<16;++r)P0[r]=__builtin_amdgcn_exp2f(P0[r]); }while(0)
  #define RESC() do{ if(resc){ asm volatile("s_waitcnt lgkmcnt(0)":::"memory"); \
      _Pragma("unroll") for(int d_=0;d_<2*VS;++d_) _Pragma("unroll") for(int r=0;r<16;++r)o[d_][r]*=wsf[crow(r,hi)]; } }while(0)
  f32x16 pA0,pA1,pB0,pB1;
  int sl_prev=0,sl_cur=0,sl_next=SLOTB;
  #define ROT() do{sl_prev=sl_cur;sl_cur=sl_next;sl_next=(sl_next==(NSLOT-1)*SLOTB)?0:sl_next+SLOTB;}while(0)
  DMA_K(2,2*SLOTB);
  WAIT_BAR(3);
  qkt(pA0,pA1,Kbase,qr,negm,r32,hi);asm volatile("s_nop 15\n\ts_nop 7":"+v"(pA0),"+v"(pA1));CMASK(pA0,pA1,0);
  START(pA0,pA1);
  _Pragma("unroll") for(int r=0;r<16;++r)pA1[r]=__builtin_amdgcn_exp2f(pA1[r]);
  WAIT_BAR(0);
  DMA_K(3,0);DMA_V(1,SLOTB);
  ROT();
  kload8(kf,kp0+sl_cur);
  #define WB2() do{ if constexpr(DV128){WAIT_BAR(3);}else{WAIT_BAR(2);} }while(0)
  #define WB1() do{ if constexpr(DV128){WAIT_BAR(2);}else{WAIT_BAR(1);} }while(0)
  WB2();
  s16x4 vlo[8],vhi[8]; u32x4 pw0,pw1,pw2,pw3;
  #define PKW(P,B) cvtpk_s(P[B],P[B+1])
  #define PAF(k) __builtin_bit_cast(bf16x8,pw##k)
  #define VFR(i) (bf16x8){vlo[i][0],vlo[i][1],vlo[i][2],vlo[i][3],vhi[i][0],vhi[i][1],vhi[i][2],vhi[i][3]}
  #define PIN(x) asm volatile("":"+v"(x))
  #define MX3(a,b,c) __builtin_fmaxf(__builtin_fmaxf((a),(b)),(c))
  #define GAPA(MF,A0,A1,A2,A3,W0,W1,PW) do{ MF; sacc+=A0; sacc+=A1; sacc+=A2; sacc+=A3; PIN(sacc); W0; W1; PIN(PW); SBAR(); }while(0)
  #define EX(v) __builtin_amdgcn_exp2f(v)
  #define GAPC(MF,X,B) do{ MF; X[B]=EX(X[B]); X[B+1]=EX(X[B+1]); PIN(X); SBAR(); }while(0)
  #define GAPB(MF,X,B) do{ MF; X[B]=EX(X[B]); X[B+1]=EX(X[B+1]); X[B+2]=EX(X[B+2]); X[B+3]=EX(X[B+3]); PIN(X); SBAR(); }while(0)
  #define VRD(i) do{ vlo[i]=vtr(vp_+(((i)>>2)*4096+((i)&3)*1024)); vhi[i]=vtr(vp_+(((i)>>2)*4096+((i)&3)*1024+512)); }while(0)
  #define KRD(G,j) do{ if(G){ kload2(kf,kp0+sl_next,j); SBAR(); } }while(0)
  #define STEP(C0,C1,P0,P1,t,GK,GV,GL) do{ SBAR(); \
    const lds_cptr vp_=vp0+VS*sl_prev; \
    VRD(0); SBAR(); float sacc=(P0[0]+P0[1]); \
    GAPA(C0=__builtin_amdgcn_mfma_f32_32x32x16_bf16(kf[0],qr[0],negm,0,0,0), P0[2],P0[3],P0[4],P0[5],     pw0[0]=PKW(P0,0), pw0[1]=PKW(P0,2), pw0); \
    VRD(4); SBAR(); GAPA(C1=__builtin_amdgcn_mfma_f32_32x32x16_bf16(kf[1],qr[0],negm,0,0,0), P0[6],P0[7],P0[8],P0[9],     pw0[2]=PKW(P0,4), pw0[3]=PKW(P0,6), pw0); \
    VRD(1); SBAR(); GAPA(C0=__builtin_amdgcn_mfma_f32_32x32x16_bf16(kf[2],qr[1],C0,0,0,0),   P0[10],P0[11],P0[12],P0[13], pw1[0]=PKW(P0,8), pw1[1]=PKW(P0,10), pw1); \
    VRD(5); SBAR(); GAPA(C1=__builtin_amdgcn_mfma_f32_32x32x16_bf16(kf[3],qr[1],C1,0,0,0),   P0[14],P0[15],P1[0],P1[1],   pw1[2]=PKW(P0,12),pw1[3]=PKW(P0,14), pw1); \
    VRD(2); SBAR(); GAPA(C0=__builtin_amdgcn_mfma_f32_32x32x16_bf16(kf[4],qr[2],C0,0,0,0),   P1[2],P1[3],P1[4],P1[5],     pw2[0]=PKW(P1,0), pw2[1]=PKW(P1,2), pw2); \
    VRD(6); SBAR(); GAPA(C1=__builtin_amdgcn_mfma_f32_32x32x16_bf16(kf[5],qr[2],C1,0,0,0),   P1[6],P1[7],P1[8],P1[9],     pw2[2]=PKW(P1,4), pw2[3]=PKW(P1,6), pw2); \
    VRD(3); SBAR(); GAPA(C0=__builtin_amdgcn_mfma_f32_32x32x16_bf16(kf[6],qr[3],C0,0,0,0),   P1[10],P1[11],P1[12],P1[13], pw3[0]=PKW(P1,8), pw3[1]=PKW(P1,10), pw3); \
    VRD(7); SBAR(); GAPA(C1=__builtin_amdgcn_mfma_f32_32x32x16_bf16(kf[7],qr[3],C1,0,0,0),   P1[14],P1[15],0.f,0.f,       pw3[2]=PKW(P1,12),pw3[3]=PKW(P1,14), pw3); \
    l_reg+=sacc; \
    if(GK){DMA_K((t)+3,sl_cur);} if(GV){DMA_V((t)+1,sl_next);} \
    CMASK(C0,C1,t); \
    { float a=MX3(C0[0],C0[1],C1[0]),b=MX3(C0[2],C0[3],C1[1]); a=MX3(a,C1[2],C1[3]); \
      _Pragma("unroll") for(int r=4;r<16;r+=4){a=MX3(a,C0[r],C0[r+1]);b=MX3(b,C0[r+2],C0[r+3]);a=MX3(a,C1[r],C1[r+1]);b=MX3(b,C1[r+2],C1[r+3]);} \
      float rm=__builtin_fmaxf(a,b); { auto rr=__builtin_amdgcn_permlane32_swap(__float_as_uint(rm),__float_as_uint(rm),false,false); rm=__builtin_fmaxf(__uint_as_float(rr[0]),__uint_as_float(rr[1])); } \
      resc=false; \
      if(__builtin_expect(__any(rm>(float)THRL),0)){ const float dl=__builtin_fmaxf(rm,0.f); mhat+=dl; \
        _Pragma("unroll") for(int r=0;r<16;++r){C0[r]-=dl;C1[r]-=dl;} \
        _Pragma("unroll") for(int r=0;r<16;++r)negm[r]=-mhat; asm volatile("":"+v"(negm)); \
        const float f=__builtin_amdgcn_exp2f(-dl); l_reg*=f; if(hi==0)wsf[r32]=f; resc=true; } } \
    SBAR(); \
    GAPB(o[0]=__builtin_amdgcn_mfma_f32_32x32x16_bf16(PAF(0),VFR(0),o[0],0,0,0), C0,0); \
    GAPB(o[1]=__builtin_amdgcn_mfma_f32_32x32x16_bf16(PAF(0),VFR(4),o[1],0,0,0), C0,4); \
    KRD(GL,0); GAPB(o[0]=__builtin_amdgcn_mfma_f32_32x32x16_bf16(PAF(1),VFR(1),o[0],0,0,0), C0,8); \
    KRD(GL,1); GAPB(o[1]=__builtin_amdgcn_mfma_f32_32x32x16_bf16(PAF(1),VFR(5),o[1],0,0,0), C0,12); \
    KRD(GL,2); GAPB(o[0]=__builtin_amdgcn_mfma_f32_32x32x16_bf16(PAF(2),VFR(2),o[0],0,0,0), C1,0); \
    KRD(GL,3); GAPB(o[1]=__builtin_amdgcn_mfma_f32_32x32x16_bf16(PAF(2),VFR(6),o[1],0,0,0), C1,4); \
    GAPB(o[0]=__builtin_amdgcn_mfma_f32_32x32x16_bf16(PAF(3),VFR(3),o[0],0,0,0), C1,8); \
    GAPB(o[1]=__builtin_amdgcn_mfma_f32_32x32x16_bf16(PAF(3),VFR(7),o[1],0,0,0), C1,12); \
    }while(0)
  #define VRD2(i) do{ vlo[i]=vtr(vp_+(8192+((i)>>2)*4096+((i)&3)*1024)); vhi[i]=vtr(vp_+(8192+((i)>>2)*4096+((i)&3)*1024+512)); }while(0)
  #define STEP128(C0,C1,P0,P1,t,GK,GV,GL) do{ SBAR(); \
    const lds_cptr vp_=vp0+VS*sl_prev; \
    float sacc=(P0[0]+P0[1]); \
    GAPA(C0=__builtin_amdgcn_mfma_f32_32x32x16_bf16(kf[0],qr[0],negm,0,0,0), P0[2],P0[3],P0[4],P0[5],     pw0[0]=PKW(P0,0), pw0[1]=PKW(P0,2), pw0); \
    GAPA(C1=__builtin_amdgcn_mfma_f32_32x32x16_bf16(kf[1],qr[0],negm,0,0,0), P0[6],P0[7],P0[8],P0[9],     pw0[2]=PKW(P0,4), pw0[3]=PKW(P0,6), pw0); \
    GAPA(C0=__builtin_amdgcn_mfma_f32_32x32x16_bf16(kf[2],qr[1],C0,0,0,0),   P0[10],P0[11],P0[12],P0[13], pw1[0]=PKW(P0,8), pw1[1]=PKW(P0,10), pw1); \
    GAPA(C1=__builtin_amdgcn_mfma_f32_32x32x16_bf16(kf[3],qr[1],C1,0,0,0),   P0[14],P0[15],P1[0],P1[1],   pw1[2]=PKW(P0,12),pw1[3]=PKW(P0,14), pw1); \
    GAPA(C0=__builtin_amdgcn_mfma_f32_32x32x16_bf16(kf[4],qr[2],C0,0,0,0),   P1[2],P1[3],P1[4],P1[5],     pw2[0]=PKW(P1,0), pw2[1]=PKW(P1,2), pw2); \
    GAPA(C1=__builtin_amdgcn_mfma_f32_32x32x16_bf16(kf[5],qr[2],C1,0,0,0),   P1[6],P1[7],P1[8],P1[9],     pw2[2]=PKW(P1,4), pw2[3]=PKW(P1,6), pw2); \
    GAPA(C0=__builtin_amdgcn_mfma_f32_32x32x16_bf16(kf[6],qr[3],C0,0,0,0),   P1[10],P1[11],P1[12],P1[13], pw3[0]=PKW(P1,8), pw3[1]=PKW(P1,10), pw3); \
    GAPA(C1=__builtin_amdgcn_mfma_f32_32x32x16_bf16(kf[7],qr[3],C1,0,0,0),   P1[14],P1[15],0.f,0.f,       pw3[2]=PKW(P1,12),pw3[3]=PKW(P1,14), pw3); \
    l_reg+=sacc; \
    if(GK){DMA_K((t)+3,sl_cur);} if(GV){DMA_V((t)+1,sl_next);} \
    CMASK(C0,C1,t); \
    { float a=MX3(C0[0],C0[1],C1[0]),b=MX3(C0[2],C0[3],C1[1]); a=MX3(a,C1[2],C1[3]); \
      _Pragma("unroll") for(int r=4;r<16;r+=4){a=MX3(a,C0[r],C0[r+1]);b=MX3(b,C0[r+2],C0[r+3]);a=MX3(a,C1[r],C1[r+1]);b=MX3(b,C1[r+2],C1[r+3]);} \
      float rm=__builtin_fmaxf(a,b); { auto rr=__builtin_amdgcn_permlane32_swap(__float_as_uint(rm),__float_as_uint(rm),false,false); rm=__builtin_fmaxf(__uint_as_float(rr[0]),__uint_as_float(rr[1])); } \
      resc=false; \
      if(__builtin_expect(__any(rm>(float)THRL),0)){ const float dl=__builtin_fmaxf(rm,0.f); mhat+=dl; \
        _Pragma("unroll") for(int r=0;r<16;++r){C0[r]-=dl;C1[r]-=dl;} \
        _Pragma("unroll") for(int r=0;r<16;++r)negm[r]=-mhat; asm volatile("":"+v"(negm)); \
        const float f=__builtin_amdgcn_exp2f(-dl); l_reg*=f; if(hi==0)wsf[r32]=f; resc=true; } } \
    SBAR(); \
    VRD(0); VRD(4); VRD(1); VRD(5); SBAR(); \
    GAPC(o[0]=__builtin_amdgcn_mfma_f32_32x32x16_bf16(PAF(0),VFR(0),o[0],0,0,0), C0,0); VRD(2); SBAR(); \
    GAPC(o[1]=__builtin_amdgcn_mfma_f32_32x32x16_bf16(PAF(0),VFR(4),o[1],0,0,0), C0,2); VRD(6); SBAR(); \
    KRD(GL,0); GAPC(o[0]=__builtin_amdgcn_mfma_f32_32x32x16_bf16(PAF(1),VFR(1),o[0],0,0,0), C0,4); VRD(3); SBAR(); \
    KRD(GL,1); GAPC(o[1]=__builtin_amdgcn_mfma_f32_32x32x16_bf16(PAF(1),VFR(5),o[1],0,0,0), C0,6); VRD(7); SBAR(); \
    KRD(GL,2); GAPC(o[0]=__builtin_amdgcn_mfma_f32_32x32x16_bf16(PAF(2),VFR(2),o[0],0,0,0), C0,8); VRD2(0); SBAR(); \
    KRD(GL,3); GAPC(o[1]=__builtin_amdgcn_mfma_f32_32x32x16_bf16(PAF(2),VFR(6),o[1],0,0,0), C0,10); VRD2(4); SBAR(); \
    GAPC(o[0]=__builtin_amdgcn_mfma_f32_32x32x16_bf16(PAF(3),VFR(3),o[0],0,0,0), C0,12); VRD2(1); SBAR(); \
    GAPC(o[1]=__builtin_amdgcn_mfma_f32_32x32x16_bf16(PAF(3),VFR(7),o[1],0,0,0), C0,14); VRD2(5); SBAR(); \
    GAPC(o[2]=__builtin_amdgcn_mfma_f32_32x32x16_bf16(PAF(0),VFR(0),o[2],0,0,0), C1,0); VRD2(2); SBAR(); \
    GAPC(o[3]=__builtin_amdgcn_mfma_f32_32x32x16_bf16(PAF(0),VFR(4),o[3],0,0,0), C1,2); VRD2(6); SBAR(); \
    GAPC(o[2]=__builtin_amdgcn_mfma_f32_32x32x16_bf16(PAF(1),VFR(1),o[2],0,0,0), C1,4); VRD2(3); SBAR(); \
    GAPC(o[3]=__builtin_amdgcn_mfma_f32_32x32x16_bf16(PAF(1),VFR(5),o[3],0,0,0), C1,6); VRD2(7); SBAR(); \
    GAPC(o[2]=__builtin_amdgcn_mfma_f32_32x32x16_bf16(PAF(2),VFR(2),o[2],0,0,0), C1,8); \
    GAPC(o[3]=__builtin_amdgcn_mfma_f32_32x32x16_bf16(PAF(2),VFR(6),o[3],0,0,0), C1,10); \
    GAPC(o[2]=__builtin_amdgcn_mfma_f32_32x32x16_bf16(PAF(3),VFR(3),o[2],0,0,0), C1,12); \
    GAPC(o[3]=__builtin_amdgcn_mfma_f32_32x32x16_bf16(PAF(3),VFR(7),o[3],0,0,0), C1,14); \
    }while(0)
  #define STEPX(...) do{ if constexpr(DV128){ STEP128(__VA_ARGS__); } else { STEP(__VA_ARGS__); } }while(0)
  int t=1;
  #undef CMASK
  #define CMASK(P0,P1,t) do{}while(0)
  for(;t+5<NT;t+=2){
    STEPX(pB0,pB1,pA0,pA1,t,true,true,true);     WB2(); RESC(); ROT();
    STEPX(pA0,pA1,pB0,pB1,t+1,true,true,true);   WB2(); RESC(); ROT();
  }
  #undef CMASK
  #define CMASK(P0,P1,t) do{}while(0)
  #define ENDW(tt) do{ if((tt)+3<NT){WB2();} else if((tt)+2<NT){WB1();} else {WAIT_BAR(0);} }while(0)
  for(;t+1<NT;t+=2){
    STEPX(pB0,pB1,pA0,pA1,t,(t+3<NT),(t+1<NT),(t+1<NT));       ENDW(t);   RESC(); ROT();
    STEPX(pA0,pA1,pB0,pB1,t+1,(t+4<NT),(t+2<NT),(t+2<NT));     ENDW(t+1); RESC(); ROT();
  }
  STEPX(pB0,pB1,pA0,pA1,NT-1,false,false,false); RESC();
  { float sacc=pB0[0]+pB0[1]; _Pragma("unroll") for(int r=2;r<16;++r)sacc+=pB0[r]; _Pragma("unroll") for(int r=0;r<16;++r)sacc+=pB1[r]; l_reg+=sacc;
    pw0=(u32x4){PKW(pB0,0),PKW(pB0,2),PKW(pB0,4),PKW(pB0,6)};pw1=(u32x4){PKW(pB0,8),PKW(pB0,10),PKW(pB0,12),PKW(pB0,14)};pw2=(u32x4){PKW(pB1,0),PKW(pB1,2),PKW(pB1,4),PKW(pB1,6)};pw3=(u32x4){PKW(pB1,8),PKW(pB1,10),PKW(pB1,12),PKW(pB1,14)};
    int lane_d=lane; asm volatile("":"+v"(lane_d)); const int vb0=(int)(lds0+LDS_V)+((lane_d>>4)&1)*32+(lane_d&3)*8+(4*(lane_d>>5)+((lane_d&15)>>2))*64;
    SBAR(); pv(o,vb0+VS*sl_cur,PAF(0),PAF(1),PAF(2),PAF(3)); if constexpr(DV128){ pv(o+2,vb0+VS*sl_cur+8192,PAF(0),PAF(1),PAF(2),PAF(3)); } }
  #undef PKW
  #undef PAF
  #undef VFR
  #undef PIN
  #undef MX3
  #undef GAPA
  #undef GAPB
  #undef GAPC
  #undef EX
  #undef VRD
  #undef KRD
  #undef STEP
  #undef STEP128
  #undef STEPX
  #undef VRD2
  #undef WB2
  #undef WB1
  #undef ENDW
  {auto rr=__builtin_amdgcn_permlane32_swap(__float_as_uint(l_reg),__float_as_uint(l_reg),false,false);l_reg=__uint_as_float(rr[0])+__uint_as_float(rr[1]);}
  if(hi==0)wsf[32+r32]=l_reg;asm volatile("s_waitcnt lgkmcnt(0)":::"memory");
  float rli[16];
  #pragma unroll
  for(int r=0;r<16;++r)rli[r]=__builtin_amdgcn_rcpf(wsf[32+crow(r,hi)]);
  bf16*Ow=Ob+(long)(wid*QBLK)*PO;
  { bf16*stg=(bf16*)(shm+L_OST)+wid*2048;
    #pragma unroll
    for(int hf=0;hf<VS;++hf){
      #pragma unroll
      for(int r=0;r<16;++r){const int orow=crow(r,hi);
        #pragma unroll
        for(int d0=0;d0<2;++d0)stg[orow*64+d0*32+r32]=__float2bfloat16(o[2*hf+d0][r]*rli[r]);}
      asm volatile("s_waitcnt lgkmcnt(0)":::"memory");
      #pragma unroll
      for(int i=0;i<4;++i){const int row=i*8+(lane>>3),ch=lane&7; const u32x4 v=*(const u32x4*)(stg+row*64+ch*8); ATTN_STORE16(Ow+(long)row*PO+hf*64+ch*8,v);}
      asm volatile("s_waitcnt lgkmcnt(0)":::"memory"); } }
  asm volatile("s_waitcnt lgkmcnt(0)\n\ts_barrier":::"memory");
  #undef DMA_K
  #undef DMA_V
  #undef CMASK
  #undef START
  #undef RESC
  #undef ROT
}
constexpr int ATTN_LDS_BYTES=LDS_BYTES;
#undef SBAR
#undef WAIT_BAR
}
#include <hip/hip_cooperative_groups.h>
namespace cg = cooperative_groups;
#define LAS __attribute__((address_space(3)))
typedef unsigned short bf16_t;
typedef unsigned v4u __attribute__((ext_vector_type(4)));
typedef unsigned v2u __attribute__((ext_vector_type(2)));
typedef float f32x4 __attribute__((ext_vector_type(4)));
typedef float cf __attribute__((ext_vector_type(2)));

constexpr int NTHR = 512;
constexpr int DMOD = 1024, NBATCH = 4, SEQ = 8192, CTXL = 256, DEPTH = 4;
constexpr int ML = NBATCH * SEQ, MC = NBATCH * CTXL, MT = ML + MC;
constexpr int INW = 2816, DFF = 2816, NKEY = SEQ + CTXL;
constexpr float EPSF = 1e-6f;
constexpr int FFTN = 16384;

constexpr size_t MiB = 1u << 20;
constexpr size_t WS_MOD = 1 * MiB;
constexpr size_t WS_LAM = 1 * MiB + 512 * 1024;
constexpr size_t WS_ROPE = WS_LAM + 256;
constexpr size_t WS_TW = 1 * MiB + 768 * 1024;
constexpr size_t WS_WIN = 2 * MiB, WS_WOUT = WS_WIN + (size_t)INW * 1024 * 2, WS_WUP = WS_WOUT + 2 * MiB, WS_WDN = WS_WUP + (size_t)2 * DFF * 1024 * 2;
constexpr size_t WS_CTXX = 26 * MiB;
constexpr size_t WS_FILT = 30 * MiB, WS_FILTC = 62 * MiB;
constexpr size_t WS_H = 64 * MiB;
constexpr size_t WS_KF = 64 * MiB;
constexpr size_t WS_RAW = 130 * MiB;
constexpr size_t WS_YRAW = 130 * MiB;
constexpr size_t WS_YH = 213 * MiB, WS_YHC = 245 * MiB;
constexpr size_t WS_QA = 312 * MiB, WS_KA = 329 * MiB, WS_VA = 338 * MiB, WS_QD = 347 * MiB, WS_KD = 380 * MiB, WS_VD = 413 * MiB;
constexpr size_t WS_HYR = 446 * MiB, WS_HYRC = 494 * MiB;
constexpr size_t WS_G = 130 * MiB;
constexpr size_t WS_END = 496 * MiB;
static_assert(WS_WDN + (size_t)DFF * 1024 * 2 <= WS_CTXX, "weights");
static_assert(WS_H + (size_t)MT * 1024 * 2 <= WS_RAW && WS_RAW + (size_t)MT * INW * 2 <= WS_QA, "map1");
static_assert(WS_YRAW + (size_t)MT * 1280 * 2 <= WS_YH && WS_G + (size_t)MT * DFF * 2 <= WS_QA, "map2");
constexpr int LDS_BYTES = 147456;
#ifndef PHM
#define PHM 0xffff
#endif
#define PH(b) ((PHM >> (b)) & 1)
#ifndef REP_ATT
#define REP_ATT 1
#endif
#ifndef REP_HY
#define REP_HY 1
#endif
#ifndef REP_GEMM
#define REP_GEMM 1
#endif
#ifndef REP_PREP
#define REP_PREP 1
#endif
#ifndef REP_PP
#define REP_PP 1
#endif
#ifndef REP_MERGE
#define REP_MERGE 1
#endif
#ifndef REP_N2
#define REP_N2 1
#endif
#ifndef REP_GLU
#define REP_GLU 1
#endif
#ifndef REP_GEMM2
#define REP_GEMM2 1
#endif
#ifndef REP_PRO
#define REP_PRO 1
#endif
#ifndef PROBE_PLAIN_LAUNCH
#define PROBE_PLAIN_LAUNCH 0
#endif
#ifndef EXTRA_SYNC
#define EXTRA_SYNC 0
#endif

typedef float f32x2_cv __attribute__((ext_vector_type(2))); typedef __bf16 bf16x2_cv __attribute__((ext_vector_type(2)));
__device__ __forceinline__ unsigned pk2(float lo, float hi) { const f32x2_cv v = {lo, hi}; const bf16x2_cv b = __builtin_convertvector(v, bf16x2_cv); return __builtin_bit_cast(unsigned, b); }
__device__ __forceinline__ unsigned f2bf(float f) { return pk2(f, f) & 0xffffu; }

__device__ __forceinline__ float bf2f(bf16_t u) { return __uint_as_float((unsigned)u << 16); }
__device__ __forceinline__ float bflo(unsigned w) { return __uint_as_float(w << 16); }
__device__ __forceinline__ float bfhi(unsigned w) { return __uint_as_float(w & 0xffff0000u); }
__device__ __forceinline__ float shx(float v, int m, int lane) { return __builtin_bit_cast(float, __builtin_amdgcn_ds_bpermute((lane ^ m) << 2, __builtin_bit_cast(int, v))); }
template <int CTRL> __device__ __forceinline__ float dpp_mov(float v) { return __builtin_bit_cast(float, __builtin_amdgcn_update_dpp(0, __builtin_bit_cast(int, v), CTRL, 0xF, 0xF, false)); }
__device__ __forceinline__ float row16_sum(float v) {
    v += dpp_mov<0xB1>(v);
    v += dpp_mov<0x4E>(v);
    v += dpp_mov<0x141>(v);
    v += dpp_mov<0x140>(v);
    return v;
}
__device__ __forceinline__ float xrow_sum(float v) {
    { const auto rr = __builtin_amdgcn_permlane16_swap(__float_as_uint(v), __float_as_uint(v), false, false); v = __uint_as_float(rr[0]) + __uint_as_float(rr[1]); }
    { const auto rr = __builtin_amdgcn_permlane32_swap(__float_as_uint(v), __float_as_uint(v), false, false); v = __uint_as_float(rr[0]) + __uint_as_float(rr[1]); }
    return v;
}
__device__ __forceinline__ float wave_sum(float v) {
    return xrow_sum(row16_sum(v));
}
__device__ __forceinline__ float wave_sum_bperm(float v) {
    const int lane = lane_id_v();
#pragma unroll
    for (int o = 1; o < 64; o <<= 1) v += shx(v, o, lane);
    return v;
}
__device__ __forceinline__ float block_sum(float v, LAS float* RED, int tid) {
    v = wave_sum(v); __syncthreads(); if ((tid & 63) == 0) RED[tid >> 6] = v; __syncthreads();
    float s = 0.f;
#pragma unroll
    for (int w = 0; w < 8; ++w) s += RED[w];
    return s;
}

struct EpiGateRes {
    static constexpr bool PERM = false, AFTER_DRAIN = false;
    const float* base_lat; float* out_lat; const float* base_ctx; float* out_ctx; const float* gate; int row_off;
    __device__ __forceinline__ void operator()(const pg8::f32x4 (&acc)[2][2][4][2], const pg8::Unit& u, int wr, int wc, int fr, int fq) const {
        const int col0 = u.pn * 256 + wc * 32 + 4 * fq;
#pragma unroll
        for (int ai = 0; ai < 2; ++ai)
#pragma unroll
            for (int m = 0; m < 4; ++m) {
                const int r = row_off + u.pm * 256 + ai * 128 + wr * 64 + m * 16 + fr;
                const bool lat = r < ML; const int bi = lat ? (r >> 13) : 4;
                const size_t off = lat ? (size_t)r * 1024 : (size_t)(r - ML) * 1024;
                const float* bp = (lat ? base_lat : base_ctx) + off + col0; float* op = (lat ? out_lat : out_ctx) + off + col0;
                const float* gp = gate + bi * 6144 + col0;
#pragma unroll
                for (int bj = 0; bj < 2; ++bj)
#pragma unroll
                    for (int n = 0; n < 2; ++n) {
                        const pg8::f32x4 g4 = *(const pg8::f32x4*)(gp + bj * 128 + n * 16), b4 = *(const pg8::f32x4*)(bp + bj * 128 + n * 16);
                        *(pg8::f32x4*)(op + bj * 128 + n * 16) = b4 + g4 * acc[ai][bj][m][n];
                    }
            }
    }
};

__device__ __forceinline__ float dpp_ror1(float v) { return __builtin_bit_cast(float, __builtin_amdgcn_update_dpp(0, __builtin_bit_cast(int, v), 0x121, 0xF, 0xF, false)); }
__device__ __forceinline__ float dpp_rol1(float v) { return __builtin_bit_cast(float, __builtin_amdgcn_update_dpp(0, __builtin_bit_cast(int, v), 0x12F, 0xF, 0xF, false)); }
struct EpiGlu {
    static constexpr bool PERM = true, AFTER_DRAIN = false;
    bf16_t* G; const float* cw; const float* cb; int nrows;
    __device__ __forceinline__ void operator()(const pg8::f32x4 (&acc)[2][2][4][2], const pg8::Unit& u, int wr, int wc, int fr, int fq) const {
        const int ch0 = u.pn * 128 + wc * 32 + 8 * fq;
        float w0[8], w1[8], w2[8], bb[8];
#pragma unroll
        for (int hq = 0; hq < 2; ++hq) { const pg8::f32x4 q0 = *(const pg8::f32x4*)(cw + ch0 + 4 * hq), q1 = *(const pg8::f32x4*)(cw + DFF + ch0 + 4 * hq), q2 = *(const pg8::f32x4*)(cw + 2 * DFF + ch0 + 4 * hq), q3 = *(const pg8::f32x4*)(cb + ch0 + 4 * hq);
#pragma unroll
            for (int e = 0; e < 4; ++e) { w0[4 * hq + e] = q0[e]; w1[4 * hq + e] = q1[e]; w2[4 * hq + e] = q2[e]; bb[4 * hq + e] = q3[e]; } }
#pragma unroll
        for (int ai = 0; ai < 2; ++ai) {
            const int kb = u.pm * 4 + ai * 2 + wr;
            float ruP[8], rdC[8];
#pragma unroll
            for (int c = 0; c < 8; ++c) { ruP[c] = 0.f; rdC[c] = dpp_rol1(acc[ai][0][0][c >> 2][c & 3]); }
#pragma unroll
            for (int m = 0; m < 4; ++m) {
                const int rl = 16 * m + fr, gr = 62 * kb - 1 + rl;
                bool first, last; if (gr < ML) { const int t = gr & 8191; first = t == 0; last = t == 8191; } else { const int t = (gr - ML) & 255; first = t == 0; last = t == 255; }
                float res[8];
#pragma unroll
                for (int c = 0; c < 8; ++c) {
                    const int n = c >> 2, e = c & 3;
                    const float x0 = acc[ai][0][m][n][e];
                    const float ruC = dpp_ror1(x0), rdN = m < 3 ? dpp_rol1(acc[ai][0][m < 3 ? m + 1 : 3][n][e]) : 0.f;
                    float xu = fr == 0 ? ruP[c] : ruC, xd = fr == 15 ? rdN : rdC[c];
                    xu = first ? 0.f : xu; xd = last ? 0.f : xd;
                    ruP[c] = ruC; rdC[c] = rdN;
                    const float x = w0[c] * xu + w1[c] * x0 + w2[c] * xd + bb[c];
                    const float u2 = -2.302208198f * (x + 0.044715f * x * x * x);
                    res[c] = x * __builtin_amdgcn_rcpf(1.0f + __builtin_amdgcn_exp2f(u2)) * acc[ai][1][m][n][e];
                }
                if (rl >= 1 && rl <= 62 && gr < nrows) { v4u o; o.x = pk2(res[0], res[1]); o.y = pk2(res[2], res[3]); o.z = pk2(res[4], res[5]); o.w = pk2(res[6], res[7]);
                    *(v4u*)(G + (size_t)gr * DFF + ch0) = o; }
            }
        }
    }
};

struct EpiInProj {
    static constexpr bool PERM = true, AFTER_DRAIN = false;
    bf16_t *qa, *ka, *va, *qd, *kd, *vd, *hyr, *hyrc; const float *qn_a, *kn_a, *qn_d, *kn_d; const cf* rope;
    __device__ __forceinline__ void operator()(const pg8::f32x4 (&acc)[2][2][4][2], const pg8::Unit& u, int wr, int wc, int fr, int fq) const {
        const int pn = u.pn, lane = fr + 16 * fq;
        bool normed, keyrow; const float* gain = qn_a; float scale = 1.f; bf16_t* dbase; int dpitch, dcol, nh = 1, hidx = 0;
        if (pn == 0) { normed = true; gain = qn_a; scale = attn_body::C2; dbase = qa; dpitch = 256; keyrow = false; dcol = wc * 64; }
        else if (pn == 1) { keyrow = true; dpitch = 64; nh = 2; dcol = 0; if (wc < 2) { normed = true; gain = kn_a; dbase = ka; hidx = wc; } else { normed = false; dbase = va; hidx = wc - 2; } }
        else if (pn < 5) { normed = false; dbase = hyr; dpitch = 0; keyrow = false; dcol = (pn - 2) * 256 + wc * 64; }
        else if (pn < 7) { normed = true; gain = qn_d; scale = attn_body::C2; dbase = qd; dpitch = 512; keyrow = false; dcol = ((pn - 5) * 4 + wc) * 64; }
        else if (pn < 9) { normed = true; gain = kn_d; dbase = kd; dpitch = 64; keyrow = true; nh = 8; hidx = (pn - 7) * 4 + wc; dcol = 0; }
        else { normed = false; dbase = vd; dpitch = 128; keyrow = true; nh = 4; hidx = (pn - 9) * 2 + (wc >> 1); dcol = (wc & 1) * 64; }
        pg8::f32x4 gg[2][2];
#pragma unroll
        for (int bj = 0; bj < 2; ++bj)
#pragma unroll
            for (int n = 0; n < 2; ++n) gg[bj][n] = *(const pg8::f32x4*)(gain + 32 * bj + 8 * fq + 4 * n);
#pragma unroll
        for (int ai = 0; ai < 2; ++ai)
#pragma unroll
            for (int m = 0; m < 4; ++m) {
                const int r = u.pm * 256 + ai * 128 + wr * 64 + m * 16 + fr;
                const bool lat = r < ML; int b, t; if (lat) { b = r >> 13; t = r & 8191; } else { b = (r - ML) >> 8; t = (r - ML) & 255; }
                const size_t drow = keyrow ? (size_t)(b * nh + hidx) * NKEY + (lat ? 256 + t : t) : (size_t)r;
                if (pn >= 2 && pn < 5) {
                    bf16_t* cbp = lat ? hyr + (size_t)b * 768 * 8192 + t : hyrc + (size_t)b * 768 * 256 + t; const size_t cst = lat ? 8192 : 256;
#pragma unroll
                    for (int bj = 0; bj < 2; ++bj)
#pragma unroll
                        for (int n = 0; n < 2; ++n)
#pragma unroll
                            for (int e = 0; e < 4; ++e) cbp[(size_t)(dcol + 32 * bj + 8 * fq + 4 * n + e) * cst] = (bf16_t)f2bf(acc[ai][bj][m][n][e]);
                    continue;
                }
                bf16_t* dp = dbase + drow * dpitch + dcol + 8 * fq;
                float rinv = 1.f;
                if (normed) { float ss = 0.f;
#pragma unroll
                    for (int bj = 0; bj < 2; ++bj)
#pragma unroll
                        for (int n = 0; n < 2; ++n) { const pg8::f32x4 x = acc[ai][bj][m][n]; ss += (x[0] * x[0] + x[1] * x[1]) + (x[2] * x[2] + x[3] * x[3]); }
                    ss = xrow_sum(ss);
                    rinv = scale * __builtin_amdgcn_rsqf(ss * (1.0f / 64.0f) + EPSF); }
#pragma unroll
                for (int bj = 0; bj < 2; ++bj) {
                    pg8::f32x4 y0 = acc[ai][bj][m][0], y1 = acc[ai][bj][m][1];
                    if (normed) {
                        y0 = y0 * rinv * gg[bj][0]; y1 = y1 * rinv * gg[bj][1];
                        if (lat) { const int p = bj == 0 ? (t >> 6) : (t & 63); const pg8::f32x4* rp = (const pg8::f32x4*)(rope + p * 16 + 4 * fq); const pg8::f32x4 c01 = rp[0], c23 = rp[1];
                            const pg8::f32x4 z0 = {y0[0] * c01[0] - y0[1] * c01[1], y0[0] * c01[1] + y0[1] * c01[0], y0[2] * c01[2] - y0[3] * c01[3], y0[2] * c01[3] + y0[3] * c01[2]};
                            const pg8::f32x4 z1 = {y1[0] * c23[0] - y1[1] * c23[1], y1[0] * c23[1] + y1[1] * c23[0], y1[2] * c23[2] - y1[3] * c23[3], y1[2] * c23[3] + y1[3] * c23[2]};
                            y0 = z0; y1 = z1; }
                    }
                    v4u o; o.x = pk2(y0[0], y0[1]); o.y = pk2(y0[2], y0[3]); o.z = pk2(y1[0], y1[1]); o.w = pk2(y1[2], y1[3]);
                    *(v4u*)(dp + 32 * bj) = o;
                }
            }
    }
};

template <int PERM_UP = 0> __device__ __forceinline__ void transpose_item(const float* W, int K, int N, bf16_t* WT, LAS float* scr, int item, int lane) {
    const int nblk = N / 32, kb = item / nblk, nb = item % nblk, k0 = 64 * kb, n0 = 32 * nb;
#pragma unroll 8
    for (int i = 0; i < 32; ++i) { const int kk = 2 * i + (lane >> 5); scr[kk * 33 + (lane & 31)] = W[(size_t)(k0 + kk) * N + n0 + (lane & 31)]; }
    asm volatile("s_waitcnt lgkmcnt(0)" ::: "memory");
    const int c = lane & 7;
#pragma unroll
    for (int j = 0; j < 4; ++j) { const int n = (lane >> 3) + 8 * j; const LAS float* s = scr + (8 * c) * 33 + n;
        v4u o; o.x = pk2(s[0 * 33], s[1 * 33]); o.y = pk2(s[2 * 33], s[3 * 33]); o.z = pk2(s[4 * 33], s[5 * 33]); o.w = pk2(s[6 * 33], s[7 * 33]);
        int row = n0 + n; if (PERM_UP == 2) { const int nl = row & 255; row = (row & ~255) + 128 * ((nl >> 5) & 1) + 32 * (nl >> 6) + (nl & 31); }
        if (PERM_UP == 1) { const bool isv = row >= DFF; const int ch = isv ? row - DFF : row; row = (ch >> 7) * 256 + (isv ? 128 : 0) + (ch & 127); }
        *(v4u*)(WT + (size_t)row * K + k0 + 8 * c) = o; }
    asm volatile("s_waitcnt lgkmcnt(0)" ::: "memory");
}

__device__ __forceinline__ void norm_mod(const float* xl, const float* xc, const float* g, const float* mod, int shoff, int scoff, bf16_t* H, int nrows, int gw, int NGW, int lane) {
    for (int r = gw; r < nrows; r += 4 * NGW) {
        int rr[4]; const float* xp[4]; const float* mp[4];
#pragma unroll
        for (int k = 0; k < 4; ++k) { const int rk = r + k * NGW; rr[k] = rk < nrows ? rk : r; xp[k] = rr[k] < ML ? xl + (size_t)rr[k] * 1024 : xc + (size_t)(rr[k] - ML) * 1024; mp[k] = mod + (rr[k] < ML ? (rr[k] >> 13) : 4) * 6144; }
        f32x4 v[4][4]; float ss[4];
#pragma unroll
        for (int k = 0; k < 4; ++k)
#pragma unroll
            for (int j = 0; j < 4; ++j) v[k][j] = __builtin_nontemporal_load(&((const f32x4*)xp[k])[lane + 64 * j]);
#pragma unroll
        for (int k = 0; k < 4; ++k) { ss[k] = 0.f;
#pragma unroll
            for (int j = 0; j < 4; ++j) ss[k] += (v[k][j].x * v[k][j].x + v[k][j].y * v[k][j].y) + (v[k][j].z * v[k][j].z + v[k][j].w * v[k][j].w); }
#pragma unroll
        for (int o = 1; o < 64; o <<= 1) {
#pragma unroll
            for (int k = 0; k < 4; ++k) { if (o == 1) ss[k] = wave_sum(ss[k]); } }
#pragma unroll
        for (int j = 0; j < 4; ++j) { const int col = 4 * lane + 256 * j;
            const f32x4 g4 = *(const f32x4*)(g + col);
#pragma unroll
            for (int k = 0; k < 4; ++k) { if (k == 0 || r + k * NGW < nrows) {
                const float rinv = 1.0f / sqrtf(ss[k] * (1.0f / 1024.0f) + EPSF);
                const f32x4 sc4 = *(const f32x4*)(mp[k] + scoff + col), sh4 = *(const f32x4*)(mp[k] + shoff + col); const f32x4 o = (v[k][j] * rinv * g4) * (sc4 + 1.0f) + sh4;
                v2u w; w.x = pk2(o.x, o.y); w.y = pk2(o.z, o.w); __builtin_nontemporal_store(w, (v2u*)(H + (size_t)rr[k] * 1024 + col)); } }
        }
    }
}

__device__ __forceinline__ cf mk2(float x, float y) { cf r; r.x = x; r.y = y; return r; }
__device__ __forceinline__ cf cmul(cf a, cf b) { return mk2(a.x * b.x - a.y * b.y, a.x * b.y + a.y * b.x); }
__device__ __forceinline__ cf cmulc(cf a, cf b) { return mk2(a.x * b.x + a.y * b.y, a.y * b.x - a.x * b.y); }
__device__ __forceinline__ cf ld_f2_l2(const cf* p) {
    const unsigned long long w = __hip_atomic_load((const unsigned long long*)p, __ATOMIC_RELAXED, __HIP_MEMORY_SCOPE_AGENT);
    return mk2(__uint_as_float((unsigned)w), __uint_as_float((unsigned)(w >> 32)));
}
__device__ __forceinline__ int PX(int i) { return i + (i >> 6); }
__device__ __forceinline__ cf twid(float frac) { return mk2(__builtin_amdgcn_cosf(frac), -__builtin_amdgcn_sinf(frac)); }
__device__ __forceinline__ void bfly4_fwd(cf& a0, cf& a1, cf& a2, cf& a3) {
    const cf s02 = a0 + a2, d02 = a0 - a2, s13 = a1 + a3, d13 = a1 - a3;
    a0 = s02 + s13; a2 = s02 - s13; a1 = mk2(d02.x + d13.y, d02.y - d13.x); a3 = mk2(d02.x - d13.y, d02.y + d13.x);
}
__device__ __forceinline__ void bfly4_inv(cf& a0, cf& a1, cf& a2, cf& a3) {
    const cf s02 = a0 + a2, d02 = a0 - a2, s13 = a1 + a3, d13 = a1 - a3;
    a0 = s02 + s13; a2 = s02 - s13; a1 = mk2(d02.x - d13.y, d02.y + d13.x); a3 = mk2(d02.x + d13.y, d02.y - d13.x);
}
template <int LG, bool INV> __device__ __forceinline__ void fft_pass2(LAS cf* X, int tid) {
    constexpr int L = 1 << LG, L16 = L >> 4, L4 = L >> 2; constexpr float fL = 1.0f / (float)L;
#pragma unroll 1
    for (int i = 0; i < 2; ++i) {
        const int it = tid + 512 * i; int g, j;
        if (LG == 14) { g = 0; j = it; } else if (LG == 10) { j = it & 63; g = it >> 6; } else { g = it & 255; j = it >> 8; }
        const int base = g * L + j;
        cf e[4][4];
#pragma unroll
        for (int r = 0; r < 4; ++r)
#pragma unroll
            for (int m = 0; m < 4; ++m) e[r][m] = X[PX(base + r * L16 + m * L4)];
        const cf v1 = twid((float)(4 * j) * fL), v2 = cmul(v1, v1), v3 = cmul(v2, v1);
        if (!INV) {
#pragma unroll
            for (int r = 0; r < 4; ++r) { bfly4_fwd(e[r][0], e[r][1], e[r][2], e[r][3]);
                const cf w1 = twid((float)(j + r * L16) * fL), w2 = cmul(w1, w1), w3 = cmul(w2, w1);
                e[r][1] = cmul(e[r][1], w1); e[r][2] = cmul(e[r][2], w2); e[r][3] = cmul(e[r][3], w3); }
#pragma unroll
            for (int p = 0; p < 4; ++p) { bfly4_fwd(e[0][p], e[1][p], e[2][p], e[3][p]); e[1][p] = cmul(e[1][p], v1); e[2][p] = cmul(e[2][p], v2); e[3][p] = cmul(e[3][p], v3); }
        } else {
#pragma unroll
            for (int p = 0; p < 4; ++p) { e[1][p] = cmulc(e[1][p], v1); e[2][p] = cmulc(e[2][p], v2); e[3][p] = cmulc(e[3][p], v3); bfly4_inv(e[0][p], e[1][p], e[2][p], e[3][p]); }
#pragma unroll
            for (int r = 0; r < 4; ++r) { const cf w1 = twid((float)(j + r * L16) * fL), w2 = cmul(w1, w1), w3 = cmul(w2, w1);
                e[r][1] = cmulc(e[r][1], w1); e[r][2] = cmulc(e[r][2], w2); e[r][3] = cmulc(e[r][3], w3); bfly4_inv(e[r][0], e[r][1], e[r][2], e[r][3]); }
        }
#pragma unroll
        for (int r = 0; r < 4; ++r)
#pragma unroll
            for (int m = 0; m < 4; ++m) X[PX(base + r * L16 + m * L4)] = e[r][m];
    }
    __syncthreads();
}
__device__ __forceinline__ void fft_last_fwd(LAS cf* X, int tid, cf* KFW, float bias, float scale) {
#pragma unroll 2
    for (int i = 0; i < 8; ++i) { const int it = tid + 512 * i, g = it & 255, k = it >> 8, base = g * 64 + 4 * k;
        cf e0 = X[PX(base)], e1 = X[PX(base + 1)], e2 = X[PX(base + 2)], e3 = X[PX(base + 3)];
        bfly4_fwd(e0, e1, e2, e3);
        if (KFW) { cf* o = KFW + (4 * k) * 256 + g; o[0] = mk2((e0.x + bias) * scale, e0.y * scale); o[256] = mk2((e1.x + bias) * scale, e1.y * scale); o[512] = mk2((e2.x + bias) * scale, e2.y * scale); o[768] = mk2((e3.x + bias) * scale, e3.y * scale); }
        else { X[PX(base)] = e0; X[PX(base + 1)] = e1; X[PX(base + 2)] = e2; X[PX(base + 3)] = e3; } }
    __syncthreads();
}
__device__ __forceinline__ void fft_first_inv_mul(LAS cf* X, int tid, const cf* KFR) {
#pragma unroll 2
    for (int i = 0; i < 8; ++i) { const int it = tid + 512 * i, g = it & 255, k = it >> 8, base = g * 64 + 4 * k; const cf* q = KFR + (4 * k) * 256 + g;
        cf e0 = cmul(X[PX(base)], ld_f2_l2(q)), e1 = cmul(X[PX(base + 1)], ld_f2_l2(q + 256)), e2 = cmul(X[PX(base + 2)], ld_f2_l2(q + 512)), e3 = cmul(X[PX(base + 3)], ld_f2_l2(q + 768));
        bfly4_inv(e0, e1, e2, e3);
        X[PX(base)] = e0; X[PX(base + 1)] = e1; X[PX(base + 2)] = e2; X[PX(base + 3)] = e3; }
    __syncthreads();
}
__device__ __forceinline__ void fft_mid_mul(LAS cf* X, int tid, const cf* KFR) {
#pragma unroll 2
    for (int i = 0; i < 8; ++i) { const int it = tid + 512 * i, g = it & 255, k = it >> 8, base = g * 64 + 4 * k; const cf* q = KFR + (4 * k) * 256 + g;
        cf e0 = X[PX(base)], e1 = X[PX(base + 1)], e2 = X[PX(base + 2)], e3 = X[PX(base + 3)];
        const cf k0 = ld_f2_l2(q), k1 = ld_f2_l2(q + 256), k2 = ld_f2_l2(q + 512), k3 = ld_f2_l2(q + 768);
        bfly4_fwd(e0, e1, e2, e3);
        e0 = cmul(e0, k0); e1 = cmul(e1, k1); e2 = cmul(e2, k2); e3 = cmul(e3, k3);
        bfly4_inv(e0, e1, e2, e3);
        X[PX(base)] = e0; X[PX(base + 1)] = e1; X[PX(base + 2)] = e2; X[PX(base + 3)] = e3; }
    __syncthreads();
}
__device__ __forceinline__ void fft_fwd_lds(LAS cf* X, int tid) { fft_pass2<14, false>(X, tid); fft_pass2<10, false>(X, tid); fft_pass2<6, false>(X, tid); }
__device__ __forceinline__ void fft_inv_lds(LAS cf* X, int tid) { fft_pass2<6, true>(X, tid); fft_pass2<10, true>(X, tid); fft_pass2<14, true>(X, tid); }
__device__ __forceinline__ void conv8(const bf16_t* p, int c, int n, float w0, float w1, float w2, float b, float (&o)[8]) {
    const v4u v = *(const v4u*)(p + 8 * c);
    const float um = c > 0 ? bf2f(p[8 * c - 1]) : 0.f, up = 8 * c + 8 < n ? bf2f(p[8 * c + 8]) : 0.f;
    const float u0 = bflo(v.x), u1 = bfhi(v.x), u2 = bflo(v.y), u3 = bfhi(v.y), u4 = bflo(v.z), u5 = bfhi(v.z), u6 = bflo(v.w), u7 = bfhi(v.w);
    o[0] = w0 * um + w1 * u0 + w2 * u1 + b; o[1] = w0 * u0 + w1 * u1 + w2 * u2 + b; o[2] = w0 * u1 + w1 * u2 + w2 * u3 + b; o[3] = w0 * u2 + w1 * u3 + w2 * u4 + b;
    o[4] = w0 * u3 + w1 * u4 + w2 * u5 + b; o[5] = w0 * u4 + w1 * u5 + w2 * u6 + b; o[6] = w0 * u5 + w1 * u6 + w2 * u7 + b; o[7] = w0 * u6 + w1 * u7 + w2 * up + b;
}
__device__ __forceinline__ float hy_in(const bf16_t* p, int t, int n, float w0, float w1, float w2, float b) {
    const float um = t > 0 ? bf2f(p[t - 1]) : 0.f, u0 = bf2f(p[t]), up = t < n - 1 ? bf2f(p[t + 1]) : 0.f;
    return w0 * um + w1 * u0 + w2 * up + b;
}

#define XB_TMO      128
#define XB_XCNT(j)  (256  + 64 * (j))
#define XB_XSUB(j)  (1280 + 64 * (j))
#define XB_XGEN(j)  (2304 + 64 * (j))
#define XB_TOP      3328
#define XB_TOPGEN   3392
#define XCD_BAR_WORDS 3456
#define XB_SPIN_CAP (1u << 18)

__device__ __forceinline__ unsigned xb_ld(unsigned* p)              { return __hip_atomic_load(p, __ATOMIC_RELAXED, __HIP_MEMORY_SCOPE_AGENT); }
__device__ __forceinline__ unsigned xb_add(unsigned* p, unsigned v) { return __hip_atomic_fetch_add(p, v, __ATOMIC_RELAXED, __HIP_MEMORY_SCOPE_AGENT); }
__device__ __forceinline__ unsigned xb_xcc_id() { return (unsigned)__builtin_amdgcn_s_getreg((3 << 11) | 20) & 0xFu; }
#define XB_SPIN(cond, bar) do { unsigned _sp = 0; while (cond) { __builtin_amdgcn_s_sleep(1); \
    if ((++_sp & 255u) == 0u) { if (xb_ld(&(bar)[XB_TMO])) break; if (_sp > XB_SPIN_CAP) { atomicAdd(&(bar)[XB_TMO], 1u); break; } } } } while (0)

struct XcdBarrier {
    unsigned* bar; unsigned x;
    volatile LAS unsigned* st;
};

__device__ __forceinline__ XcdBarrier xcd_barrier_post(unsigned* bar, volatile LAS unsigned* st) {
    XcdBarrier b; b.bar = bar; b.x = xb_xcc_id(); b.st = st;
    if (threadIdx.x == 0) (void)xb_add(&bar[XB_XCNT(b.x)], 1u);
    return b;
}
__device__ __forceinline__ void xcd_barrier_complete(unsigned* bar, unsigned x, unsigned& nloc, unsigned& nx) {
    const unsigned G = gridDim.x * gridDim.y * gridDim.z;
    unsigned sum, cnt, mine, sp = 0u;
    for (;;) {
        sum = 0u; cnt = 0u; mine = 0u;
#pragma unroll
        for (unsigned j = 0; j < 16; ++j) { const unsigned c = xb_ld(&bar[XB_XCNT(j)]); sum += c; cnt += (c > 0u) ? 1u : 0u; mine = (j == x) ? c : mine; }
        if (sum == G) break;
        __builtin_amdgcn_s_sleep(1);
        if ((++sp & 255u) == 0u) { if (xb_ld(&bar[XB_TMO])) break; if (sp > XB_SPIN_CAP) { atomicAdd(&bar[XB_TMO], 1u); break; } }
    }
    nloc = mine > 0u ? mine : 1u; nx = cnt > 0u ? cnt : 1u;
}

__device__ __forceinline__ void xcd_barrier(const XcdBarrier& b, const int wave0) {
    asm volatile("s_waitcnt vmcnt(0)" ::: "memory");
    __syncthreads();
    if (wave0 == 0 && lane_id_v() == 0) {
        unsigned* bar = b.bar;
        __builtin_amdgcn_s_waitcnt(0);
        unsigned nloc = b.st[0], nx = b.st[1];
        if (nloc == 0u) { xcd_barrier_complete(bar, b.x, nloc, nx); b.st[0] = nloc; b.st[1] = nx; }
        const unsigned old = xb_add(&bar[XB_XSUB(b.x)], 1u);
        const unsigned gen = old / nloc;
        if (old + 1u == (gen + 1u) * nloc) {
            __builtin_amdgcn_fence(__ATOMIC_RELEASE, "agent");
            asm volatile("s_waitcnt vmcnt(0)" ::: "memory");
            const unsigned og = xb_add(&bar[XB_TOP], 1u);
            const unsigned tg = og / nx;
            if (og + 1u == (tg + 1u) * nx) xb_add(&bar[XB_TOPGEN], 1u);
            else XB_SPIN(xb_ld(&bar[XB_TOPGEN]) == tg, bar);
            __builtin_amdgcn_fence(__ATOMIC_ACQUIRE, "agent");
            xb_add(&bar[XB_XGEN(b.x)], 1u);
            asm volatile("s_waitcnt vmcnt(0)" ::: "memory");
        } else {
            XB_SPIN(xb_ld(&bar[XB_XGEN(b.x)]) == gen, bar);
            __builtin_amdgcn_fence(__ATOMIC_ACQUIRE, "agent");
            asm volatile("s_waitcnt vmcnt(0)" ::: "memory");
        }
    }
    __syncthreads();
}


struct Args { const float* in[33]; float* out; unsigned char* ws; };
__device__ __forceinline__ unsigned char* wsb(unsigned char* p) { asm volatile("" : "+s"(p)); return p; }
__device__ __forceinline__ int opq(int i) { asm volatile("" : "+s"(i)); return i; }

#define MOD ((float*)(wsb(a.ws) + WS_MOD))
#define LAM ((float*)(wsb(a.ws) + WS_LAM))
#define ROPE ((cf*)(wsb(a.ws) + WS_ROPE))
#define TW ((cf*)(wsb(a.ws) + WS_TW))
#define WIN ((bf16_t*)(wsb(a.ws) + WS_WIN))
#define WOUT ((bf16_t*)(wsb(a.ws) + WS_WOUT))
#define WUP ((bf16_t*)(wsb(a.ws) + WS_WUP))
#define WDN ((bf16_t*)(wsb(a.ws) + WS_WDN))
#define CTXX ((float*)(wsb(a.ws) + WS_CTXX))
#define FILT ((float*)(wsb(a.ws) + WS_FILT))
#define FILTC ((float*)(wsb(a.ws) + WS_FILTC))
#define H ((bf16_t*)(wsb(a.ws) + WS_H))
#define KFB ((cf*)(wsb(a.ws) + WS_KF))
#define RAW ((bf16_t*)(wsb(a.ws) + WS_RAW))
#define YRAW ((bf16_t*)(wsb(a.ws) + WS_YRAW))
#define YH ((float*)(wsb(a.ws) + WS_YH))
#define YHC ((float*)(wsb(a.ws) + WS_YHC))
#define QA ((bf16_t*)(wsb(a.ws) + WS_QA))
#define KA ((bf16_t*)(wsb(a.ws) + WS_KA))
#define VA ((bf16_t*)(wsb(a.ws) + WS_VA))
#define QD ((bf16_t*)(wsb(a.ws) + WS_QD))
#define KD ((bf16_t*)(wsb(a.ws) + WS_KD))
#define VD ((bf16_t*)(wsb(a.ws) + WS_VD))
#define HYR ((bf16_t*)(wsb(a.ws) + WS_HYR))
#define HYRC ((bf16_t*)(wsb(a.ws) + WS_HYRC))
#define GB ((bf16_t*)(wsb(a.ws) + WS_G))
#define OUT (a.out)
__device__ __forceinline__ void prep_work(const Args& a, LAS unsigned char* lds, const int lp, const bool needc, const int widx, const int nwg, const bool do_main, const bool do_dn, const int tid, const int lane, const int wave) {
    LAS float* scr = (LAS float*)(lds + wave * 16384);
    constexpr int I_IN = 16 * 88, I_OUT = 16 * 32, I_UP = 16 * 176, I_DN = 44 * 32;
    for (int it = (do_main ? 0 : I_IN + I_OUT + I_UP) + widx * 8 + wave; it < (do_dn ? I_IN + I_OUT + I_UP + I_DN : I_IN + I_OUT + I_UP); it += nwg * 8) {
        int r = it;
        if (r < I_IN) { transpose_item<2>(a.in[opq(8)] + (size_t)lp * 1024 * INW, 1024, INW, WIN, scr, r, lane); continue; } r -= I_IN;
        if (r < I_OUT) { transpose_item(a.in[opq(28)] + (size_t)lp * 1024 * 1024, 1024, 1024, WOUT, scr, r, lane); continue; } r -= I_OUT;
        if (r < I_UP) { transpose_item<1>(a.in[opq(29)] + (size_t)lp * 1024 * 2 * DFF, 1024, 2 * DFF, WUP, scr, r, lane); continue; } r -= I_UP;
        transpose_item(a.in[opq(32)] + (size_t)lp * DFF * 1024, DFF, 1024, WDN, scr, r, lane);
    }
    __syncthreads();
    if (do_main) {
    const float* fw1 = a.in[opq(19)] + lp * 33 * 64; const float* fb1 = a.in[opq(20)] + lp * 64; const float* fw2 = a.in[opq(21)] + lp * 64 * 64; const float* fb2 = a.in[opq(22)] + lp * 64;
    const float* fw3 = a.in[opq(23)] + (size_t)lp * 64 * 1024; const float* fb3 = a.in[opq(24)] + lp * 1024; const float* freq = a.in[opq(25)] + lp * 64;
    LAS float* Z = (LAS float*)lds; LAS float* H1 = Z + 33 * 33; LAS float* H2 = H1 + 33 * 64; LAS float* W1 = H2 + 33 * 64; LAS float* W2 = W1 + 33 * 64; LAS float* FB = W2 + 64 * 64;
    for (int i = tid; i < 33 * 64; i += NTHR) W1[i] = fw1[i];
    for (int i = tid; i < 64 * 64; i += NTHR) W2[i] = fw2[i];
    if (tid < 64) { FB[tid] = fb1[tid]; FB[64 + tid] = fb2[tid]; FB[128 + tid] = freq[tid]; }
    const int npos = needc ? 33 : 32;
    for (int item = widx; item < 256; item += nwg) {
        __syncthreads();
        for (int i = tid; i < npos * 33; i += NTHR) { const int p = i / 33, e = i - p * 33; const bool isc = p == 32; const int n = isc ? item : item * 32 + p; const float NP = isc ? 256.0f : 8192.0f; float val;
            if (e == 0) val = (float)n / (NP - 1.0f);
            else { const int k = (e - 1) & 15; const float band = 1e-4f + (float)k * ((15.0f - 1e-4f) / 15.0f); const float w = 6.283185307179586f * (float)n / NP; const float arg = band * w;
                val = (e <= 16) ? cosf(arg) : -sinf(arg); }
            Z[i] = val; }
        __syncthreads();
        for (int i = tid; i < npos * 64; i += NTHR) { const int p = i >> 6, j = i & 63; float s = FB[j];
#pragma unroll
            for (int e = 0; e < 33; ++e) s += Z[p * 33 + e] * W1[e * 64 + j];
            H1[i] = sinf(FB[128 + j] * s); }
        __syncthreads();
        for (int i = tid; i < npos * 64; i += NTHR) { const int p = i >> 6, j = i & 63; float s = FB[64 + j];
#pragma unroll 16
            for (int e = 0; e < 64; ++e) s += H1[p * 64 + e] * W2[e * 64 + j];
            H2[i] = sinf(FB[128 + j] * s); }
        __syncthreads();
#pragma unroll 1
        for (int half = 0; half < 2; ++half) { const int q = tid + 512 * half, c = q & 255;
            float w[64];
#pragma unroll
            for (int e = 0; e < 64; ++e) w[e] = fw3[(size_t)e * 1024 + q];
            const float b3 = fb3[q], adelta = 3.0701134573253945f + (float)c * ((15.350567286626973f - 3.0701134573253945f) / 255.0f);
#pragma unroll 1
            for (int p = 0; p < npos; ++p) { float s = b3;
#pragma unroll
                for (int e = 0; e < 64; ++e) s += H2[p * 64 + e] * w[e];
                const bool isc = p == 32; const int n = isc ? item : item * 32 + p; const float t = (float)n / (isc ? 255.0f : 8191.0f);
                float* dst = isc ? FILTC + (size_t)q * 256 : FILT + (size_t)q * 8192;
                dst[n] = s * expf(-t * adelta); }
        }
    }
    __syncthreads();
    }
}

__global__ void __launch_bounds__(NTHR, 2) fwd_mega(Args a) {
    extern __shared__ __attribute__((aligned(16))) unsigned char lds_raw[];
    cg::grid_group grid = cg::this_grid();
    LAS unsigned char* lds = (LAS unsigned char*)lds_raw;
    const int G = gridDim.x, bx = blockIdx.x;
    const int NGW = G * 8;
const int wave0 = __builtin_amdgcn_readfirstlane(threadIdx.x >> 6);
#define PHASE_IDS int tid = wave0 * 64 + lane_id_v(); asm volatile("" : "+v"(tid)); const int lane = tid & 63, wave = __builtin_amdgcn_readfirstlane(tid >> 6); const int gw = bx * 8 + wave; (void)lane; (void)gw;

    volatile LAS unsigned* MISC = (volatile LAS unsigned*)(lds + 147392);
    if (threadIdx.x < 16) MISC[threadIdx.x] = 0u;
    __syncthreads();
    const XcdBarrier xbar = xcd_barrier_post((unsigned*)a.ws, MISC + 8);
    if (threadIdx.x == 0) MISC[2] = xb_add((unsigned*)a.ws + 4096 + 64 * xbar.x, 1u);
    {
        PHASE_IDS
        LAS float* S = (LAS float*)lds; LAS float* RED = S + 5 * 1024;
        const float* c = a.in[opq(1)]; const float* cctx = a.in[opq(3)];
        for (int i = tid; i < 5 * 1024; i += NTHR) { const float v = i < 4096 ? c[i] : cctx[i - 4096]; S[i] = v / (1.f + expf(-v)); }
        __syncthreads();
        const float* wmod = a.in[opq(6)]; const float* bmod = a.in[opq(7)];
        for (int item = bx; item < 384; item += G) {
            const int l = item / 96, cgi = item % 96, ks = tid >> 6, jl = tid & 63, col = cgi * 64 + jl;
            const float* w = wmod + ((size_t)l * 1024 + ks * 128) * 6144 + col;
            float a0 = 0.f, a1 = 0.f, a2 = 0.f, a3 = 0.f, a4 = 0.f;
#pragma unroll 8
            for (int k = 0; k < 128; ++k) { const float wv = w[(size_t)k * 6144]; const int kk = ks * 128 + k;
                a0 += S[kk] * wv; a1 += S[1024 + kk] * wv; a2 += S[2048 + kk] * wv; a3 += S[3072 + kk] * wv; a4 += S[4096 + kk] * wv; }
            RED[(ks * 5 + 0) * 64 + jl] = a0; RED[(ks * 5 + 1) * 64 + jl] = a1; RED[(ks * 5 + 2) * 64 + jl] = a2; RED[(ks * 5 + 3) * 64 + jl] = a3; RED[(ks * 5 + 4) * 64 + jl] = a4;
            __syncthreads();
            if (tid < 320) { const int bi = tid >> 6, j = tid & 63; float s = bmod[l * 6144 + cgi * 64 + j];
#pragma unroll
                for (int k2 = 0; k2 < 8; ++k2) s += RED[(k2 * 5 + bi) * 64 + j];
                MOD[((size_t)l * 5 + bi) * 6144 + cgi * 64 + j] = s; }
            __syncthreads();
        }
        if (bx == 0 && wave < 4) { const int l = wave;
            const float s1 = wave_sum(a.in[opq(13)][l * 64 + lane] * a.in[opq(14)][l * 64 + lane]), s2 = wave_sum(a.in[opq(15)][l * 64 + lane] * a.in[opq(16)][l * 64 + lane]);
            if (lane == 0) LAM[l] = expf(s1) - expf(s2) + (0.8f - 0.6f * expf(-0.3f * (float)l)); }
        const int gt = bx * NTHR + tid;
        if (gt < 2048) { const int p = gt >> 4, f = gt & 15; const float inv = powf(10000.0f, -(float)f / 16.0f); float sn, cs; sincosf((float)p * inv, &sn, &cs); ROPE[gt] = mk2(cs, sn); }
        for (int m = gt; m < FFTN; m += G * NTHR) { float sn, cs; sincospif((float)m / 8192.0f, &sn, &cs); TW[m] = mk2(cs, -sn); }
    }
    if (PROBE_PLAIN_LAUNCH) xcd_barrier(xbar, wave0); else grid.sync();
    if (threadIdx.x == 0) {
        bool ok = (G % 8 == 0) && xbar.x < 8u;
        for (int j = 0; j < 8; ++j) ok = ok && (xb_ld((unsigned*)a.ws + 4096 + 64 * j) == (unsigned)(G / 8));
        const unsigned rk = MISC[2];
        MISC[0] = ok ? rk * 8u + xbar.x : (unsigned)bx;
        MISC[1] = ok ? xbar.x * (unsigned)(G / 8) + rk : (unsigned)((G % 8 == 0) ? (bx % 8) * (G / 8) + bx / 8 : bx);
    }
    __syncthreads();
    const int cbx = __builtin_amdgcn_readfirstlane((int)MISC[0]), vcu = __builtin_amdgcn_readfirstlane((int)MISC[1]);

    for (int l = 0; l < DEPTH; ++l) {
        const bool need_ctx = l < DEPTH - 1;
        const float* xl = l == 0 ? a.in[opq(0)] : OUT; const float* xc = l == 0 ? a.in[opq(2)] : CTXX;
        const float* modl = MOD + (size_t)l * 5 * 6144;
        for (int rep_ = 0; rep_ < REP_PREP; ++rep_) {
            PHASE_IDS
            __syncthreads();
            prep_work(a, lds, l, need_ctx, bx, G, l == 0, true, tid, lane, wave);
            norm_mod(xl, xc, a.in[opq(4)] + l * 1024, modl, 0, 1024, H, MT, gw, NGW, lane);
        }
        xcd_barrier(xbar, wave0);
        {
            pg8::Gemm g{H, WIN, MT, INW, 1024}; pg8::StaticOrder S; S.init(MT, INW, G, cbx);
            EpiInProj E{QA, KA, VA, QD, KD, VD, HYR, HYRC, a.in[opq(9)] + l * 64, a.in[opq(10)] + l * 64, a.in[opq(11)] + l * 64, a.in[opq(12)] + l * 64, ROPE};
            pg8::gemm_phase<EpiInProj, pg8::StaticOrder, PG8_ALIGN, PG8_SP2>(lds, g, S, E, wave0);
        }
        xcd_barrier(xbar, wave0);
        {
            PHASE_IDS
            LAS cf* X = (LAS cf*)lds; LAS float* RED = (LAS float*)(lds + 135168);
            const float* cw = a.in[opq(17)] + l * 3 * 768; const float* cb = a.in[opq(18)] + l * 768; const float* hb_ = a.in[opq(26)] + l * 512;
            for (int rep_ = 0; rep_ < REP_HY; ++rep_) for (int c = vcu; c < 256; c += G) {
                const float wv0 = cw[c], wv1 = cw[768 + c], wv2 = cw[1536 + c], bv = cb[c];
                const float wa0 = cw[256 + c], wa1 = cw[768 + 256 + c], wa2 = cw[1536 + 256 + c], ba = cb[256 + c];
                const float wb0 = cw[512 + c], wb1 = cw[768 + 512 + c], wb2 = cw[1536 + 512 + c], bb = cb[512 + c];
                const float bias1 = hb_[c], bias2 = hb_[256 + c];
                cf* KF = KFB + (size_t)c * 2 * FFTN;
                const int cw = 8 * (lane & 7) + (lane >> 3);
                for (int o = 0; o < 2; ++o) {
                    const float* hf = FILT + ((size_t)(0 * 2 + o) * 256 + c) * 8192; const float* hb = FILT + ((size_t)(1 * 2 + o) * 256 + c) * 8192;
                    float s = 0.f; for (int i = tid; i < 8192; i += NTHR) s += fabsf(hf[i]) + fabsf(hb[i]);
                    s = block_sum(s, RED, tid); const float inv = 1.0f / (s + EPSF);
                    for (int i = tid; i < 8192; i += NTHR) { X[PX(i)] = mk2(hf[i] * inv, 0.f); X[PX(8192 + i)] = (i == 0) ? mk2(0.f, 0.f) : mk2(hb[8192 - i] * inv, 0.f); }
                    __syncthreads();
                    fft_fwd_lds(X, tid);
                    fft_last_fwd(X, tid, KF + o * FFTN, o == 0 ? bias1 : bias2, 1.0f / FFTN);
                }
                __threadfence(); __syncthreads();
                for (int bp = 0; bp < 2; ++bp) {
                    const int b0 = 2 * bp, b1 = b0 + 1;
                    const bf16_t* pv0 = HYR + ((size_t)b0 * 768 + c) * 8192; const bf16_t* pv1 = HYR + ((size_t)b1 * 768 + c) * 8192;
#pragma unroll 1
                    for (int k = 0; k < 2; ++k) { const int ch = 64 * (wave + 8 * k) + cw; float u0[8], u1[8];
                        conv8(pv0, ch, 8192, wv0, wv1, wv2, bv, u0); conv8(pv1, ch, 8192, wv0, wv1, wv2, bv, u1);
#pragma unroll
                        for (int e = 0; e < 8; ++e) { X[PX(8 * ch + e)] = mk2(u0[e], u1[e]); X[PX(8192 + 8 * ch + e)] = mk2(0.f, 0.f); } }
                    __syncthreads();
                    fft_fwd_lds(X, tid); fft_mid_mul(X, tid, KF); fft_inv_lds(X, tid);
#pragma unroll 1
                    for (int k = 0; k < 2; ++k) { const int ch = 64 * (wave + 8 * k) + cw; float a0_[8], a1_[8];
                        conv8(pv0 + 256 * 8192, ch, 8192, wa0, wa1, wa2, ba, a0_); conv8(pv1 + 256 * 8192, ch, 8192, wa0, wa1, wa2, ba, a1_);
#pragma unroll
                        for (int e = 0; e < 8; ++e) { const cf cv = X[PX(8 * ch + e)]; X[PX(8 * ch + e)] = mk2(a0_[e] * cv.x, a1_[e] * cv.y); X[PX(8192 + 8 * ch + e)] = mk2(0.f, 0.f); } }
                    __syncthreads();
                    fft_fwd_lds(X, tid); fft_mid_mul(X, tid, KF + FFTN); fft_inv_lds(X, tid);
#pragma unroll 1
                    for (int k = 0; k < 2; ++k) { const int ch = 64 * (wave + 8 * k) + cw; float x0_[8], x1_[8];
                        conv8(pv0 + 512 * 8192, ch, 8192, wb0, wb1, wb2, bb, x0_); conv8(pv1 + 512 * 8192, ch, 8192, wb0, wb1, wb2, bb, x1_);
                        f32x4 o0a, o0b, o1a, o1b;
#pragma unroll
                        for (int e = 0; e < 4; ++e) { const cf ca = X[PX(8 * ch + e)], cb2 = X[PX(8 * ch + 4 + e)]; o0a[e] = x0_[e] * ca.x; o1a[e] = x1_[e] * ca.y; o0b[e] = x0_[4 + e] * cb2.x; o1b[e] = x1_[4 + e] * cb2.y; }
                        float* y0p = YH + ((size_t)b0 * 256 + c) * 8192 + 8 * ch; float* y1p = YH + ((size_t)b1 * 256 + c) * 8192 + 8 * ch;
                        *(f32x4*)y0p = o0a; *(f32x4*)(y0p + 4) = o0b; *(f32x4*)y1p = o1a; *(f32x4*)(y1p + 4) = o1b; }
                    __syncthreads();
                }
                if (need_ctx) {
                    int tidc = tid; asm volatile("" : "+v"(tidc));
                    LAS float* KC = (LAS float*)lds; LAS float* U = KC + 1024; LAS float* XA = U + 1024; LAS float* XB = XA + 1024; LAS float* Z1 = XB + 1024;
                    for (int o = 0; o < 2; ++o) {
                        const float* hf = FILTC + ((size_t)(0 * 2 + o) * 256 + c) * 256; const float* hb = FILTC + ((size_t)(1 * 2 + o) * 256 + c) * 256;
                        const float f_ = tid < 256 ? hf[tid] : 0.f, b_ = tid < 256 ? hb[tid] : 0.f;
                        float s = fabsf(f_) + fabsf(b_);
                        s = block_sum(s, RED, tid); const float inv = 1.0f / (s + EPSF);
                        if (tid < 256) { KC[o * 512 + 255 + tid] = f_ * inv; if (tid > 0) KC[o * 512 + 255 - tid] = b_ * inv; }
                    }
#pragma unroll 1
                    for (int k = 0; k < 2; ++k) { const int i = tidc + 512 * k, b = i >> 8, t = i & 255; const bf16_t* p = HYRC + ((size_t)b * 768 + c) * 256;
                        U[i] = hy_in(p, t, 256, wv0, wv1, wv2, bv); XA[i] = hy_in(p + 256 * 256, t, 256, wa0, wa1, wa2, ba); XB[i] = hy_in(p + 512 * 256, t, 256, wb0, wb1, wb2, bb); }
                    __syncthreads();
#pragma unroll 1
                    for (int k = 0; k < 2; ++k) { const int i = tidc + 512 * k, b = i >> 8, t = i & 255; float acc = 0.f; const LAS float* kp = KC + 255 + t; const LAS float* up = U + b * 256;
#pragma unroll 8
                        for (int s = 0; s < 256; ++s) acc += kp[-s] * up[s];
                        Z1[i] = XA[i] * (acc + bias1 * U[i]); }
                    __syncthreads();
#pragma unroll 1
                    for (int k = 0; k < 2; ++k) { const int i = tidc + 512 * k, b = i >> 8, t = i & 255; float acc = 0.f; const LAS float* kp = KC + 512 + 255 + t; const LAS float* up = Z1 + b * 256;
#pragma unroll 8
                        for (int s = 0; s < 256; ++s) acc += kp[-s] * up[s];
                        YHC[((size_t)b * 256 + c) * 256 + t] = XB[i] * (acc + bias2 * Z1[i]); }
                    __syncthreads();
                }
            }
            for (int rep_ = 0; rep_ < REP_ATT; ++rep_) {
                const int nA = 16 * 32 + (need_ctx ? 16 : 0), nC = 32 * 32 + (need_ctx ? 32 : 0);
                for (int u = vcu; u < nA; u += G) {
                    const bool isc = u >= 16 * 32; const int hu = isc ? u - 16 * 32 : (u >> 5), qb = u & 31, b = hu >> 2, k = hu & 3, row0 = isc ? ML + b * 256 : b * 8192 + qb * 256;
                    attn_body::attn_unit<8, false, 256, 64, 64, 1280>((const attn_body::bf16*)(QA + k * 64 + (size_t)row0 * 256), (const attn_body::bf16*)(KA + (size_t)(b * 2 + (k >> 1)) * NKEY * 64), (const attn_body::bf16*)(VA + (size_t)(b * 2 + (k >> 1)) * NKEY * 64),
                        (attn_body::bf16*)(YRAW + k * 64 + (size_t)row0 * 1280), isc ? 4 : 132, (char*)lds_raw, wave0);
                }
                for (int u = vcu; u < nC; u += G) {
                    const bool isc = u >= 32 * 32; const int hu = isc ? u - 32 * 32 : (u >> 5), qb = u & 31, b = hu >> 3, h = (hu & 7) >> 1, j = hu & 1, row0 = isc ? ML + b * 256 : b * 8192 + qb * 256;
                    attn_body::attn_unit<8, true, 512, 64, 128, 1280>((const attn_body::bf16*)(QD + (h * 2 + j) * 64 + (size_t)row0 * 512), (const attn_body::bf16*)(KD + (size_t)(b * 8 + h * 2 + j) * NKEY * 64), (const attn_body::bf16*)(VD + (size_t)(b * 4 + h) * NKEY * 128),
                        (attn_body::bf16*)(YRAW + 256 + j * 512 + h * 128 + (size_t)row0 * 1280), isc ? 4 : 132, (char*)lds_raw, wave0);
                }
            }
        }
        xcd_barrier(xbar, wave0);
        for (int rep_ = 0; rep_ < REP_MERGE; ++rep_) {
            PHASE_IDS
            LAS float* S = (LAS float*)lds;
            const float* go = a.in[opq(27)] + l * 1024;
            const float lam = LAM[l], lam_init = 0.8f - 0.6f * expf(-0.3f * (float)l);
            const int ntile = need_ctx ? 528 : 512;
            for (int tl = bx; tl < ntile; tl += G) {
                const int r0 = tl * 64; const float* yb; int cstride;
                if (r0 < ML) { yb = YH + (size_t)(r0 >> 13) * 256 * 8192 + (r0 & 8191); cstride = 8192; } else { const int rr = r0 - ML; yb = YHC + (size_t)(rr >> 8) * 256 * 256 + (rr & 255); cstride = 256; }
                for (int i = 0; i < 32; ++i) { const int c = i * 8 + wave; S[lane * 257 + c] = __builtin_nontemporal_load(&yb[(size_t)c * cstride + lane]); }
                __syncthreads();
                for (int k = 0; k < 8; ++k) {
                    const int row = wave * 8 + k, r = r0 + row; const bf16_t* yr = YRAW + (size_t)r * 1280; bf16_t* hr = H + (size_t)r * 1024;
                    { const v2u w = __builtin_nontemporal_load((const v2u*)(yr + 4 * lane)); const float y0 = bflo(w.x), y1 = bfhi(w.x), y2 = bflo(w.y), y3 = bfhi(w.y);
                      const float ss = wave_sum(y0 * y0 + y1 * y1 + y2 * y2 + y3 * y3); const float rinv = 1.0f / sqrtf(ss * (1.0f / 256.0f) + EPSF);
                      const f32x4 g4 = *(const f32x4*)(go + 4 * lane); v2u o; o.x = pk2(y0 * rinv * g4.x, y1 * rinv * g4.y); o.y = pk2(y2 * rinv * g4.z, y3 * rinv * g4.w); __builtin_nontemporal_store(o, (v2u*)(hr + 4 * lane)); }
                    { const float y0 = S[row * 257 + 4 * lane], y1 = S[row * 257 + 4 * lane + 1], y2 = S[row * 257 + 4 * lane + 2], y3 = S[row * 257 + 4 * lane + 3];
                      const float ss = wave_sum(y0 * y0 + y1 * y1 + y2 * y2 + y3 * y3); const float rinv = 1.0f / sqrtf(ss * (1.0f / 256.0f) + EPSF);
                      const f32x4 g4 = *(const f32x4*)(go + 256 + 4 * lane); v2u o; o.x = pk2(y0 * rinv * g4.x, y1 * rinv * g4.y); o.y = pk2(y2 * rinv * g4.z, y3 * rinv * g4.w); __builtin_nontemporal_store(o, (v2u*)(hr + 256 + 4 * lane)); }
                    { const v4u w0 = __builtin_nontemporal_load((const v4u*)(yr + 256 + 8 * lane)), w1 = __builtin_nontemporal_load((const v4u*)(yr + 768 + 8 * lane));
                      float d[8];
                      d[0] = bflo(w0.x) - lam * bflo(w1.x); d[1] = bfhi(w0.x) - lam * bfhi(w1.x); d[2] = bflo(w0.y) - lam * bflo(w1.y); d[3] = bfhi(w0.y) - lam * bfhi(w1.y);
                      d[4] = bflo(w0.z) - lam * bflo(w1.z); d[5] = bfhi(w0.z) - lam * bfhi(w1.z); d[6] = bflo(w0.w) - lam * bflo(w1.w); d[7] = bfhi(w0.w) - lam * bfhi(w1.w);
                      float ss = 0.f;
#pragma unroll
                      for (int q = 0; q < 8; ++q) ss += d[q] * d[q];
                      ss = row16_sum(ss);
                      const float rinv = (1.0f - lam_init) / sqrtf(ss * (1.0f / 128.0f) + EPSF);
                      const f32x4 ga = *(const f32x4*)(go + 512 + 8 * lane), gb = *(const f32x4*)(go + 512 + 8 * lane + 4);
                      v4u o; o.x = pk2(d[0] * rinv * ga.x, d[1] * rinv * ga.y); o.y = pk2(d[2] * rinv * ga.z, d[3] * rinv * ga.w); o.z = pk2(d[4] * rinv * gb.x, d[5] * rinv * gb.y); o.w = pk2(d[6] * rinv * gb.z, d[7] * rinv * gb.w);
                      __builtin_nontemporal_store(o, (v4u*)(hr + 512 + 8 * lane)); }
                }
                __syncthreads();
            }
        }
        xcd_barrier(xbar, wave0);
        for (int es_ = 0; es_ < EXTRA_SYNC; ++es_) xcd_barrier(xbar, wave0);
        const int M5 = need_ctx ? MT : ML;
        {
            pg8::Gemm g{H, WOUT, M5, 1024, 1024}; pg8::StaticOrder S; S.init(M5, 1024, G, cbx);
            EpiGateRes E{xl, OUT, xc, CTXX, modl + 2048, 0};
            pg8::gemm_phase<EpiGateRes, pg8::StaticOrder, PG8_ALIGN, PG8_SP2>(lds, g, S, E, wave0);
            for (int rep_ = 1; rep_ < REP_GEMM2; ++rep_) { EpiGateRes E2{OUT, OUT, CTXX, CTXX, (const float*)(wsb(a.ws) + 65536), 0}; pg8::gemm_phase<EpiGateRes, pg8::StaticOrder, PG8_ALIGN, PG8_SP2>(lds, g, S, E2, wave0); }
        }
        xcd_barrier(xbar, wave0);
        for (int rep_ = 0; rep_ < REP_N2; ++rep_) { PHASE_IDS norm_mod(OUT, CTXX, a.in[opq(5)] + l * 1024, modl, 3072, 4096, H, M5, gw, NGW, lane); }
        xcd_barrier(xbar, wave0);
        {
            const int ntm = (M5 + 247) / 248;
            pg8::Gemm g{H - 1024, WUP, ntm * 256, 2 * DFF, 1024}; pg8::StaticOrder S; S.init(ntm * 256, 2 * DFF, G, cbx);
            EpiGlu E{GB, a.in[opq(30)] + (size_t)l * 3 * DFF, a.in[opq(31)] + l * DFF, M5};
            pg8::gemm_phase<EpiGlu, pg8::StaticOrder, PG8_ALIGN, PG8_SP2, true>(lds, g, S, E, wave0);
        }
        xcd_barrier(xbar, wave0);
        {
            pg8::Gemm g{GB, WDN, M5, 1024, DFF}; pg8::StaticOrder S; S.init(M5, 1024, G, cbx);
            EpiGateRes E{OUT, OUT, CTXX, CTXX, modl + 5120, 0};
            pg8::gemm_phase<EpiGateRes, pg8::StaticOrder, PG8_ALIGN, PG8_SP2>(lds, g, S, E, wave0);
            if (l + 1 < DEPTH) { const int units = (M5 >> 8) * 4, first = units % G;
                if (cbx >= first) { PHASE_IDS __syncthreads(); prep_work(a, lds, l + 1, l + 1 < DEPTH - 1, cbx - first, G - first, true, false, tid, lane, wave); } }
        }
        xcd_barrier(xbar, wave0);
    }
}

extern "C" void kernel_launch(void* const* d_in, const int* in_sizes, int n_in, void* d_out, int out_size, void* d_ws, size_t ws_size, hipStream_t stream) {
    static int grid = 0;
    if (grid == 0) {
        if (n_in != 33 || out_size != ML * DMOD || ws_size < WS_END) { fprintf(stderr, "kernel_launch: unexpected shapes: n_in %d out %d ws %zu (need %zu)\n", n_in, out_size, ws_size, (size_t)WS_END); grid = -1; return; }
        int dev = 0, cus = 0, per_cu = 0;
        if (hipGetDevice(&dev) != hipSuccess || hipDeviceGetAttribute(&cus, hipDeviceAttributeMultiprocessorCount, dev) != hipSuccess) { grid = -1; return; }
        if (hipFuncSetAttribute((const void*)fwd_mega, hipFuncAttributeMaxDynamicSharedMemorySize, LDS_BYTES) != hipSuccess) { fprintf(stderr, "kernel_launch: hipFuncSetAttribute failed\n"); grid = -1; return; }
        if (hipOccupancyMaxActiveBlocksPerMultiprocessor(&per_cu, (const void*)fwd_mega, NTHR, LDS_BYTES) != hipSuccess || per_cu < 1) { fprintf(stderr, "kernel_launch: occupancy query says %d\n", per_cu); }
        (void)hipGetLastError();
        grid = cus;
    }
    if (grid < 0) return;
    Args a{};
    for (int i = 0; i < 33; ++i) a.in[i] = (const float*)d_in[i];
    a.out = (float*)d_out; a.ws = (unsigned char*)d_ws;
    if (hipMemsetAsync(d_ws, 0, 32768, stream) != hipSuccess) { fprintf(stderr, "kernel_launch: memset failed\n"); return; }
    void* args[] = {&a};
#if PROBE_PLAIN_LAUNCH
    hipLaunchKernelGGL(fwd_mega, dim3(grid), dim3(NTHR), LDS_BYTES, stream, a); const hipError_t e = hipPeekAtLastError(); (void)args;
#else
    const hipError_t e = hipLaunchCooperativeKernel((const void*)fwd_mega, dim3(grid), dim3(NTHR), args, LDS_BYTES, stream);
#endif
    if (e != hipSuccess) fprintf(stderr, "kernel_launch: cooperative launch failed: %s (grid %d)\n", hipGetErrorString(e), grid);
}
```
